# Optimizing an MI355X kernel written in HIP

```python
import jax, jax.numpy as jnp
from jax import lax
import numpy as np

D_MODEL = 4096
BATCH = 2
SEQ = 8192
DEPTH = 1

N_META = 16
BLOCK = 128
PAD = BLOCK - N_META
EPS = 1e-6
NEG = -1e30
FOX_HEADS = 16
FOX_HD = 128
FOX_W = FOX_HEADS * FOX_HD
RET_HEADS = 16
RET_DK = 128
RET_DV = 256
RET_QK_W = RET_HEADS * RET_DK
RET_V_W = RET_HEADS * RET_DV
ROPE_BASE = 10000.0
PEER_HEADS = 8
PEER_NKEYS = 128
PEER_N = PEER_NKEYS * PEER_NKEYS
PEER_QDIM = 256
PEER_HALF = PEER_QDIM // 2
PEER_TOPK = 16
PEER_CHUNK = 128
W_IN_SPLITS = (FOX_W, FOX_W, FOX_W, FOX_HEADS,
               RET_QK_W, RET_QK_W, RET_V_W, RET_V_W,
               D_MODEL, D_MODEL)
W_IN_COLS = 3 * FOX_W + FOX_HEADS + 2 * RET_QK_W + 2 * RET_V_W + 2 * D_MODEL

kernel_name = "hybrid_fox_retnet_peer_block"


def _rmsnorm(x, g):
    xf = x.astype(jnp.float32)
    xf = xf * lax.rsqrt(jnp.mean(xf * xf, axis=-1, keepdims=True) + EPS)
    return xf.astype(x.dtype) * g


def _split_points():
    pts, acc = [], 0
    for w in W_IN_SPLITS[:-1]:
        acc += w
        pts.append(acc)
    return pts


def _heads(t, n_heads):
    b, l, _ = t.shape
    return t.reshape(b, l, n_heads, -1).transpose(0, 2, 1, 3)


def _rotary(x, pos):
    half = x.shape[-1] // 2
    inv = ROPE_BASE ** (-jnp.arange(half, dtype=jnp.float32) / half)
    ang = pos[:, None] * inv[None, :]
    cos, sin = jnp.cos(ang), jnp.sin(ang)
    xf = x.astype(jnp.float32)
    x1, x2 = xf[..., :half], xf[..., half:]
    return jnp.concatenate([x1 * cos - x2 * sin, x1 * sin + x2 * cos], axis=-1).astype(x.dtype)


def _fox_attention(q, k, v, logf):
    b, h, l, hd = q.shape
    nb = l // BLOCK
    c = jnp.cumsum(logf, axis=-1)
    kpos = jnp.arange(l)
    scale = hd ** -0.5

    def one_block(i):
        start = i * BLOCK
        qb = lax.dynamic_slice_in_dim(q, start, BLOCK, axis=2)
        cb = lax.dynamic_slice_in_dim(c, start, BLOCK, axis=2)
        qpos = start + jnp.arange(BLOCK)
        s = jnp.einsum('bhqd,bhkd->bhqk', qb, k).astype(jnp.float32) * scale
        s = s + (cb[..., :, None] - c[..., None, :])
        mask = (kpos[None, :] <= qpos[:, None]) & (kpos[None, :] >= PAD)
        s = jnp.where(mask, s, NEG)
        p = jax.nn.softmax(s, axis=-1)
        return jnp.einsum('bhqk,bhkd->bhqd', p.astype(v.dtype), v)

    out = lax.map(one_block, jnp.arange(nb))
    return out.transpose(1, 0, 3, 2, 4).reshape(b, l, h * hd)


def _retention(q, k, v):
    b, h, l, dk = q.shape
    dv = v.shape[-1]
    nc = l // BLOCK
    log_gamma = jnp.log1p(-(2.0 ** (-5.0 - jnp.arange(h, dtype=jnp.float32))))
    idx = jnp.arange(BLOCK, dtype=jnp.float32)
    diff = idx[:, None] - idx[None, :]
    decay = jnp.where(diff >= 0, jnp.exp(log_gamma[:, None, None] * jnp.maximum(diff, 0.0)), 0.0)
    xi = jnp.exp(log_gamma[:, None] * (idx + 1.0))
    zeta = jnp.exp(log_gamma[:, None] * (BLOCK - 1.0 - idx))
    chunk_decay = jnp.exp(log_gamma * BLOCK)

    qc = q.reshape(b, h, nc, BLOCK, dk).astype(jnp.float32)
    kc = k.reshape(b, h, nc, BLOCK, dk).astype(jnp.float32)
    vc = v.reshape(b, h, nc, BLOCK, dv).astype(jnp.float32)
    s = jnp.einsum('bhnid,bhnjd->bhnij', qc, kc) * decay[:, None]
    intra = jnp.einsum('bhnij,bhnje->bhnie', s, vc)

    def step(state, inp):
        qn, kn, vn = inp
        cross = jnp.einsum('bhid,bhde->bhie', qn, state) * xi[..., None]
        state = state * chunk_decay[:, None, None] + jnp.einsum('bhjd,bhje->bhde', kn * zeta[..., None], vn)
        return state, cross

    state0 = jnp.zeros((b, h, dk, dv), jnp.float32)
    _, cross = lax.scan(step, state0, (qc.transpose(2, 0, 1, 3, 4),
                                       kc.transpose(2, 0, 1, 3, 4),
                                       vc.transpose(2, 0, 1, 3, 4)))
    o = intra + cross.transpose(1, 2, 0, 3, 4)
    return o.reshape(b, h, l, dv)


def _head_groupnorm(o, g):
    mu = jnp.mean(o, axis=-1, keepdims=True)
    var = jnp.mean(jnp.square(o - mu), axis=-1, keepdims=True)
    o = (o - mu) * lax.rsqrt(var + EPS)
    b, h, l, dv = o.shape
    return o.transpose(0, 2, 1, 3).reshape(b, l, h * dv) * g.astype(jnp.float32)


def _mixer(h, pos, valid, norm_g, w_in, b_forget, q_norm_g, k_norm_g, ret_norm_g, w_proj_fox, w_proj_ret, w_out):
    u = _rmsnorm(h, norm_g)
    z = u @ w_in
    qa, ka, va, fa, qr, kr, vr, gr, gate_a, gate_r = jnp.split(z, _split_points(), axis=-1)
    qa = _rmsnorm(_heads(qa, FOX_HEADS), q_norm_g)
    ka = _rmsnorm(_heads(ka, FOX_HEADS), k_norm_g)
    logf = jax.nn.log_sigmoid((fa + b_forget).astype(jnp.float32)).transpose(0, 2, 1)
    ya = _fox_attention(qa, ka, _heads(va, FOX_HEADS), logf)
    vmask = valid.astype(h.dtype)[:, None]
    qr = _rotary(_heads(qr, RET_HEADS), pos)
    kr = _rotary(_heads(kr, RET_HEADS), pos) * (RET_DK ** -0.5) * vmask
    vr = _heads(vr, RET_HEADS) * vmask
    o = _head_groupnorm(_retention(qr, kr, vr), ret_norm_g)
    yr = jax.nn.silu(gr) * o.astype(h.dtype)
    merged = jax.nn.sigmoid(gate_a) * (ya @ w_proj_fox) + jax.nn.sigmoid(gate_r) * (yr @ w_proj_ret)
    return merged @ w_out


def _peer(h, norm_g, w_q, keys_1, keys_2, u_tab, v_tab):
    b, l, d = h.shape
    x = _rmsnorm(h, norm_g)
    tokens = x.reshape(-1, PEER_CHUNK, d)

    def chunk(t):
        q = (t @ w_q).reshape(PEER_CHUNK, PEER_HEADS, PEER_QDIM)
        q1, q2 = q[..., :PEER_HALF], q[..., PEER_HALF:]
        s1 = jnp.einsum('thd,hnd->thn', q1, keys_1)
        s2 = jnp.einsum('thd,hnd->thn', q2, keys_2)
        v1, i1 = lax.top_k(s1, PEER_TOPK)
        v2, i2 = lax.top_k(s2, PEER_TOPK)
        cand = (v1[..., :, None] + v2[..., None, :]).reshape(PEER_CHUNK, PEER_HEADS, PEER_TOPK * PEER_TOPK)
        cid = (i1[..., :, None] * PEER_NKEYS + i2[..., None, :]).reshape(PEER_CHUNK, PEER_HEADS, PEER_TOPK * PEER_TOPK)
        sv, sp = lax.top_k(cand, PEER_TOPK)
        eid = jnp.take_along_axis(cid, sp, axis=-1)
        g = jax.nn.softmax(sv.astype(jnp.float32), axis=-1)
        act = jax.nn.gelu(jnp.einsum('td,thkd->thk', t, u_tab[eid]).astype(jnp.float32), approximate=False)
        return jnp.einsum('thk,thkd->td', (g * act).astype(t.dtype), v_tab[eid])

    y = lax.map(chunk, tokens)
    return y.reshape(b, l, d)


def setup_inputs(seed: int = 0) -> dict:
    key = jax.random.key(seed)
    ks = jax.random.split(key, 20)
    f32 = jnp.float32
    nrm = lambda k, shape, s: jax.random.normal(k, shape, f32) * s
    return {
        "x": nrm(ks[0], (BATCH, SEQ, D_MODEL), 1.0),
        "meta_tokens": nrm(ks[1], (N_META, D_MODEL), 1.0),
        "norm_mix_g": 1.0 + nrm(ks[2], (DEPTH, D_MODEL), 0.02),
        "w_in": nrm(ks[3], (DEPTH, D_MODEL, W_IN_COLS), D_MODEL ** -0.5),
        "b_forget": jnp.linspace(1.0, 5.0, FOX_HEADS, dtype=f32)[None, :] + nrm(ks[4], (DEPTH, FOX_HEADS), 0.1),
        "q_norm_g": 1.0 + nrm(ks[5], (DEPTH, FOX_HD), 0.02),
        "k_norm_g": 1.0 + nrm(ks[6], (DEPTH, FOX_HD), 0.02),
        "ret_norm_g": 1.0 + nrm(ks[7], (DEPTH, RET_V_W), 0.02),
        "w_proj_fox": nrm(ks[8], (DEPTH, FOX_W, D_MODEL), FOX_W ** -0.5),
        "w_proj_ret": nrm(ks[9], (DEPTH, RET_V_W, D_MODEL), RET_V_W ** -0.5),
        "w_out": nrm(ks[10], (DEPTH, D_MODEL, D_MODEL), D_MODEL ** -0.5),
        "norm_ffn_g": 1.0 + nrm(ks[11], (DEPTH, D_MODEL), 0.02),
        "peer_w_q": nrm(ks[12], (DEPTH, D_MODEL, PEER_HEADS * PEER_QDIM), D_MODEL ** -0.5),
        "peer_keys_1": nrm(ks[13], (DEPTH, PEER_HEADS, PEER_NKEYS, PEER_HALF), PEER_HALF ** -0.5),
        "peer_keys_2": nrm(ks[14], (DEPTH, PEER_HEADS, PEER_NKEYS, PEER_HALF), PEER_HALF ** -0.5),
        "peer_u": nrm(ks[15], (DEPTH, PEER_N, D_MODEL), D_MODEL ** -0.5),
        "peer_v": nrm(ks[16], (DEPTH, PEER_N, D_MODEL), (PEER_HEADS * PEER_TOPK) ** -0.5),
    }


def reference(x, meta_tokens, norm_mix_g, w_in, b_forget, q_norm_g, k_norm_g, ret_norm_g,
              w_proj_fox, w_proj_ret, w_out, norm_ffn_g, peer_w_q, peer_keys_1, peer_keys_2,
              peer_u, peer_v):
    b = x.shape[0]
    pad = jnp.zeros((b, PAD, D_MODEL), x.dtype)
    meta = jnp.broadcast_to(meta_tokens.astype(x.dtype)[None], (b, N_META, D_MODEL))
    h = jnp.concatenate([pad, meta, x], axis=1)
    lp = h.shape[1]
    pos = jnp.arange(lp, dtype=jnp.float32) - PAD
    valid = jnp.arange(lp) >= PAD
    for i in range(DEPTH):
        h = h + _mixer(h, pos, valid, norm_mix_g[i], w_in[i], b_forget[i], q_norm_g[i], k_norm_g[i],
                       ret_norm_g[i], w_proj_fox[i], w_proj_ret[i], w_out[i])
        h = h + _peer(h, norm_ffn_g[i], peer_w_q[i], peer_keys_1[i], peer_keys_2[i], peer_u[i], peer_v[i])
    return h[:, PAD + N_META:]
```

```cpp
#include <hip/hip_runtime.h>
#include <cstdio>
#include <cstdint>

#ifndef MK_N_LAUNCHES
#define MK_N_LAUNCHES 1
#endif
#ifndef DBG_CHECK
#define DBG_CHECK 0
#endif

constexpr int DM = 4096, NB = 2, SEQ = 8192, MTOK = NB * SEQ;
constexpr int NMETA = 16, MROWS = MTOK + 256;
constexpr int NH = 16, HD = 128, RDV = 256;
constexpr int SKV = 64 + SEQ;
constexpr int LR = 128 + SEQ;
constexpr int NZ = 26880;
constexpr int NCHUNK = 64;
constexpr int PH = 8, PK = 128, PTOP = 16, PQ = 2048;
constexpr float EPS = 1e-6f;
constexpr int Z_QA = 0, Z_KA = 2048, Z_VA = 4096, Z_QR = 6144, Z_KR = 8192, Z_VR = 10240, Z_GR = 14336, Z_GA = 18432, Z_GT = 22528, Z_F = 26624;

constexpr size_t MiB = 1u << 20;
constexpr size_t WS_CTL = 0, CTL_ZERO_BYTES = 1 * MiB;
constexpr size_t WS_WFOX = 2 * MiB;
constexpr size_t WS_WRET = WS_WFOX + 16 * MiB;
constexpr size_t WS_WOUT = WS_WRET + 32 * MiB;
constexpr size_t WS_WQ   = WS_WOUT + 32 * MiB;
constexpr size_t WS_KEYS = WS_WQ + 16 * MiB;
constexpr size_t WS_T1   = WS_KEYS + 1 * MiB;
constexpr size_t WS_WZ   = WS_T1;
constexpr size_t WS_UX   = WS_T1 + 210 * MiB;
constexpr size_t WS_KVT  = WS_T1;
constexpr size_t WS_MRG  = WS_T1;
constexpr size_t WS_XN   = WS_T1 + 128 * MiB;
constexpr size_t WS_QP   = WS_T1 + 256 * MiB;
constexpr size_t WS_P1   = WS_T1 + 340 * MiB;
constexpr size_t WS_QA   = WS_P1;
constexpr size_t WS_KA   = WS_QA + 64 * MiB;
constexpr size_t WS_VA   = WS_KA + 65 * MiB;
constexpr size_t WS_QR   = WS_VA + 65 * MiB;
constexpr size_t WS_KR   = WS_QR + 65 * MiB;
constexpr size_t WS_VR   = WS_KR + 65 * MiB;
constexpr size_t WS_CUM  = WS_VR + 130 * MiB;
constexpr size_t WS_GR   = WS_CUM + 2 * MiB;
constexpr size_t WS_GA   = WS_GR + 128 * MiB;
constexpr size_t WS_GT   = WS_GA + 128 * MiB;
constexpr size_t WS_ST   = WS_GT + 128 * MiB;
constexpr size_t WS_YA   = WS_ST + 128 * MiB;
constexpr size_t WS_YR   = WS_YA + 64 * MiB;
constexpr size_t WS_END  = WS_YR + 128 * MiB;
constexpr size_t WS_U16  = WS_QA;
constexpr size_t WS_V16  = WS_QA + 128 * MiB;
constexpr size_t WS_EID  = WS_QA + 256 * MiB;
constexpr size_t WS_GW   = WS_QA + 264 * MiB;
static_assert(WS_GW + 8 * MiB <= WS_CUM, "overlay fits in the dead QA..VR region");
static_assert(WS_END <= 1745879040ull, "workspace map fits 4 x sizeof(w_in)");
static_assert(WS_QP + 64 * MiB <= WS_P1 && WS_UX + 130 * MiB <= WS_P1, "T1 map");

constexpr int CW_TMO = 0, CW_CODE = 1;
constexpr int CW_BAR = 4096;
constexpr int CW_DBG = 65536;

constexpr int RING_OFF = 0, RING_BYTES = 131072;
constexpr int LDSX_OFF = RING_BYTES;
constexpr int LDSCTL_OFF = RING_BYTES + 24576, MISC_OFF = LDSCTL_OFF + 320;
constexpr int LDS_BYTES = LDSCTL_OFF + 1024;
static_assert(LDS_BYTES <= 163840, "LDS");

#define GAS __attribute__((address_space(1)))
#define LAS __attribute__((address_space(3)))
typedef unsigned short bf16;
typedef unsigned v4u __attribute__((ext_vector_type(4)));
typedef unsigned v2u __attribute__((ext_vector_type(2)));
typedef float f32x4 __attribute__((ext_vector_type(4)));
typedef float f32x2 __attribute__((ext_vector_type(2)));
typedef float f32x16 __attribute__((ext_vector_type(16)));
typedef short bf16x8 __attribute__((ext_vector_type(8)));
typedef short s16x4 __attribute__((ext_vector_type(4)));
typedef __bf16 bf16x2_t __attribute__((ext_vector_type(2)));
typedef GAS unsigned gu32;
#define RLX_AGENT __ATOMIC_RELAXED, __HIP_MEMORY_SCOPE_AGENT
#define LDS_WAIT() asm volatile("s_waitcnt lgkmcnt(0)" ::: "memory")
#define VM_WAIT() asm volatile("s_waitcnt vmcnt(0)" ::: "memory")
#define SBAR() __builtin_amdgcn_sched_barrier(0)
__device__ __forceinline__ unsigned f2bf(float f) { unsigned u = __builtin_bit_cast(unsigned, f); return (u + 0x7fffu + ((u >> 16) & 1u)) >> 16; }
__device__ __forceinline__ unsigned pk2(float lo, float hi) { return f2bf(lo) | (f2bf(hi) << 16); }
__device__ __forceinline__ unsigned cvtpk(float lo, float hi) { unsigned r; asm volatile("v_cvt_pk_bf16_f32 %0, %1, %2" : "=v"(r) : "v"(lo), "v"(hi)); return r; }
__device__ __forceinline__ float bflo(unsigned w) { return __uint_as_float(w << 16); }
__device__ __forceinline__ float bfhi(unsigned w) { return __uint_as_float(w & 0xffff0000u); }
__device__ __forceinline__ float fast_exp2(float x) { return __builtin_amdgcn_exp2f(x); }
__device__ __forceinline__ float fast_rcp(float x) { return __builtin_amdgcn_rcpf(x); }
__device__ __forceinline__ float sigmoidf_(float x) { return fast_rcp(1.f + fast_exp2(-1.4426950408889634f * x)); }
__device__ __forceinline__ float wave_sum(float v) {
#pragma unroll
    for (int o = 1; o < 64; o <<= 1) v += __shfl_xor(v, o);
    return v;
}
namespace pg8 {
#define PG8_LAS __attribute__((address_space(3)))
typedef unsigned short bf16_t;
typedef short bf16x8 __attribute__((ext_vector_type(8)));
typedef float f32x4 __attribute__((ext_vector_type(4)));
typedef unsigned u32x4 __attribute__((ext_vector_type(4)));
constexpr int BM = 256, BK = 64, HALF = 128, HTB = HALF * BK * 2  , STAGE_BYTES = 8 * HTB, NXCD = 8, WGM = 8;

__host__ __device__ __forceinline__ int lds_byte(int r, int c) { const int st = (r >> 4) * 2 + (c >> 5), rr = r & 15, cc = c & 31, ob = rr * 64 + cc * 2; return st * 1024 + (ob ^ (((ob >> 9) & 1) << 5)); }
__host__ __device__ __forceinline__ void stage_rc(int b, int& R, int& C) { const int st = b / 1024, sb = b % 1024, swz = sb ^ (((sb >> 9) & 1) << 5); R = (st >> 1) * 16 + swz / 64; C = (st & 1) * 32 + (swz % 64) / 2; }
__host__ __device__ __forceinline__ int perm32(int rho) { const int n = rho >> 4, i = rho & 15; return 8 * (i >> 2) + 4 * n + (i & 3); }

struct Unit { int pm, pn; };
struct Gemm { const bf16_t* A; const bf16_t* Bt; int M, N, K; };

struct StaticOrder {
    int nM, nN, nwg, G, c;
    __host__ __device__ void init(int M, int N, int G_, int c_) { nM = M / BM; nN = N / BM; nwg = nM * nN; G = G_; c = c_; }
    __host__ __device__ bool next(int i, Unit& u) const {
        const long L = (long)i * G + c; if (L >= nwg) return false;
        int wgid = (int)L; { const int q = nwg / NXCD, r = nwg % NXCD, xcd = wgid % NXCD, off = wgid / NXCD; wgid = (xcd < r ? xcd * (q + 1) : r * (q + 1) + (xcd - r) * q) + off; }
        const int nig = WGM * nN, gid = wgid / nig, fm = gid * WGM, gsz = (nM - fm) < WGM ? (nM - fm) : WGM;
        u.pm = fm + ((wgid % nig) % gsz); u.pn = (wgid % nig) / gsz; return true;
    }
    __device__ __forceinline__ void a_ready(const Unit&) const {}
    __device__ __forceinline__ void done(const Unit&) const {}
};

__device__ __forceinline__ unsigned cvt_pk_bf16(float lo, float hi) { unsigned r; asm volatile("v_cvt_pk_bf16_f32 %0, %1, %2" : "=v"(r) : "v"(lo), "v"(hi)); return r; }
typedef float f32x2 __attribute__((ext_vector_type(2)));
}
__device__ const double ROT_REV[64] = {
    1.59154943091895346e-01, 1.37822502603982849e-01, 1.19349370211248862e-01, 1.03352296618434064e-01,
    8.94994016088910133e-02, 7.75032887553740585e-02, 6.71150830052272551e-02, 5.81192674418762462e-02,
    5.03292121044870353e-02, 4.35833021053073297e-02, 3.77415847174197711e-02, 3.26828658723569976e-02,
    2.83021958306233987e-02, 2.45086918620698521e-02, 2.12236527647776604e-02, 1.83789261056796667e-02,
    1.59154943091895339e-02, 1.37822502603982839e-02, 1.19349370211248862e-02, 1.03352296618434061e-02,
    8.94994016088910237e-03, 7.75032887553740550e-03, 6.71150830052272534e-03, 5.81192674418762410e-03,
    5.03292121044870370e-03, 4.35833021053073314e-03, 3.77415847174197719e-03, 3.26828658723569932e-03,
    2.83021958306233987e-03, 2.45086918620698521e-03, 2.12236527647776622e-03, 1.83789261056796667e-03,
    1.59154943091895356e-03, 1.37822502603982878e-03, 1.19349370211248849e-03, 1.03352296618434048e-03,
    8.94994016088910237e-04, 7.75032887553740507e-04, 6.71150830052272599e-04, 5.81192674418762388e-04,
    5.03292121044870326e-04, 4.35833021053073292e-04, 3.77415847174197741e-04, 3.26828658723569922e-04,
    2.83021958306233954e-04, 2.45086918620698543e-04, 2.12236527647776605e-04, 1.83789261056796662e-04,
    1.59154943091895351e-04, 1.37822502603982856e-04, 1.19349370211248862e-04, 1.03352296618434061e-04,
    8.94994016088910182e-05, 7.75032887553740561e-05, 6.71150830052272545e-05, 5.81192674418762388e-05,
    5.03292121044870354e-05, 4.35833021053073225e-05, 3.77415847174197768e-05, 3.26828658723569989e-05,
    2.83021958306233961e-05, 2.45086918620698523e-05, 2.12236527647776592e-05, 1.83789261056796682e-05,
};
namespace pg8 {
#if 1
typedef unsigned char* rsrc_t;
__device__ __forceinline__ rsrc_t mk_rsrc(const void* p, unsigned) { return (unsigned char*)p; }
#else
typedef __amdgpu_buffer_rsrc_t rsrc_t;
__device__ __forceinline__ rsrc_t mk_rsrc(const void* p, unsigned bytes) { return __builtin_amdgcn_make_buffer_rsrc((void*)p, 0, bytes, 0x00020000); }
#endif
__device__ __forceinline__ void st8b(rsrc_t rs, int voff, int soff, const f32x4& a, const f32x4& b) {
    u32x4 w; w.x = cvt_pk_bf16(a[0], a[1]); w.y = cvt_pk_bf16(a[2], a[3]); w.z = cvt_pk_bf16(b[0], b[1]); w.w = cvt_pk_bf16(b[2], b[3]);
#if 1
    *(u32x4*)((rs + (size_t)(unsigned)soff) + (unsigned)voff) = w;
#else
    __builtin_amdgcn_raw_buffer_store_b128(w, rs, voff, soff, 0);
#endif
}
__device__ __forceinline__ float silu1(float x) { return x * __builtin_amdgcn_rcpf(1.f + __builtin_amdgcn_exp2f(-1.4426950408889634f * x)); }
__device__ __forceinline__ float sigm1(float x) { return __builtin_amdgcn_rcpf(1.f + __builtin_amdgcn_exp2f(-1.4426950408889634f * x)); }
__device__ __forceinline__ float logsig1(float x) {
    const float e = __builtin_amdgcn_exp2f(-1.4426950408889634f * __builtin_fabsf(x));
    return fminf(x, 0.f) - 0.6931471805599453f * __builtin_amdgcn_logf(1.f + e);
}
#if 1
#define ST1(so) (*(float*)((rs + (size_t)(unsigned)(so)) + (unsigned)voff) = lf)
#else
#define ST1(so) __builtin_amdgcn_raw_buffer_store_b32(__float_as_uint(lf), rs, voff, (so), 0)
#endif
#ifndef EPIZ_SECS
#define EPIZ_SECS 31
#endif
struct EpiZ {
    static constexpr bool PERM = true, AFTER_DRAIN = false;
    unsigned char* ws; const float* b_forget;
    __device__ __forceinline__ void operator()(const f32x4 (&acc)[2][2][4][2], const Unit& u, int wr, int wc, int fr, int fq) const {
        int fr_ = fr, fq_ = fq; asm volatile("" : "+v"(fr_), "+v"(fq_));
        body(acc, u, wr, wc, fr_, fq_);
    }
    __device__ __forceinline__ void body(const f32x4 (&acc)[2][2][4][2], const Unit& u, int wr, int wc, int fr, int fq) const {
        const int pn = u.pn, pm = u.pm;
        const bool meta_tile = (pm == MTOK / 256);
        const int b = pm >> 5;
        const int tu0 = (pm & 31) * 256 + wr * 64;
        if (pn < 24) {
            const int sec = pn >> 3, hb = (pn & 7) * 2;
            if (!(EPIZ_SECS & 1)) return;
            if (meta_tile && (sec == 0 || wr != 0)) return;
            const int rows_per = sec == 0 ? SEQ : SKV, roff = sec == 0 ? 0 : 64;
            const rsrc_t rs = mk_rsrc(ws + (sec == 0 ? WS_QA : (sec == 1 ? WS_KA : WS_VA)), (unsigned)(NB * NH) * rows_per * HD * 2);
            const int voff = (fr * HD + 8 * fq) * 2;
            if (!meta_tile) {
#pragma unroll
                for (int ai = 0; ai < 2; ++ai)
#pragma unroll
                    for (int m = 0; m < 4; ++m)
#pragma unroll
                        for (int bj = 0; bj < 2; ++bj)
                            st8b(rs, voff, (((b * NH + hb + bj) * rows_per + roff + tu0 + ai * 128 + m * 16) * HD + wc * 32) * 2, acc[ai][bj][m][0], acc[ai][bj][m][1]);
            } else {
#pragma unroll
                for (int bj = 0; bj < 2; ++bj)
#pragma unroll
                    for (int bb = 0; bb < NB; ++bb) st8b(rs, voff, (((bb * NH + hb + bj) * rows_per + 48) * HD + wc * 32) * 2, acc[0][bj][0][0], acc[0][bj][0][1]);
            }
        } else if (pn < 40) {
            const bool isk = pn >= 32; const int hb = ((pn - 24) & 7) * 2;
            if (!(EPIZ_SECS & 2)) return;
            if (meta_tile && (!isk || wr != 0)) return;
            const rsrc_t rs = mk_rsrc(ws + (isk ? WS_KR : WS_QR), (unsigned)(NB * NH) * LR * HD * 2);
            const float sc = isk ? 0.08838834764831845f : 1.f;
            const int voff = (fr * HD + 8 * fq) * 2;
            double rr[4];
#pragma unroll
            for (int p = 0; p < 4; ++p) rr[p] = ROT_REV[wc * 16 + 4 * fq + p];
#pragma unroll
            for (int ai = 0; ai < 2; ++ai)
#pragma unroll
                for (int m = 0; m < 4; ++m) {
                    if (meta_tile && (ai != 0 || m != 0)) continue;
                    const int pos = meta_tile ? fr : (NMETA + tu0 + ai * 128 + m * 16 + fr);
                    float cs[4], sn[4];
#pragma unroll
                    for (int p = 0; p < 4; ++p) { double rv = (double)pos * rr[p]; rv -= __builtin_floor(rv); const float rf = (float)rv; sn[p] = __builtin_amdgcn_sinf(rf) * sc; cs[p] = __builtin_amdgcn_cosf(rf) * sc; }
#pragma unroll
                    for (int bj = 0; bj < 2; ++bj) {
                        const f32x4 a = acc[ai][bj][m][0], c = acc[ai][bj][m][1];
                        f32x4 oa, oc;
                        oa[0] = a[0] * cs[0] - a[1] * sn[0]; oa[1] = a[0] * sn[0] + a[1] * cs[0];
                        oa[2] = a[2] * cs[1] - a[3] * sn[1]; oa[3] = a[2] * sn[1] + a[3] * cs[1];
                        oc[0] = c[0] * cs[2] - c[1] * sn[2]; oc[1] = c[0] * sn[2] + c[1] * cs[2];
                        oc[2] = c[2] * cs[3] - c[3] * sn[3]; oc[3] = c[2] * sn[3] + c[3] * cs[3];
                        if (!meta_tile) st8b(rs, voff, (((b * NH + hb + bj) * LR + 128 + tu0 + ai * 128 + m * 16) * HD + wc * 32) * 2, oa, oc);
                        else {
#pragma unroll
                            for (int bb = 0; bb < NB; ++bb) st8b(rs, voff, (((bb * NH + hb + bj) * LR + 112) * HD + wc * 32) * 2, oa, oc);
                        }
                    }
                    __builtin_amdgcn_sched_barrier(0);
                }
        } else if (pn < 56) {
            const int h = pn - 40;
            if (!(EPIZ_SECS & 4)) return;
            if (meta_tile && wr != 0) return;
            const rsrc_t rs = mk_rsrc(ws + WS_VR, (unsigned)(NB * NH) * LR * RDV * 2);
            const int voff = (fr * RDV + 8 * fq) * 2;
            if (!meta_tile) {
#pragma unroll
                for (int ai = 0; ai < 2; ++ai)
#pragma unroll
                    for (int m = 0; m < 4; ++m)
#pragma unroll
                        for (int bj = 0; bj < 2; ++bj)
                            st8b(rs, voff, (((b * NH + h) * LR + 128 + tu0 + ai * 128 + m * 16) * RDV + bj * 128 + wc * 32) * 2, acc[ai][bj][m][0], acc[ai][bj][m][1]);
            } else {
#pragma unroll
                for (int bj = 0; bj < 2; ++bj)
#pragma unroll
                    for (int bb = 0; bb < NB; ++bb) st8b(rs, voff, (((bb * NH + h) * LR + 112) * RDV + bj * 128 + wc * 32) * 2, acc[0][bj][0][0], acc[0][bj][0][1]);
            }
        } else if (pn < 104) {
            if (meta_tile || !(EPIZ_SECS & 8)) return;
            const int sec = (pn - 56) >> 4;
            const rsrc_t rs = mk_rsrc(ws + (sec == 0 ? WS_GR : (sec == 1 ? WS_GA : WS_GT)), (unsigned)MTOK * DM * 2);
            const int voff = (fr * DM + 8 * fq) * 2, c0 = ((pn - 56) & 15) * 256 + wc * 32;
#pragma unroll
            for (int ai = 0; ai < 2; ++ai)
#pragma unroll
                for (int m = 0; m < 4; ++m) {
#pragma unroll
                    for (int bj = 0; bj < 2; ++bj) { f32x4 a = acc[ai][bj][m][0], c = acc[ai][bj][m][1];
                        if (sec == 0) {
#pragma unroll
                            for (int k = 0; k < 4; ++k) { a[k] = silu1(a[k]); c[k] = silu1(c[k]); }
                        } else {
#pragma unroll
                            for (int k = 0; k < 4; ++k) { a[k] = sigm1(a[k]); c[k] = sigm1(c[k]); }
                        }
                        st8b(rs, voff, ((pm * 256 + wr * 64 + ai * 128 + m * 16) * DM + c0 + bj * 128) * 2, a, c); }
                    __builtin_amdgcn_sched_barrier(0);
                }
        } else {
            if (!(EPIZ_SECS & 16)) return;
            if (wc != 0 || fq >= 2 || (meta_tile && wr != 0)) return;
            const rsrc_t rs = mk_rsrc(ws + WS_CUM, (unsigned)(NB * NH) * SKV * 4);
            const f32x4 b0 = *(const f32x4*)(b_forget + 8 * fq), b1 = *(const f32x4*)(b_forget + 8 * fq + 4);
            const int voff = (8 * fq * SKV + fr) * 4;
#pragma unroll
            for (int ai = 0; ai < 2; ++ai)
#pragma unroll
                for (int m = 0; m < 4; ++m) {
                    if (meta_tile && (ai != 0 || m != 0)) continue;
                    const f32x4 a = acc[ai][0][m][0] + b0, c = acc[ai][0][m][1] + b1;
#pragma unroll
                    for (int k = 0; k < 8; ++k) { const float lf = logsig1(k < 4 ? a[k] : c[k - 4]);
                        if (!meta_tile) ST1(((b * NH + k) * SKV + 64 + tu0 + ai * 128 + m * 16) * 4);
                        else { ST1(((0 * NH + k) * SKV + 48) * 4); ST1(((1 * NH + k) * SKV + 48) * 4); } }
                }
        }
    }
};
}
namespace pg8 {
__device__ __forceinline__ void unpack8(const u32x4 w, float (&f)[8]) {
    f[0] = __uint_as_float(w.x << 16); f[1] = __uint_as_float(w.x & 0xffff0000u); f[2] = __uint_as_float(w.y << 16); f[3] = __uint_as_float(w.y & 0xffff0000u);
    f[4] = __uint_as_float(w.z << 16); f[5] = __uint_as_float(w.z & 0xffff0000u); f[6] = __uint_as_float(w.w << 16); f[7] = __uint_as_float(w.w & 0xffff0000u);
}
template <int MODE> struct EpiGate {
    static constexpr bool PERM = true, AFTER_DRAIN = false;
    bf16_t* O; const bf16_t* G; int ldc;
    __device__ __forceinline__ void operator()(const f32x4 (&acc)[2][2][4][2], const Unit& u, int wr, int wc, int fr, int fq) const {
        const int row0 = u.pm * BM + wr * 64 + fr, col0 = u.pn * BM + wc * 32 + 8 * fq;
#pragma unroll
        for (int ai = 0; ai < 2; ++ai)
#pragma unroll
            for (int m = 0; m < 4; ++m) { const size_t off = (size_t)(row0 + ai * HALF + m * 16) * ldc + col0;
#pragma unroll
                for (int bj = 0; bj < 2; ++bj) { f32x4 v0 = acc[ai][bj][m][0], v1 = acc[ai][bj][m][1];
                    if (MODE != 2) { float g[8]; unpack8(*(const u32x4*)(G + off + bj * HALF), g);
                        v0[0] *= g[0]; v0[1] *= g[1]; v0[2] *= g[2]; v0[3] *= g[3]; v1[0] *= g[4]; v1[1] *= g[5]; v1[2] *= g[6]; v1[3] *= g[7]; }
                    if (MODE == 1) { float t[8]; unpack8(*(const u32x4*)(O + off + bj * HALF), t);
                        v0[0] += t[0]; v0[1] += t[1]; v0[2] += t[2]; v0[3] += t[3]; v1[0] += t[4]; v1[1] += t[5]; v1[2] += t[6]; v1[3] += t[7]; }
                    u32x4 w; w.x = cvt_pk_bf16(v0[0], v0[1]); w.y = cvt_pk_bf16(v0[2], v0[3]); w.z = cvt_pk_bf16(v1[0], v1[1]); w.w = cvt_pk_bf16(v1[2], v1[3]);
                    *(u32x4*)(O + off + bj * HALF) = w; } }
    }
};
struct EpiResF32 {
    static constexpr bool PERM = false, AFTER_DRAIN = false;
    const float* base; float* out; int ldc;
    __device__ __forceinline__ void operator()(const f32x4 (&acc)[2][2][4][2], const Unit& u, int wr, int wc, int fr, int fq) const {
        const int row0 = u.pm * BM + wr * 64 + fr, col0 = u.pn * BM + wc * 32 + 4 * fq;
#pragma unroll
        for (int ai = 0; ai < 2; ++ai)
#pragma unroll
            for (int m = 0; m < 4; ++m) { const size_t off = (size_t)(row0 + ai * HALF + m * 16) * ldc + col0;
#pragma unroll
                for (int bj = 0; bj < 2; ++bj)
#pragma unroll
                    for (int n = 0; n < 2; ++n) { const f32x4 bs = *(const f32x4*)(base + off + bj * HALF + n * 16); *(f32x4*)(out + off + bj * HALF + n * 16) = bs + acc[ai][bj][m][n]; } }
    }
};
}
namespace pg8 {
template <class Epi, class Sched, bool ALIGN_EPI = false, bool SP2 = false>
__device__ __forceinline__ void gemm_phase(PG8_LAS unsigned char* lds, const Gemm g, const Sched& S, const Epi& E) {
    const int tid = threadIdx.x, wid = __builtin_amdgcn_readfirstlane(tid >> 6), lane = tid & 63, wr = wid >> 2, wc = wid & 3, fr = lane & 15, fq = lane >> 4;
    const int K = g.K, nt = K / BK;
    unsigned voffA[2], voffB[2];
#pragma unroll
    for (int i = 0; i < 2; ++i) { int R, C; stage_rc(tid * 16 + i * 8192, R, C); const int Rb = Epi::PERM ? ((R & ~31) + perm32(R & 31)) : R;
        voffA[i] = (unsigned)(R * K + C) * 2u; voffB[i] = (unsigned)(Rb * K + C) * 2u; }
    const size_t kstep = (size_t)(BK * 2);
    const size_t hstep = (size_t)HALF * K * 2;
    const size_t tstep = 2 * hstep;
    const unsigned ldsw = (unsigned)wid * 1024u;
    const int aoff = lds_byte(wr * 64 + fr, fq * 8), boff = lds_byte(wc * 32 + fr, fq * 8);
#define PG8_SA(b, h) (((b) * 2 + (h)) * HTB)
#define PG8_SB(b, h) ((4 + (b) * 2 + (h)) * HTB)
#define PG8_STAGE(bufoff, gbase, voff) do { _Pragma("unroll") for (int _i = 0; _i < 2; ++_i) \
        __builtin_amdgcn_global_load_lds((const unsigned*)((const char*)(gbase) + (voff)[_i]), (PG8_LAS unsigned*)(lds + (bufoff) + ldsw + _i * 8192), 16, 0, 0); } while (0)
#define PG8_LDA(dst, b, h) do { _Pragma("unroll") for (int m = 0; m < 4; ++m) _Pragma("unroll") for (int k = 0; k < 2; ++k) dst[m][k] = *(const PG8_LAS bf16x8*)(lds + PG8_SA(b, h) + aoff + m * 2048 + k * 1024); } while (0)
#define PG8_LDB(dst, b, h) do { _Pragma("unroll") for (int n = 0; n < 2; ++n) _Pragma("unroll") for (int k = 0; k < 2; ++k) dst[n][k] = *(const PG8_LAS bf16x8*)(lds + PG8_SB(b, h) + boff + n * 2048 + k * 1024); } while (0)
#define PG8_MMA(ai, bj, At, Bt) do { __builtin_amdgcn_s_setprio(1); _Pragma("unroll") for (int m = 0; m < 4; ++m) _Pragma("unroll") for (int n = 0; n < 2; ++n) _Pragma("unroll") for (int k = 0; k < 2; ++k) \
        acc[ai][bj][m][n] = __builtin_amdgcn_mfma_f32_16x16x32_bf16(Bt[n][k], At[m][k], acc[ai][bj][m][n], 0, 0, 0); __builtin_amdgcn_s_setprio(0); } while (0)
#define PG8_WAIT_V(n) asm volatile("s_waitcnt vmcnt(" #n ")" ::: "memory")
#define PG8_WAIT_L(n) asm volatile("s_waitcnt lgkmcnt(" #n ")" ::: "memory")
#define PG8_BAR __builtin_amdgcn_s_barrier()
#define PG8_SCHED __builtin_amdgcn_sched_barrier(0)
    Unit cur, nxt; int ui = 0;
    if (!S.next(0, cur)) return;
    f32x4 acc[2][2][4][2];
#pragma unroll
    for (int a = 0; a < 2; ++a)
#pragma unroll
        for (int b = 0; b < 2; ++b)
#pragma unroll
            for (int m = 0; m < 4; ++m)
#pragma unroll
                for (int n = 0; n < 2; ++n) acc[a][b][m][n] = (f32x4){0.f, 0.f, 0.f, 0.f};
    bf16x8 At[4][2], B0[2][2], B1[2][2];
    const char* cA = (const char*)g.A + (size_t)cur.pm * tstep; const char* cB = (const char*)g.Bt + (size_t)cur.pn * tstep;
    S.a_ready(cur);
    if constexpr (SP2) {
        PG8_STAGE(PG8_SB(0, 0), cB, voffB); PG8_STAGE(PG8_SB(0, 1), cB + hstep, voffB); PG8_STAGE(PG8_SA(0, 0), cA, voffA); PG8_STAGE(PG8_SA(0, 1), cA + hstep, voffA);
        if (wr == 1) PG8_BAR;
        PG8_WAIT_V(2); PG8_BAR;
        PG8_STAGE(PG8_SB(1, 0), cB + kstep, voffB); PG8_STAGE(PG8_SA(1, 0), cA + kstep, voffA); PG8_STAGE(PG8_SB(1, 1), cB + hstep + kstep, voffB);
        PG8_WAIT_V(6); PG8_BAR;
    } else {
        PG8_STAGE(PG8_SB(0, 0), cB, voffB); PG8_STAGE(PG8_SA(0, 0), cA, voffA); PG8_STAGE(PG8_SB(0, 1), cB + hstep, voffB); PG8_STAGE(PG8_SA(0, 1), cA + hstep, voffA);
        if (wr == 1) PG8_BAR;
        PG8_WAIT_V(4); PG8_BAR;
        PG8_STAGE(PG8_SB(1, 0), cB + kstep, voffB); PG8_STAGE(PG8_SA(1, 0), cA + kstep, voffA); PG8_STAGE(PG8_SB(1, 1), cB + hstep + kstep, voffB);
        PG8_WAIT_V(6); PG8_BAR;
    }
    for (;;) {
        const bool has_next = S.next(ui + 1, nxt);
        const char* nA = has_next ? (const char*)g.A + (size_t)nxt.pm * tstep : cA; const char* nB = has_next ? (const char*)g.Bt + (size_t)nxt.pn * tstep : cB;
        for (int t = 0; t < nt; t += 2) {
            const bool last = (t == nt - 2);
            const char* a1 = cA + (size_t)(t + 1) * kstep;
            const char* a2 = last ? nA : cA + (size_t)(t + 2) * kstep; const char* b2 = last ? nB : cB + (size_t)(t + 2) * kstep;
            const char* a3 = a2 + kstep; const char* b3 = b2 + kstep;
            if (last && has_next) S.a_ready(nxt);
            if constexpr (SP2) {
            PG8_LDB(B0, 0, 0); PG8_LDB(B1, 0, 1); PG8_SCHED; PG8_LDA(At, 0, 0); PG8_STAGE(PG8_SA(1, 1), a1 + hstep, voffA);
            PG8_WAIT_V(8); PG8_WAIT_L(0); PG8_BAR; PG8_MMA(0, 0, At, B0); PG8_MMA(0, 1, At, B1); PG8_BAR; PG8_SCHED;
            PG8_LDA(At, 0, 1); PG8_STAGE(PG8_SB(0, 0), b2, voffB); PG8_STAGE(PG8_SB(0, 1), b2 + hstep, voffB); PG8_STAGE(PG8_SA(0, 0), a2, voffA);
            PG8_WAIT_V(8); PG8_WAIT_L(0); PG8_BAR; PG8_MMA(1, 0, At, B0); PG8_MMA(1, 1, At, B1); PG8_BAR; PG8_SCHED;
            PG8_LDB(B0, 1, 0); PG8_LDB(B1, 1, 1); PG8_SCHED; PG8_LDA(At, 1, 0); PG8_STAGE(PG8_SA(0, 1), a2 + hstep, voffA);
            PG8_WAIT_V(8); PG8_WAIT_L(0); PG8_BAR; PG8_MMA(0, 0, At, B0); PG8_MMA(0, 1, At, B1); PG8_BAR; PG8_SCHED;
            PG8_LDA(At, 1, 1); PG8_STAGE(PG8_SB(1, 0), b3, voffB); PG8_STAGE(PG8_SB(1, 1), b3 + hstep, voffB); PG8_STAGE(PG8_SA(1, 0), a3, voffA);
            PG8_WAIT_V(8); PG8_WAIT_L(0); PG8_BAR; PG8_MMA(1, 0, At, B0); PG8_MMA(1, 1, At, B1); PG8_BAR; PG8_SCHED;
            } else {
            PG8_LDB(B0, 0, 0); PG8_SCHED; PG8_LDA(At, 0, 0); PG8_STAGE(PG8_SA(1, 1), a1 + hstep, voffA);
            PG8_WAIT_L(8); PG8_BAR; PG8_WAIT_L(0); PG8_MMA(0, 0, At, B0); PG8_BAR; PG8_SCHED;
            PG8_LDB(B1, 0, 1); PG8_STAGE(PG8_SB(0, 0), b2, voffB);
            PG8_BAR; PG8_WAIT_L(0); PG8_MMA(0, 1, At, B1); PG8_BAR;
            PG8_LDA(At, 0, 1); PG8_STAGE(PG8_SA(0, 0), a2, voffA);
            PG8_BAR; PG8_WAIT_L(0); PG8_MMA(1, 0, At, B0); PG8_BAR; PG8_SCHED;
            PG8_STAGE(PG8_SB(0, 1), b2 + hstep, voffB);
            PG8_WAIT_V(6); PG8_BAR; PG8_MMA(1, 1, At, B1); PG8_BAR;
            PG8_LDB(B0, 1, 0); PG8_SCHED; PG8_LDA(At, 1, 0); PG8_STAGE(PG8_SA(0, 1), a2 + hstep, voffA);
            PG8_WAIT_L(8); PG8_BAR; PG8_WAIT_L(0); PG8_MMA(0, 0, At, B0); PG8_BAR; PG8_SCHED;
            PG8_LDB(B1, 1, 1); PG8_STAGE(PG8_SB(1, 0), b3, voffB);
            PG8_BAR; PG8_WAIT_L(0); PG8_MMA(0, 1, At, B1); PG8_BAR;
            PG8_LDA(At, 1, 1); PG8_STAGE(PG8_SA(1, 0), a3, voffA);
            PG8_BAR; PG8_WAIT_L(0); PG8_MMA(1, 0, At, B0); PG8_BAR; PG8_SCHED;
            PG8_STAGE(PG8_SB(1, 1), b3 + hstep, voffB);
            PG8_WAIT_V(6); PG8_BAR; PG8_MMA(1, 1, At, B1); PG8_BAR;
            }
        }
        if constexpr (ALIGN_EPI) { if (wr == 0) PG8_BAR; }
        if constexpr (!Epi::AFTER_DRAIN) { E(acc, cur, wr, wc, fr, fq); S.done(cur); }
        if (!has_next) break;
#pragma unroll
        for (int a = 0; a < 2; ++a)
#pragma unroll
            for (int b = 0; b < 2; ++b)
#pragma unroll
                for (int m = 0; m < 4; ++m)
#pragma unroll
                    for (int n = 0; n < 2; ++n) acc[a][b][m][n] = (f32x4){0.f, 0.f, 0.f, 0.f};
        cur = nxt; cA = nA; cB = nB; ++ui;
        if constexpr (ALIGN_EPI) { if (wr == 1) PG8_BAR; }
    }
    PG8_WAIT_V(0);
    if constexpr (!ALIGN_EPI) { if (wr == 0) PG8_BAR; }
    PG8_BAR;
    if constexpr (Epi::AFTER_DRAIN) { E.fused(acc, cur, wr, wc, fr, fq, lds, wid, lane); S.done(cur); }
#undef PG8_SA
#undef PG8_SB
#undef PG8_STAGE
#undef PG8_LDA
#undef PG8_LDB
#undef PG8_MMA
#undef PG8_WAIT_V
#undef PG8_WAIT_L
#undef PG8_BAR
#undef PG8_SCHED
}
}
#define XB_TMO      128
#define XB_XCNT(j)  (256  + 64 * (j))
#define XB_XSUB(j)  (1280 + 64 * (j))
#define XB_XGEN(j)  (2304 + 64 * (j))
#define XB_TOP      3328
#define XB_TOPGEN   3392
#define XCD_BAR_WORDS 3456
#define XB_SPIN_CAP (1u << 22)

__device__ __forceinline__ unsigned xb_ld(unsigned* p)              { return __hip_atomic_load(p, __ATOMIC_RELAXED, __HIP_MEMORY_SCOPE_AGENT); }
__device__ __forceinline__ unsigned xb_add(unsigned* p, unsigned v) { return __hip_atomic_fetch_add(p, v, __ATOMIC_RELAXED, __HIP_MEMORY_SCOPE_AGENT); }
__device__ __forceinline__ unsigned xb_xcc_id() { return (unsigned)__builtin_amdgcn_s_getreg((3 << 11) | 20) & 0xFu; }
#define XB_SPIN(cond, bar) do { unsigned _sp = 0; while (cond) { __builtin_amdgcn_s_sleep(1); \
    if ((++_sp & 255u) == 0u) { if (xb_ld(&(bar)[XB_TMO])) break; if (_sp > XB_SPIN_CAP) { atomicAdd(&(bar)[XB_TMO], 1u); break; } } } } while (0)

struct XcdBarrier {
    unsigned* bar; unsigned x;
    volatile LAS unsigned* st;
};

__device__ __forceinline__ XcdBarrier xcd_barrier_post(unsigned* bar, volatile LAS unsigned* st) {
    XcdBarrier b; b.bar = bar; b.x = xb_xcc_id(); b.st = st;
    if (threadIdx.x == 0) (void)xb_add(&bar[XB_XCNT(b.x)], 1u);
    return b;
}
__device__ __forceinline__ void xcd_barrier_complete(unsigned* bar, unsigned x, unsigned& nloc, unsigned& nx) {
    const unsigned G = gridDim.x * gridDim.y * gridDim.z;
    unsigned sum, cnt, mine, sp = 0u;
    for (;;) {
        sum = 0u; cnt = 0u; mine = 0u;
#pragma unroll
        for (unsigned j = 0; j < 16; ++j) { const unsigned c = xb_ld(&bar[XB_XCNT(j)]); sum += c; cnt += (c > 0u) ? 1u : 0u; mine = (j == x) ? c : mine; }
        if (sum == G) break;
        __builtin_amdgcn_s_sleep(1);
        if ((++sp & 255u) == 0u) { if (xb_ld(&bar[XB_TMO])) break; if (sp > XB_SPIN_CAP) { atomicAdd(&bar[XB_TMO], 1u); break; } }
    }
    nloc = mine > 0u ? mine : 1u; nx = cnt > 0u ? cnt : 1u;
}

__device__ __forceinline__ void xcd_barrier(const XcdBarrier& b) {
    asm volatile("s_waitcnt vmcnt(0)" ::: "memory");
    __syncthreads();
    if (threadIdx.x == 0) {
        unsigned* bar = b.bar;
        __builtin_amdgcn_s_waitcnt(0);
        unsigned nloc = b.st[0], nx = b.st[1];
        if (nloc == 0u) { xcd_barrier_complete(bar, b.x, nloc, nx); b.st[0] = nloc; b.st[1] = nx; }
        const unsigned old = xb_add(&bar[XB_XSUB(b.x)], 1u);
        const unsigned gen = old / nloc;
        if (old + 1u == (gen + 1u) * nloc) {
            __builtin_amdgcn_fence(__ATOMIC_RELEASE, "agent");
            asm volatile("s_waitcnt vmcnt(0)" ::: "memory");
            const unsigned og = xb_add(&bar[XB_TOP], 1u);
            const unsigned tg = og / nx;
            if (og + 1u == (tg + 1u) * nx) xb_add(&bar[XB_TOPGEN], 1u);
            else XB_SPIN(xb_ld(&bar[XB_TOPGEN]) == tg, bar);
            __builtin_amdgcn_fence(__ATOMIC_ACQUIRE, "agent");
            xb_add(&bar[XB_XGEN(b.x)], 1u);
            asm volatile("s_waitcnt vmcnt(0)" ::: "memory");
        } else {
            XB_SPIN(xb_ld(&bar[XB_XGEN(b.x)]) == gen, bar);
            __builtin_amdgcn_fence(__ATOMIC_ACQUIRE, "agent");
            asm volatile("s_waitcnt vmcnt(0)" ::: "memory");
        }
    }
    __syncthreads();
}
struct Frame {
    LAS unsigned char* lds;
    volatile LAS unsigned* MISC;
    gu32* ctl;
    int tid, lane, wave;
    int vcu, G;
    unsigned char* ws;
    const float *x, *meta, *g_mix, *w_in, *b_forget, *g_q, *g_k, *g_ret, *w_fox, *w_ret, *w_out, *g_ffn, *w_q, *keys1, *keys2, *pu, *pv;
    float* out;
};
template <class T> __device__ __forceinline__ T* wsp(const Frame& F, size_t off) { return (T*)(F.ws + off); }

__device__ __forceinline__ int z_src_col(int n) {
    if (n < Z_QR) return n;
    if (n < Z_VR) { const int np = n - Z_QR, j = np & 127, base = np - j; return 6160 + base + ((j & 1) ? 64 + (j >> 1) : (j >> 1)); }
    if (n < Z_F) return n + 16;
    if (n < Z_F + 16) return 6144 + (n - Z_F);
    return -1;
}
template <bool ZMAP>
__device__ __forceinline__ void p0_transpose_item(const float* W, int K, int Nsrc, int Ndst, bf16* WT, LAS float* scr, int item, int lane) {
    const int nblk = Ndst / 32, kb = item / nblk, nb = item % nblk, k0 = 64 * kb, n0 = 32 * nb;
    const int sc = ZMAP ? z_src_col(n0 + (lane & 31)) : (n0 + (lane & 31));
#pragma unroll 8
    for (int i = 0; i < 32; ++i) { const int kk = 2 * i + (lane >> 5); scr[kk * 33 + (lane & 31)] = (sc >= 0) ? W[(size_t)(k0 + kk) * Nsrc + sc] : 0.f; }
    LDS_WAIT(); asm volatile("" ::: "memory");
    const int c = lane & 7;
#pragma unroll
    for (int j = 0; j < 4; ++j) { const int n = (lane >> 3) + 8 * j; const LAS float* s = scr + (8 * c) * 33 + n;
        v4u o; o.x = pk2(s[0 * 33], s[1 * 33]); o.y = pk2(s[2 * 33], s[3 * 33]); o.z = pk2(s[4 * 33], s[5 * 33]); o.w = pk2(s[6 * 33], s[7 * 33]);
        *(GAS v4u*)(WT + (size_t)(n0 + n) * K + k0 + 8 * c) = o; }
    LDS_WAIT(); asm volatile("" ::: "memory");
}
__device__ __forceinline__ void rms_row_to_bf16(const float* xrow, const float* g, bf16* orow, int lane) {
    const GAS f32x4* xr = (const GAS f32x4*)xrow + lane;
    f32x4 v[16]; float s = 0.f;
#pragma unroll
    for (int j = 0; j < 16; ++j) { v[j] = xr[64 * j]; s += (v[j].x * v[j].x + v[j].y * v[j].y) + (v[j].z * v[j].z + v[j].w * v[j].w); }
    const float r = 1.f / sqrtf(wave_sum(s) * (1.f / DM) + EPS);
    const GAS f32x4* gr = (const GAS f32x4*)g + lane;
    GAS v2u* o8 = (GAS v2u*)orow + lane;
#pragma unroll
    for (int j = 0; j < 16; ++j) { const f32x4 gg = gr[64 * j]; v2u w; w.x = pk2(v[j].x * r * gg.x, v[j].y * r * gg.y); w.y = pk2(v[j].z * r * gg.z, v[j].w * r * gg.w); o8[64 * j] = w; }
}
__device__ __forceinline__ void zero_bytes16(unsigned char* p, size_t n16, int gt, int NT) {
    const v4u z = {0u, 0u, 0u, 0u};
    for (size_t i = gt; i < n16; i += NT) ((GAS v4u*)p)[i] = z;
}
__device__ __forceinline__ void p0_prologue(Frame& F) {
    LAS float* scr = (LAS float*)(F.lds + RING_OFF + F.wave * 16384);
    const int gw = F.vcu * 8 + F.wave, NGW = F.G * 8;
    bf16* WZ = wsp<bf16>(F, WS_WZ); bf16* WFOX = wsp<bf16>(F, WS_WFOX); bf16* WRET = wsp<bf16>(F, WS_WRET); bf16* WOUT = wsp<bf16>(F, WS_WOUT); bf16* WQ = wsp<bf16>(F, WS_WQ);
    constexpr int I_Z = (DM / 64) * (NZ / 32), I_FOX = (2048 / 64) * (DM / 32), I_RET = (DM / 64) * (DM / 32), I_OUT = I_RET, I_Q = (DM / 64) * (PQ / 32);
    constexpr int NITEMS = I_Z + I_FOX + I_RET + I_OUT + I_Q;
    for (int it = gw; it < NITEMS; it += NGW) {
        int r = it;
        if (r < I_Z) { p0_transpose_item<true>(F.w_in, DM, 26640, NZ, WZ, scr, r, F.lane); continue; } r -= I_Z;
        if (r < I_FOX) { p0_transpose_item<false>(F.w_fox, 2048, DM, DM, WFOX, scr, r, F.lane); continue; } r -= I_FOX;
        if (r < I_RET) { p0_transpose_item<false>(F.w_ret, DM, DM, DM, WRET, scr, r, F.lane); continue; } r -= I_RET;
        if (r < I_OUT) { p0_transpose_item<false>(F.w_out, DM, DM, DM, WOUT, scr, r, F.lane); continue; } r -= I_OUT;
        p0_transpose_item<false>(F.w_q, DM, PQ, PQ, WQ, scr, r, F.lane);
    }
    bf16* UX = wsp<bf16>(F, WS_UX);
    for (int m = gw; m < MTOK + NMETA; m += NGW) {
        const float* src = (m < MTOK) ? F.x + (size_t)m * DM : F.meta + (size_t)(m - MTOK) * DM;
        rms_row_to_bf16(src, F.g_mix, UX + (size_t)m * DM, F.lane);
    }
    const int gt = F.vcu * 512 + F.tid, NT = F.G * 512;
    zero_bytes16((unsigned char*)(UX + (size_t)(MTOK + NMETA) * DM), (size_t)(256 - NMETA) * DM * 2 / 16, gt, NT);
    { bf16* KB = wsp<bf16>(F, WS_KEYS); constexpr int NKE = PH * PK * PK;
      for (int i = gt; i < 2 * NKE / 4; i += NT) { const float* s = (i < NKE / 4) ? F.keys1 + 4 * (size_t)i : F.keys2 + 4 * (size_t)(i - NKE / 4); const f32x4 v = *(const GAS f32x4*)s;
          v2u w; w.x = pk2(v.x, v.y); w.y = pk2(v.z, v.w); *(GAS v2u*)(KB + 4 * (size_t)i) = w; } }
    for (int bh = 0; bh < NB * NH; ++bh) {
        zero_bytes16((unsigned char*)(wsp<bf16>(F, WS_KA) + (size_t)bh * SKV * HD), 48 * HD * 2 / 16, gt, NT);
        zero_bytes16((unsigned char*)(wsp<bf16>(F, WS_VA) + (size_t)bh * SKV * HD), 48 * HD * 2 / 16, gt, NT);
        zero_bytes16((unsigned char*)(wsp<bf16>(F, WS_KR) + (size_t)bh * LR * HD), 112 * HD * 2 / 16, gt, NT);
        zero_bytes16((unsigned char*)(wsp<bf16>(F, WS_VR) + (size_t)bh * LR * RDV), 112 * RDV * 2 / 16, gt, NT);
    }
}
typedef short v4i16_t __attribute__((ext_vector_type(4)));
__device__ __forceinline__ int v_st(int k, int c) { const int kk = (k & ~0xC) | ((k & 4) << 1) | ((k & 8) >> 1); return ((kk >> 3) * 4 + (c >> 5)) * 512 + ((kk & 7) * 32 + (c & 31)) * 2; }
__device__ __forceinline__ int v_rd_base(int lane) { return ((lane & 3) << 3) | (((lane >> 2) & 3) << 6) | (((lane >> 4) & 1) << 5) | (((lane >> 5) & 1) << 8); }
__device__ __forceinline__ s16x4 vtr(const LAS unsigned char* p) { return __builtin_bit_cast(s16x4, __builtin_amdgcn_ds_read_tr16_b64_v4i16((LAS v4i16_t*)p)); }
__device__ __forceinline__ bf16x8 tr_frag(const LAS unsigned char* p) {
    const s16x4 l = vtr(p), h = vtr(p + 2048);
    return (bf16x8){l[0], l[1], l[2], l[3], h[0], h[1], h[2], h[3]};
}
__device__ __forceinline__ int crow(int r, int hi) { return (r & 3) + 8 * (r >> 2) + 4 * hi; }
__device__ const float LG2GAM[16] = { -4.580368961e-02f, -2.272007650e-02f, -1.131531323e-02f, -5.646563141e-03f, -2.820519062e-03f, -1.409570255e-03f, -7.046129766e-04f, -3.522634716e-04f,
    -1.761209843e-04f, -8.805780458e-05f, -4.402823044e-05f, -2.201394726e-05f, -1.100693164e-05f, -5.503455325e-06f, -2.751725038e-06f, -1.375861863e-06f };

__device__ __forceinline__ void p2_cumsum(float* CUMp, int lane) {
    float carry = 0.f;
    constexpr int NIT = (SKV - 48 + 255) / 256;
    const GAS f32x4* src = (const GAS f32x4*)(CUMp + 48) + lane;
    f32x4 v = *src, vn;
    for (int it = 0; it < NIT; ++it) {
        const int j0n = 48 + (it + 1) * 256 + lane * 4;
        vn = (f32x4){0.f, 0.f, 0.f, 0.f};
        if (it + 1 < NIT && j0n < SKV) vn = src[(it + 1) * 64];
        const float p0 = v.x, p1 = p0 + v.y, p2 = p1 + v.z, p3 = p2 + v.w;
        float x = p3;
#pragma unroll
        for (int o = 1; o < 64; o <<= 1) { const float t = __shfl_up(x, o); if (lane >= o) x += t; }
        const float excl = carry + (x - p3);
        const int j0 = 48 + it * 256 + lane * 4;
        if (j0 < SKV) *((GAS f32x4*)(CUMp + j0)) = (f32x4){-(excl + p0), -(excl + p1), -(excl + p2), -(excl + p3)};
        carry += __shfl(x, 63);
        v = vn;
    }
    if (lane < 12) *((GAS f32x4*)CUMp + lane) = (f32x4){-__builtin_inff(), -__builtin_inff(), -__builtin_inff(), -__builtin_inff()};
}
__device__ __forceinline__ void p2_qknorm(Frame& F, int gw, int NGW) {
    constexpr int R_Q = NB * NH * SEQ, RK_PER = SKV - 48, R_K = NB * NH * RK_PER, NSTEP = (R_Q + R_K) / 4;
    bf16* QA = wsp<bf16>(F, WS_QA); bf16* KA = wsp<bf16>(F, WS_KA);
    const int sub = F.lane >> 4, c8 = (F.lane & 15) * 8;
    float gq[8], gk[8];
#pragma unroll
    for (int k = 0; k < 8; ++k) { gq[k] = F.g_q[c8 + k] * 0.08838834764831845f; gk[k] = F.g_k[c8 + k]; }
    for (int s0 = gw; s0 < NSTEP; s0 += 4 * NGW) {
        v4u w[4]; bf16* ptr[4]; bool isq[4], ok[4];
#pragma unroll
        for (int u = 0; u < 4; ++u) { const int s = s0 + u * NGW; ok[u] = s < NSTEP; const int r = 4 * s + sub;
            if (r < R_Q) { isq[u] = true; ptr[u] = QA + (size_t)r * HD + c8; }
            else { const int rp = r - R_Q, bh = rp / RK_PER, j = 48 + rp % RK_PER; isq[u] = false; ptr[u] = KA + ((size_t)bh * SKV + j) * HD + c8; }
            if (ok[u]) w[u] = *(const GAS v4u*)ptr[u]; else w[u] = (v4u){0u, 0u, 0u, 0u}; }
#pragma unroll
        for (int u = 0; u < 4; ++u) {
            float f[8] = {bflo(w[u].x), bfhi(w[u].x), bflo(w[u].y), bfhi(w[u].y), bflo(w[u].z), bfhi(w[u].z), bflo(w[u].w), bfhi(w[u].w)};
            float ss = 0.f;
#pragma unroll
            for (int k = 0; k < 8; ++k) ss += f[k] * f[k];
            ss += __shfl_xor(ss, 1); ss += __shfl_xor(ss, 2); ss += __shfl_xor(ss, 4); ss += __shfl_xor(ss, 8);
            const float rs = 1.f / sqrtf(ss * (1.f / HD) + EPS);
#pragma unroll
            for (int k = 0; k < 8; ++k) f[k] = f[k] * rs * (isq[u] ? gq[k] : gk[k]);
            v4u o; o.x = pk2(f[0], f[1]); o.y = pk2(f[2], f[3]); o.z = pk2(f[4], f[5]); o.w = pk2(f[6], f[7]);
            if (ok[u]) *(GAS v4u*)ptr[u] = o;
        }
    }
}
__device__ __forceinline__ void p2_kv_item(Frame& F, int item) {
    const int bh = item >> 6, n = item & 63, h = bh & (NH - 1);
    const float lg2 = LG2GAM[h];
    const bf16* Kg = wsp<bf16>(F, WS_KR) + ((size_t)bh * LR + 128 * n) * HD;
    const bf16* Vg = wsp<bf16>(F, WS_VR) + ((size_t)bh * LR + 128 * n) * RDV;
    LAS unsigned char* ldsV = F.lds; LAS unsigned char* ldsK = F.lds + 65536;
    const int sr = F.tid >> 4, sc = (F.tid & 15) * 8;
    v4u kw[4], vw[2][4];
#pragma unroll
    for (int q = 0; q < 4; ++q) { const int j = sr + 32 * q; kw[q] = *(const GAS v4u*)(Kg + (size_t)j * HD + sc);
        vw[0][q] = *(const GAS v4u*)(Vg + (size_t)j * RDV + sc); vw[1][q] = *(const GAS v4u*)(Vg + (size_t)j * RDV + 128 + sc); }
#pragma unroll
    for (int q = 0; q < 4; ++q) { const int j = sr + 32 * q; const float z = fast_exp2(lg2 * (float)(127 - j));
        v4u o; o.x = pk2(bflo(kw[q].x) * z, bfhi(kw[q].x) * z); o.y = pk2(bflo(kw[q].y) * z, bfhi(kw[q].y) * z); o.z = pk2(bflo(kw[q].z) * z, bfhi(kw[q].z) * z); o.w = pk2(bflo(kw[q].w) * z, bfhi(kw[q].w) * z);
        const int so = v_st(j & 63, sc);
        *(LAS v4u*)(ldsK + (j >> 6) * 16384 + so) = o;
        *(LAS v4u*)(ldsV + ((j >> 6) * 2 + 0) * 16384 + so) = vw[0][q];
        *(LAS v4u*)(ldsV + ((j >> 6) * 2 + 1) * 16384 + so) = vw[1][q]; }
    __syncthreads();
    const int w = F.wave, r32 = F.lane & 31, hi = F.lane >> 5;
    const LAS unsigned char* pa = ldsV + v_rd_base(F.lane) + (w >> 2) * 16384 + (w & 3) * 512;
    const LAS unsigned char* pb = ldsK + v_rd_base(F.lane);
    f32x16 acc[4] = {};
#pragma unroll
    for (int jh = 0; jh < 2; ++jh)
#pragma unroll
        for (int ks = 0; ks < 4; ++ks) {
            const bf16x8 a = tr_frag(pa + jh * 32768 + ks * 4096);
#pragma unroll
            for (int dt = 0; dt < 4; ++dt) { const bf16x8 b = tr_frag(pb + jh * 16384 + dt * 512 + ks * 4096); acc[dt] = __builtin_amdgcn_mfma_f32_32x32x16_bf16(a, b, acc[dt], 0, 0, 0); }
        }
    float* outp = wsp<float>(F, WS_KVT) + (size_t)item * (RDV * HD);
#pragma unroll
    for (int dt = 0; dt < 4; ++dt)
#pragma unroll
        for (int r = 0; r < 16; ++r) outp[(size_t)(32 * w + crow(r, hi)) * HD + 32 * dt + r32] = acc[dt][r];
    __syncthreads();
}
__device__ __forceinline__ void p2_phase(Frame& F) {
    const int gw = F.vcu * 8 + F.wave, NGW = F.G * 8;
    if (gw < NB * NH) p2_cumsum(wsp<float>(F, WS_CUM) + (size_t)gw * SKV, F.lane);
    p2_qknorm(F, gw, NGW);
    for (int item = F.vcu; item < NB * NH * NCHUNK; item += F.G) p2_kv_item(F, item);
}
__device__ __forceinline__ void p3_scan(Frame& F) {
    const int gt = F.vcu * 512 + F.tid, NT = F.G * 512;
    const float* KVT = wsp<float>(F, WS_KVT); bf16* ST = wsp<bf16>(F, WS_ST);
    for (int g = gt; g < NB * NH * 4096; g += NT) {
        const int bh = g >> 12, off = (g & 4095) * 8, h = bh & (NH - 1);
        const float cd = fast_exp2(LG2GAM[h] * 128.f);
        const float* src = KVT + (size_t)bh * NCHUNK * 32768 + off; bf16* dst = ST + (size_t)bh * NCHUNK * 32768 + off;
        float s[8] = {0.f, 0.f, 0.f, 0.f, 0.f, 0.f, 0.f, 0.f};
        for (int n0 = 0; n0 < NCHUNK; n0 += 4) {
            f32x4 a[4], b[4];
#pragma unroll
            for (int u = 0; u < 4; ++u) { a[u] = *(const GAS f32x4*)(src + (size_t)(n0 + u) * 32768); b[u] = *(const GAS f32x4*)(src + (size_t)(n0 + u) * 32768 + 4); }
#pragma unroll
            for (int u = 0; u < 4; ++u) {
#pragma unroll
                for (int k = 0; k < 4; ++k) { s[k] = s[k] * cd + a[u][k]; s[4 + k] = s[4 + k] * cd + b[u][k]; }
                v4u o; o.x = pk2(s[0], s[1]); o.y = pk2(s[2], s[3]); o.z = pk2(s[4], s[5]); o.w = pk2(s[6], s[7]);
                *(GAS v4u*)(dst + (size_t)(n0 + u) * 32768) = o; }
        }
    }
}

namespace fox {
constexpr int D = 128, NW = 8, QBLK = 32, KVBLK = 64, QB = NW * QBLK;
constexpr int SHM_V = KVBLK * D * 2, SHM_K = KVBLK * D * 2;
constexpr int LDS_ATT = 2 * SHM_V + 2 * SHM_K + NW * 64 * 4;
constexpr float THR = 8.f;
constexpr int OSTRIDE = NH * HD;
#define KSWZ(row, colB) ((row) * 256 + ((colB) ^ (((row) & 7) << 4)))
constexpr int v_rd_off(int d0, int ks, int half) { return d0 * 512 + ks * 4096 + half * 2048; }
__device__ __forceinline__ bf16x8 load8(const bf16* p) { return *reinterpret_cast<const bf16x8*>(p); }
__device__ __forceinline__ void mask_tile(f32x16& p0, f32x16& p1, int dq) {
    const float NEG = -__builtin_inff();
#pragma unroll
    for (int r = 0; r < 16; ++r) {
        const int c = (r & 3) + 8 * (r >> 2);
        if (dq - c < 0) p0[r] = NEG;
        if (dq - c - 32 < 0) p1[r] = NEG;
    }
}
__device__ __forceinline__ void partialSM(f32x16& p0, f32x16& p1, float& m_reg, float& mn, float& alpha) {
    float pmax = p0[0];
#pragma unroll
    for (int r = 1; r < 16; ++r) pmax = fmaxf(pmax, p0[r]);
#pragma unroll
    for (int r = 0; r < 16; ++r) pmax = fmaxf(pmax, p1[r]);
    { auto rr = __builtin_amdgcn_permlane32_swap(__float_as_uint(pmax), __float_as_uint(pmax), false, false);
      pmax = fmaxf(__uint_as_float(rr[0]), __uint_as_float(rr[1])); }
    constexpr float C2 = 1.4426950408889634f;
    if (__builtin_expect(__all((pmax - m_reg) <= THR), 1)) { mn = m_reg; alpha = 1.f; }
    else { mn = fmaxf(m_reg, pmax); alpha = __builtin_amdgcn_exp2f((m_reg - mn) * C2); m_reg = mn; }
    const float mnL = -mn * C2;
#pragma unroll
    for (int r = 0; r < 16; ++r) p0[r] = fmaf(p0[r], C2, mnL);
#pragma unroll
    for (int r = 0; r < 16; ++r) p1[r] = fmaf(p1[r], C2, mnL);
#pragma unroll
    for (int r = 0; r < 16; ++r) p0[r] = __builtin_amdgcn_exp2f(p0[r]);
}
__device__ __forceinline__ void finishSM(f32x16& p0, f32x16& p1, float alpha, float& l_reg, bf16x8& pa0, bf16x8& pa1, bf16x8& pa2, bf16x8& pa3) {
#pragma unroll
    for (int r = 0; r < 16; ++r) p1[r] = __builtin_amdgcn_exp2f(p1[r]);
    float ps = 0;
#pragma unroll
    for (int r = 0; r < 16; ++r) ps += p0[r];
#pragma unroll
    for (int r = 0; r < 16; ++r) ps += p1[r];
    { auto rr = __builtin_amdgcn_permlane32_swap(__float_as_uint(ps), __float_as_uint(ps), false, false);
      ps = __uint_as_float(rr[0]) + __uint_as_float(rr[1]); }
    l_reg = l_reg * alpha + ps;
#define PK4(P, B_, OUT) do { unsigned a0 = cvtpk(P[B_+0], P[B_+1]), a1 = cvtpk(P[B_+2], P[B_+3]);                          \
        unsigned b0 = cvtpk(P[B_+4], P[B_+5]), b1 = cvtpk(P[B_+6], P[B_+7]);                                             \
        auto r0 = __builtin_amdgcn_permlane32_swap(a0, b0, false, false); auto r1 = __builtin_amdgcn_permlane32_swap(a1, b1, false, false); \
        v4u w = {r0[0], r1[0], r0[1], r1[1]}; OUT = *reinterpret_cast<bf16x8*>(&w); } while (0)
    PK4(p0, 0, pa0); PK4(p0, 8, pa1); PK4(p1, 0, pa2); PK4(p1, 8, pa3);
}
__device__ __forceinline__ void load_bias(f32x16& p0, f32x16& p1, __amdgpu_buffer_rsrc_t rs, int kb, int hi) {
    const int vo = hi * 16, so = kb * 4;
#pragma unroll
    for (int g = 0; g < 4; ++g) { const v4u x = __builtin_amdgcn_raw_buffer_load_b128(rs, vo, so + 32 * g, 0), y = __builtin_amdgcn_raw_buffer_load_b128(rs, vo, so + 32 * g + 128, 0);
        p0[4 * g] = __uint_as_float(x[0]); p0[4 * g + 1] = __uint_as_float(x[1]); p0[4 * g + 2] = __uint_as_float(x[2]); p0[4 * g + 3] = __uint_as_float(x[3]);
        p1[4 * g] = __uint_as_float(y[0]); p1[4 * g + 1] = __uint_as_float(y[1]); p1[4 * g + 2] = __uint_as_float(y[2]); p1[4 * g + 3] = __uint_as_float(y[3]); }
}
template <int KB>
__device__ __forceinline__ void qkt(f32x16& p0, f32x16& p1, const char* K_lds, int r32, int hi, const bf16x8* qr) {
    const char* kb[4];
#pragma unroll
    for (int dd = 0; dd < 4; ++dd) kb[dd] = K_lds + KB * SHM_K + KSWZ(r32, (dd * 16 + hi * 8) * 2);
#pragma unroll
    for (int d0 = 0; d0 < 8; ++d0) { const char* a = kb[d0 & 3] + (d0 >> 2) * 128;
        bf16x8 b0 = *reinterpret_cast<const bf16x8*>(a);
        bf16x8 b1 = *reinterpret_cast<const bf16x8*>(a + 32 * 256);
        p0 = __builtin_amdgcn_mfma_f32_32x32x16_bf16(b0, qr[d0], p0, 0, 0, 0);
        p1 = __builtin_amdgcn_mfma_f32_32x32x16_bf16(b1, qr[d0], p1, 0, 0, 0); }
}
template <int VB>
__device__ __forceinline__ void pv_tile(f32x16* o, int vb0, bf16x8 pa0, bf16x8 pa1, bf16x8 pa2, bf16x8 pa3) {
#define TRRD(dst, off) asm volatile("ds_read_b64_tr_b16 %0, %1 offset:%2" : "=&v"(dst) : "v"(vb0), "i"(off) : "memory")
#define PV_D0(d0) do { s16x4 l0, l1, l2, l3, h0, h1, h2, h3; constexpr int b_ = VB * SHM_V + v_rd_off(d0, 0, 0); \
        TRRD(l0, b_); TRRD(h0, b_ + 2048); TRRD(l1, b_ + 4096); TRRD(h1, b_ + 6144); TRRD(l2, b_ + 8192); TRRD(h2, b_ + 10240); TRRD(l3, b_ + 12288); TRRD(h3, b_ + 14336); \
        asm volatile("s_waitcnt lgkmcnt(0)" ::: "memory"); SBAR();   \
        o[d0] = __builtin_amdgcn_mfma_f32_32x32x16_bf16(pa0, (bf16x8){l0[0], l0[1], l0[2], l0[3], h0[0], h0[1], h0[2], h0[3]}, o[d0], 0, 0, 0);   \
        o[d0] = __builtin_amdgcn_mfma_f32_32x32x16_bf16(pa1, (bf16x8){l1[0], l1[1], l1[2], l1[3], h1[0], h1[1], h1[2], h1[3]}, o[d0], 0, 0, 0);   \
        o[d0] = __builtin_amdgcn_mfma_f32_32x32x16_bf16(pa2, (bf16x8){l2[0], l2[1], l2[2], l2[3], h2[0], h2[1], h2[2], h2[3]}, o[d0], 0, 0, 0);   \
        o[d0] = __builtin_amdgcn_mfma_f32_32x32x16_bf16(pa3, (bf16x8){l3[0], l3[1], l3[2], l3[3], h3[0], h3[1], h3[2], h3[3]}, o[d0], 0, 0, 0); } while (0)
    PV_D0(0); PV_D0(1); PV_D0(2); PV_D0(3);
#undef PV_D0
#undef TRRD
}
struct BlockRef { const bf16* Q; const bf16* K; const bf16* V; bf16* O; const float* Bz; int P0; };
struct Seam { bf16x8 qr[8]; bf16x8 st_v0, st_v1, st_k0, st_k1; };
#define VMW() asm volatile("s_waitcnt vmcnt(0)" ::: "memory")
#define VMWN(n) asm volatile("s_waitcnt vmcnt(%0)" :: "i"(n) : "memory")
#define BL16(rs, so) __builtin_bit_cast(bf16x8, __builtin_amdgcn_raw_buffer_load_b128(rs, lkvB, (so), 0))
#define SLOAD_H(rK, rV, k0) do { S.st_v0 = BL16(rV, (k0) * (D * 2)); S.st_v1 = BL16(rV, ((k0) + 32) * (D * 2));              \
                         S.st_k0 = BL16(rK, (k0) * (D * 2)); S.st_k1 = BL16(rK, ((k0) + 32) * (D * 2)); } while (0)
#define SWRITE_HK(bf) do { *(bf16x8*)(K_lds + (bf) * SHM_K + kws) = S.st_k0; *(bf16x8*)(K_lds + (bf) * SHM_K + kws + 32 * 256) = S.st_k1; } while (0)
#define SWRITE_HV(bf) do { *(bf16x8*)(V_lds + (bf) * SHM_V + vst0) = S.st_v0; *(bf16x8*)(V_lds + (bf) * SHM_V + vst1) = S.st_v1; } while (0)
#define SWRITE_H(bf) do { SWRITE_HV(bf); SWRITE_HK(bf); } while (0)
__device__ __forceinline__ void attn_prime(const BlockRef& cur, char* lds, Seam& S) {
    const int tid = threadIdx.x, wid = __builtin_amdgcn_readfirstlane(tid >> 6), lane = tid & 63, r32 = lane & 31, hi = lane >> 5;
    const int sr = tid >> 4, sc = (tid & 15) * 8, kws = KSWZ(sr, sc * 2); char* K_lds = lds + 2 * SHM_V; const int lkvB = (sr * D + sc) * 2;
    const __amdgpu_buffer_rsrc_t rsK = __builtin_amdgcn_make_buffer_rsrc((void*)cur.K, 0, SKV * D * 2, 0x00020000), rsV = __builtin_amdgcn_make_buffer_rsrc((void*)cur.V, 0, SKV * D * 2, 0x00020000);
    { const bf16* qp = (cur.Q + (size_t)(wid * QBLK) * D) + (unsigned)(r32 * D + hi * 8);
#pragma unroll
      for (int d0 = 0; d0 < 8; ++d0) S.qr[d0] = load8(qp + d0 * 16); }
    SLOAD_H(rsK, rsV, 0); VMW(); SWRITE_HK(0);
    __syncthreads();
}
__device__ __forceinline__ void attn_block(const BlockRef& cur, int skv, char* lds, Seam& S) {
    const int tid = threadIdx.x, wid = __builtin_amdgcn_readfirstlane(tid >> 6), lane = tid & 63, r32 = lane & 31, hi = lane >> 5;
    int j_hi = (cur.P0 + QB - 1) / KVBLK + 1; if (j_hi > skv / KVBLK) j_hi = skv / KVBLK;
    const int NT = j_hi;
    const int qlo = cur.P0 + wid * QBLK, qm = qlo + r32 - 4 * hi;
    char* V_lds = lds; char* K_lds = lds + 2 * SHM_V;
    float* ws = (float*)(lds + 2 * SHM_V + 2 * SHM_K) + wid * 64; float* li_l = ws, * al_l = ws + 32;
    float m_reg = -1e30f, l_reg = 0; f32x16 o[4] = {};
    const int sr = tid >> 4, sc = (tid & 15) * 8, vst0 = v_st(sr, sc), vst1 = v_st(32 + sr, sc), kws = KSWZ(sr, sc * 2); const int lkvB = (sr * D + sc) * 2;
    const int vb0 = (int)(uintptr_t)V_lds + v_rd_base(lane);
    const __amdgpu_buffer_rsrc_t Kh = __builtin_amdgcn_make_buffer_rsrc((void*)cur.K, 0, SKV * D * 2, 0x00020000), Vh = __builtin_amdgcn_make_buffer_rsrc((void*)cur.V, 0, SKV * D * 2, 0x00020000);
    const __amdgpu_buffer_rsrc_t Bz = __builtin_amdgcn_make_buffer_rsrc((void*)cur.Bz, 0, SKV * 4, 0x00020000);
#define RESC(a) do { if (__any((a) < 1.f)) { if (hi == 0) al_l[r32] = (a); asm volatile("s_waitcnt lgkmcnt(0)" ::: "memory");              \
                     for (int d_ = 0; d_ < 4; ++d_) for (int r = 0; r < 16; ++r) o[d_][r] *= al_l[crow(r, hi)]; } } while (0)
#define KBASE(t) ((t) * KVBLK)
#define MASKT(P0_, P1_, t) do { const int kb_ = KBASE(t); if (kb_ + KVBLK - 1 > qlo) mask_tile(P0_, P1_, qm - kb_); } while (0)
    f32x16 pA0, pA1, pB0, pB1; float mnA, mnB, alA, alB; bf16x8 pa0, pa1, pa2, pa3;
    SWRITE_HV(0); SBAR();
    load_bias(pA0, pA1, Bz, KBASE(0), hi);
    if (NT > 1) { load_bias(pB0, pB1, Bz, KBASE(1), hi); SLOAD_H(Kh, Vh, KBASE(1)); }
    SBAR(); qkt<0>(pA0, pA1, K_lds, r32, hi, S.qr);
    MASKT(pA0, pA1, 0); partialSM(pA0, pA1, m_reg, mnA, alA);
    if (NT > 1) { VMW(); SWRITE_H(1); }
    __syncthreads();
#define HALF_STEP(PX0, PX1, mnX, alX, PY0, PY1, alY, t, KB, VB, SB) do {                                                      \
        SBAR(); qkt<KB>(PX0, PX1, K_lds, r32, hi, S.qr);                                                                      \
        finishSM(PY0, PY1, alY, l_reg, pa0, pa1, pa2, pa3); SBAR();                                                           \
        if ((t) + 1 < NT) { load_bias(PY0, PY1, Bz, KBASE((t) + 1), hi); SLOAD_H(Kh, Vh, KBASE((t) + 1)); SBAR(); }            \
        pv_tile<VB>(o, vb0, pa0, pa1, pa2, pa3); MASKT(PX0, PX1, (t)); partialSM(PX0, PX1, m_reg, mnX, alX);                  \
        __syncthreads();                                                                                                      \
        if ((t) + 1 < NT) { VMW(); SWRITE_H(SB); }                                                                            \
        RESC(alX); __syncthreads(); } while (0)
    for (int t = 1; t + 1 < NT; t += 2) {
        HALF_STEP(pB0, pB1, mnB, alB, pA0, pA1, alA, t, 1, 0, 0);
        HALF_STEP(pA0, pA1, mnA, alA, pB0, pB1, alB, t + 1, 0, 1, 1);
    }
    const bool even = (NT & 1) == 0;
    if (even) { SBAR(); qkt<1>(pB0, pB1, K_lds, r32, hi, S.qr); SBAR(); }
    finishSM(pA0, pA1, alA, l_reg, pa0, pa1, pa2, pa3); SBAR();
    pv_tile<0>(o, vb0, pa0, pa1, pa2, pa3);
    if (even) { MASKT(pB0, pB1, NT - 1); partialSM(pB0, pB1, m_reg, mnB, alB); __syncthreads(); RESC(alB);
        finishSM(pB0, pB1, alB, l_reg, pa0, pa1, pa2, pa3); SBAR(); pv_tile<1>(o, vb0, pa0, pa1, pa2, pa3); }
    SBAR();
    if (hi == 0) li_l[r32] = l_reg; asm volatile("s_waitcnt lgkmcnt(0)" ::: "memory");
    float rli[16];
#pragma unroll
    for (int r = 0; r < 16; ++r) rli[r] = __builtin_amdgcn_rcpf(li_l[crow(r, hi)]);
    unsigned char* const Ow = (unsigned char*)(cur.O + (size_t)(wid * QBLK) * OSTRIDE); const unsigned lo_ = (unsigned)((4 * hi * OSTRIDE + r32) * 2);
#pragma unroll
    for (int r = 0; r < 16; ++r) { const int orow = crow(r, hi);
#pragma unroll
        for (int d0 = 0; d0 < 4; ++d0) { const float v = o[d0][r] * rli[r];
            const float vn = __shfl_xor(v, 1);
            if ((r32 & 1) == 0) *(unsigned*)((Ow + (size_t)((((r & 3) + 8 * (r >> 2)) * OSTRIDE + d0 * 32) * 2)) + lo_) = cvtpk(v, vn); } }
    __syncthreads();
#undef RESC
#undef KBASE
#undef MASKT
#undef HALF_STEP
}
#undef BL16
#undef VMW
#undef VMWN
#undef SLOAD_H
#undef SWRITE_HK
#undef SWRITE_HV
#undef SWRITE_H
#undef PK4
#undef KSWZ
}

__device__ __forceinline__ fox::BlockRef attn_ref(const Frame& F, int L, int pass) {
    const int bh = L >> 4, x = L & 15, qb = pass ? 31 - x : x, b = bh >> 4, h = bh & 15;
    fox::BlockRef r;
    r.Q = wsp<bf16>(F, WS_QA) + ((size_t)bh * SEQ + (size_t)qb * 256) * HD;
    r.K = wsp<bf16>(F, WS_KA) + (size_t)bh * SKV * HD; r.V = wsp<bf16>(F, WS_VA) + (size_t)bh * SKV * HD;
    r.O = wsp<bf16>(F, WS_YA) + ((size_t)b * SEQ + (size_t)qb * 256) * (NH * HD) + h * HD;
    r.Bz = wsp<float>(F, WS_CUM) + (size_t)bh * SKV; r.P0 = 64 + qb * 256;
    return r;
}
__device__ __forceinline__ void p3_attention(Frame& F, char* ldsg) {
    constexpr int TOTAL = NB * NH * 16;
    char* lds = ldsg + RING_OFF;
    for (int L = F.vcu; L < TOTAL; L += F.G)
#pragma unroll 1
        for (int pass = 0; pass < 2; ++pass) {
            const fox::BlockRef cur = attn_ref(F, L, pass);
            fox::Seam S;
            fox::attn_prime(cur, lds, S);
            fox::attn_block(cur, SKV, lds, S);
        }
}
template <int B_> __device__ __forceinline__ bf16x8 pk4(const f32x16& P) {
    unsigned a0 = cvtpk(P[B_ + 0], P[B_ + 1]), a1 = cvtpk(P[B_ + 2], P[B_ + 3]), b0 = cvtpk(P[B_ + 4], P[B_ + 5]), b1 = cvtpk(P[B_ + 6], P[B_ + 7]);
    auto r0 = __builtin_amdgcn_permlane32_swap(a0, b0, false, false); auto r1 = __builtin_amdgcn_permlane32_swap(a1, b1, false, false);
    v4u w = {r0[0], r1[0], r0[1], r1[1]}; return *reinterpret_cast<bf16x8*>(&w);
}
__device__ __forceinline__ void p4_ret_item(Frame& F, int item) {
    const int bh = item >> 6, c = (item & 63) + 1, b = bh >> 4, h = bh & (NH - 1);
    const float lg2 = LG2GAM[h];
    const bf16* Qg = wsp<bf16>(F, WS_QR) + ((size_t)bh * LR + 128 * c) * HD;
    const bf16* Kg = wsp<bf16>(F, WS_KR) + ((size_t)bh * LR + 128 * c) * HD;
    const bf16* Vg = wsp<bf16>(F, WS_VR) + ((size_t)bh * LR + 128 * c) * RDV;
    const bf16* STg = wsp<bf16>(F, WS_ST) + ((size_t)bh * NCHUNK + (c - 1)) * 32768;
    LAS unsigned char* ldsV = F.lds; LAS f32x2* stats = (LAS f32x2*)(F.lds + 65536);
    const int sr = F.tid >> 4, sc = (F.tid & 15) * 8;
    {   v4u vw[2][4];
#pragma unroll
        for (int q = 0; q < 4; ++q) { const int j = sr + 32 * q; vw[0][q] = *(const GAS v4u*)(Vg + (size_t)j * RDV + sc); vw[1][q] = *(const GAS v4u*)(Vg + (size_t)j * RDV + 128 + sc); }
#pragma unroll
        for (int q = 0; q < 4; ++q) { const int j = sr + 32 * q, so = v_st(j & 63, sc);
            *(LAS v4u*)(ldsV + ((j >> 6) * 2 + 0) * 16384 + so) = vw[0][q]; *(LAS v4u*)(ldsV + ((j >> 6) * 2 + 1) * 16384 + so) = vw[1][q]; } }
    __syncthreads();
    const int w = F.wave, ib = w & 3, eh = w >> 2, r32 = F.lane & 31, hi = F.lane >> 5;
    bf16x8 qr[8];
#pragma unroll
    for (int ks = 0; ks < 8; ++ks) qr[ks] = *(const GAS bf16x8*)(Qg + (size_t)(32 * ib + r32) * HD + 16 * ks + 8 * hi);
    f32x16 acc[4] = {};
#pragma unroll
    for (int ks = 0; ks < 8; ++ks)
#pragma unroll
        for (int et = 0; et < 4; ++et) { const bf16x8 a = *(const GAS bf16x8*)(STg + (size_t)(128 * eh + 32 * et + r32) * HD + 16 * ks + 8 * hi);
            acc[et] = __builtin_amdgcn_mfma_f32_32x32x16_bf16(a, qr[ks], acc[et], 0, 0, 0); }
    { const float xi = fast_exp2(lg2 * (float)(32 * ib + r32 + 1));
#pragma unroll
      for (int et = 0; et < 4; ++et)
#pragma unroll
          for (int r = 0; r < 16; ++r) acc[et][r] *= xi; }
    const LAS unsigned char* pv = ldsV + v_rd_base(F.lane) + eh * 16384;
    for (int jt = 0; jt <= ib; ++jt) {
        f32x16 p = {};
#pragma unroll
        for (int ks = 0; ks < 8; ++ks) { const bf16x8 a = *(const GAS bf16x8*)(Kg + (size_t)(32 * jt + r32) * HD + 16 * ks + 8 * hi);
            p = __builtin_amdgcn_mfma_f32_32x32x16_bf16(a, qr[ks], p, 0, 0, 0); }
        const int ibase = 32 * ib + r32 - 32 * jt - 4 * hi;
#pragma unroll
        for (int r = 0; r < 16; ++r) { const int dl = ibase - ((r & 3) + 8 * (r >> 2)); p[r] = dl >= 0 ? p[r] * fast_exp2(lg2 * (float)dl) : 0.f; }
        const bf16x8 pa0 = pk4<0>(p), pa1 = pk4<8>(p);
        const LAS unsigned char* pvj = pv + (jt >> 1) * 32768 + (jt & 1) * 8192;
#pragma unroll
        for (int et = 0; et < 4; ++et) { const bf16x8 a0 = tr_frag(pvj + et * 512), a1 = tr_frag(pvj + et * 512 + 4096);
            acc[et] = __builtin_amdgcn_mfma_f32_32x32x16_bf16(a0, pa0, acc[et], 0, 0, 0);
            acc[et] = __builtin_amdgcn_mfma_f32_32x32x16_bf16(a1, pa1, acc[et], 0, 0, 0); }
    }
    float s1 = 0.f, s2 = 0.f;
#pragma unroll
    for (int et = 0; et < 4; ++et)
#pragma unroll
        for (int r = 0; r < 16; ++r) { s1 += acc[et][r]; s2 += acc[et][r] * acc[et][r]; }
    s1 += __shfl_xor(s1, 32); s2 += __shfl_xor(s2, 32);
    if (hi == 0) stats[eh * 128 + 32 * ib + r32] = (f32x2){s1, s2};
    __syncthreads();
    const f32x2 sa = stats[32 * ib + r32], sb = stats[128 + 32 * ib + r32];
    const float mean = (sa.x + sb.x) * (1.f / RDV), var = fmaxf((sa.y + sb.y) * (1.f / RDV) - mean * mean, 0.f), rstd = 1.f / sqrtf(var + EPS);
    const size_t tok = (size_t)b * SEQ + 128 * (c - 1) + 32 * ib + r32;
    const bf16* GRp = wsp<bf16>(F, WS_GR) + tok * DM + h * RDV + 128 * eh + 4 * hi;
    bf16* YRp = wsp<bf16>(F, WS_YR) + tok * DM + h * RDV + 128 * eh + 4 * hi;
    const float* gp = F.g_ret + h * RDV + 128 * eh + 4 * hi;
#pragma unroll
    for (int et = 0; et < 4; ++et)
#pragma unroll
        for (int g4 = 0; g4 < 4; ++g4) { const int eo = 32 * et + 8 * g4;
            const f32x4 gn = *(const GAS f32x4*)(gp + eo); const v2u gt = *(const GAS v2u*)(GRp + eo);
            const float o0 = (acc[et][4 * g4 + 0] - mean) * rstd * gn[0] * bflo(gt.x), o1 = (acc[et][4 * g4 + 1] - mean) * rstd * gn[1] * bfhi(gt.x);
            const float o2 = (acc[et][4 * g4 + 2] - mean) * rstd * gn[2] * bflo(gt.y), o3 = (acc[et][4 * g4 + 3] - mean) * rstd * gn[3] * bfhi(gt.y);
            v2u ov; ov.x = pk2(o0, o1); ov.y = pk2(o2, o3); *(GAS v2u*)(YRp + eo) = ov; }
    __syncthreads();
}
__device__ __forceinline__ void p4_phase(Frame& F) {
    for (int item = F.vcu; item < NB * NH * NCHUNK; item += F.G) p4_ret_item(F, item);
}
__device__ __forceinline__ int f2key(float x) { const int i = __float_as_int(x); return i ^ ((i >> 31) & 0x7fffffff); }
__device__ __forceinline__ float key2f(int k) { return __int_as_float(k ^ ((k >> 31) & 0x7fffffff)); }
__device__ __forceinline__ int imax(int a, int b) { return a > b ? a : b; }
__device__ __forceinline__ int imin(int a, int b) { return a < b ? a : b; }
__device__ __forceinline__ void ins16(int (&a)[16], int x) {
#pragma unroll
    for (int i = 0; i < 16; ++i) { const int t = imax(a[i], x); x = imin(a[i], x); a[i] = t; }
}
__device__ __forceinline__ void merge_partner16(int (&a)[16]) {
    int c[16];
#pragma unroll
    for (int i = 0; i < 16; ++i) c[i] = __shfl_xor(a[15 - i], 32);
#pragma unroll
    for (int i = 0; i < 16; ++i) c[i] = imax(a[i], c[i]);
#pragma unroll
    for (int st = 8; st >= 1; st >>= 1)
#pragma unroll
        for (int i = 0; i < 16; ++i) if (!(i & st)) { const int hi_ = imax(c[i], c[i + st]), lo_ = imin(c[i], c[i + st]); c[i] = hi_; c[i + st] = lo_; }
#pragma unroll
    for (int i = 0; i < 16; ++i) a[i] = c[i];
}
struct CandTab { int a[50], b[50]; };
constexpr CandTab make_cands() { CandTab t{}; int n = 0; for (int a = 0; a < 16; ++a) for (int b = 0; b < 16; ++b) if ((a + 1) * (b + 1) <= 16) { t.a[n] = a; t.b[n] = b; ++n; } return t; }
constexpr CandTab CANDS = make_cands();

__device__ __forceinline__ void p9_unit(Frame& F, int unit) {
    const int tt = unit >> 3, h = unit & 7;
    const int w = F.wave, r32 = F.lane & 31, hi = F.lane >> 5;
    const int t = tt * 256 + 32 * w + r32;
    const bf16* QPp = wsp<bf16>(F, WS_QP) + (size_t)t * PQ + h * 256 + 8 * hi;
    const bf16* KB = wsp<bf16>(F, WS_KEYS);
    LAS int* mylds = (LAS int*)(F.lds + RING_OFF) + (size_t)F.tid * 32;
#pragma unroll 1
    for (int half = 0; half < 2; ++half) {
        bf16x8 qf[8];
#pragma unroll
        for (int ks = 0; ks < 8; ++ks) qf[ks] = *(const GAS bf16x8*)(QPp + half * 128 + 16 * ks);
        int top[16];
#pragma unroll
        for (int i = 0; i < 16; ++i) top[i] = (int)0x80000000;
        const bf16* Kh = KB + ((size_t)half * PH + h) * PK * 128 + (size_t)r32 * 128 + 8 * hi;
#pragma unroll 1
        for (int nt = 0; nt < 4; ++nt) {
            f32x16 p = {};
#pragma unroll
            for (int ks = 0; ks < 8; ++ks) { const bf16x8 a = *(const GAS bf16x8*)(Kh + (size_t)nt * 32 * 128 + 16 * ks); p = __builtin_amdgcn_mfma_f32_32x32x16_bf16(a, qf[ks], p, 0, 0, 0); }
            const int nb = 32 * nt + 4 * hi;
#pragma unroll
            for (int r = 0; r < 16; ++r) { const int n = nb + (r & 3) + 8 * (r >> 2); ins16(top, (f2key(p[r]) & ~127) | n); }
        }
        merge_partner16(top);
#pragma unroll
        for (int i = 0; i < 4; ++i) *(LAS v4u*)(mylds + half * 16 + 4 * i) = (v4u){(unsigned)top[4 * i], (unsigned)top[4 * i + 1], (unsigned)top[4 * i + 2], (unsigned)top[4 * i + 3]};
    }
    float f1[16], f2[16];
#pragma unroll
    for (int i = 0; i < 4; ++i) { const v4u a = *(LAS v4u*)(mylds + 4 * i), b = *(LAS v4u*)(mylds + 16 + 4 * i);
#pragma unroll
        for (int k = 0; k < 4; ++k) { f1[4 * i + k] = key2f((int)a[k] & ~127); f2[4 * i + k] = key2f((int)b[k] & ~127); } }
    int fin[16];
#pragma unroll
    for (int i = 0; i < 16; ++i) fin[i] = (int)0x80000000;
#pragma unroll
    for (int s = 0; s < 25; ++s) {
        const float ve = f1[CANDS.a[2 * s]] + f2[CANDS.b[2 * s]], vo = f1[CANDS.a[2 * s + 1]] + f2[CANDS.b[2 * s + 1]];
        const int ie = (CANDS.a[2 * s] << 4) | CANDS.b[2 * s], io = (CANDS.a[2 * s + 1] << 4) | CANDS.b[2 * s + 1];
        const float v = hi ? vo : ve; const int id = hi ? io : ie;
        ins16(fin, (f2key(v) & ~255) | id);
    }
    merge_partner16(fin);
    float sv[16], e[16]; float den = 0.f;
#pragma unroll
    for (int i = 0; i < 16; ++i) sv[i] = key2f(fin[i] & ~255);
#pragma unroll
    for (int i = 0; i < 16; ++i) { e[i] = fast_exp2((sv[i] - sv[0]) * 1.4426950408889634f); den += e[i]; }
    const float rden = 1.f / den;
    int eid[8]; float gw[8];
#pragma unroll
    for (int k = 0; k < 8; ++k) { const int key = hi ? fin[8 + k] : fin[k]; const int a = (key >> 4) & 15, b = key & 15;
        const int n1 = mylds[a] & 127, n2 = mylds[16 + b] & 127; eid[k] = n1 * PK + n2; gw[k] = (hi ? e[8 + k] : e[k]) * rden; }
    int* EIDp = wsp<int>(F, WS_EID) + (size_t)t * 128 + h * 16 + 8 * hi; float* GWp = wsp<float>(F, WS_GW) + (size_t)t * 128 + h * 16 + 8 * hi;
    *(GAS v4u*)EIDp = (v4u){(unsigned)eid[0], (unsigned)eid[1], (unsigned)eid[2], (unsigned)eid[3]}; *(GAS v4u*)(EIDp + 4) = (v4u){(unsigned)eid[4], (unsigned)eid[5], (unsigned)eid[6], (unsigned)eid[7]};
    *(GAS f32x4*)GWp = (f32x4){gw[0], gw[1], gw[2], gw[3]}; *(GAS f32x4*)(GWp + 4) = (f32x4){gw[4], gw[5], gw[6], gw[7]};
}
__device__ __forceinline__ void p9_phase(Frame& F) {
    for (int unit = F.vcu; unit < (MTOK / 256) * PH; unit += F.G) p9_unit(F, unit);
}
typedef __amdgpu_buffer_rsrc_t rsrc_t;
__device__ __forceinline__ rsrc_t mk_rsrc(const void* p, unsigned bytes) { return __builtin_amdgcn_make_buffer_rsrc((void*)p, 0, bytes, 0x00020000); }
__device__ __forceinline__ float fdot2(unsigned a, unsigned b, float c) { return __builtin_amdgcn_fdot2_f32_bf16(__builtin_bit_cast(bf16x2_t, a), __builtin_bit_cast(bf16x2_t, b), c, false); }
__device__ __forceinline__ void load_row(v4u (&r)[8], rsrc_t rs, int lane16, int e) {
    const int so = e * (DM * 2);
#pragma unroll
    for (int j = 0; j < 8; ++j) r[j] = __builtin_amdgcn_raw_buffer_load_b128(rs, lane16, so + j * 1024, 0);
}
__device__ __forceinline__ float dot_row(const v4u (&r)[8], const v4u (&x)[8]) {
    float a0 = 0.f, a1 = 0.f, a2 = 0.f, a3 = 0.f;
#pragma unroll
    for (int j = 0; j < 8; ++j) { a0 = fdot2(r[j].x, x[j].x, a0); a1 = fdot2(r[j].y, x[j].y, a1); a2 = fdot2(r[j].z, x[j].z, a2); a3 = fdot2(r[j].w, x[j].w, a3); }
    return wave_sum((a0 + a1) + (a2 + a3));
}
__device__ __forceinline__ void axpy_row(float (&acc)[64], const v4u (&r)[8], float w) {
#pragma unroll
    for (int j = 0; j < 8; ++j) {
        acc[8 * j + 0] += w * bflo(r[j].x); acc[8 * j + 1] += w * bfhi(r[j].x); acc[8 * j + 2] += w * bflo(r[j].y); acc[8 * j + 3] += w * bfhi(r[j].y);
        acc[8 * j + 4] += w * bflo(r[j].z); acc[8 * j + 5] += w * bfhi(r[j].z); acc[8 * j + 6] += w * bflo(r[j].w); acc[8 * j + 7] += w * bfhi(r[j].w); }
}
__device__ __forceinline__ int imin_(int a, int b) { return a < b ? a : b; }
__device__ __forceinline__ float gelu1(float v) {
    const float av = __builtin_fabsf(v), t = fast_rcp(av * 0.2316418882f + 1.0f);
    float q = t * 0.5307027145f + (-0.7265760135f); q = q * t + 0.7107068705f; q = q * t + (-0.142248368f); q = q * t + 0.127414796f; q = q * t;
    const float e = fast_exp2((v * v) * (-0.72134752044f)), m = v * (q * e);
    return v < 0.f ? m : v - m;
}
__device__ __forceinline__ float u_half(const v4u (&x)[8], rsrc_t rs, int lane16, int ev, int lane) {
    float a = 0.f;
    v4u R0[8], R1[8], R2[8], R3[8];
    load_row(R0, rs, lane16, __builtin_amdgcn_readlane(ev, 0)); load_row(R1, rs, lane16, __builtin_amdgcn_readlane(ev, 1)); load_row(R2, rs, lane16, __builtin_amdgcn_readlane(ev, 2));
#pragma unroll 1
    for (int k = 0; k < 64; k += 4) {
        load_row(R3, rs, lane16, __builtin_amdgcn_readlane(ev, k + 3));             SBAR(); { const float d = dot_row(R0, x); a = (lane == k) ? d : a; } SBAR();
        load_row(R0, rs, lane16, __builtin_amdgcn_readlane(ev, imin_(k + 4, 63))); SBAR(); { const float d = dot_row(R1, x); a = (lane == k + 1) ? d : a; } SBAR();
        load_row(R1, rs, lane16, __builtin_amdgcn_readlane(ev, imin_(k + 5, 63))); SBAR(); { const float d = dot_row(R2, x); a = (lane == k + 2) ? d : a; } SBAR();
        load_row(R2, rs, lane16, __builtin_amdgcn_readlane(ev, imin_(k + 6, 63))); SBAR(); { const float d = dot_row(R3, x); a = (lane == k + 3) ? d : a; } SBAR();
    }
    return a;
}
__device__ __forceinline__ float rlf(float v, int k) { return __int_as_float(__builtin_amdgcn_readlane(__float_as_int(v), k)); }
__device__ __forceinline__ void v_half(float (&acc)[64], rsrc_t rs, int lane16, int ev, float wv) {
    v4u R0[8], R1[8];
    load_row(R0, rs, lane16, __builtin_amdgcn_readlane(ev, 0));
#pragma unroll 1
    for (int k = 0; k < 64; k += 2) {
        load_row(R1, rs, lane16, __builtin_amdgcn_readlane(ev, k + 1));             SBAR(); axpy_row(acc, R0, rlf(wv, k)); SBAR();
        load_row(R0, rs, lane16, __builtin_amdgcn_readlane(ev, imin_(k + 2, 63))); SBAR(); axpy_row(acc, R1, rlf(wv, k + 1)); SBAR();
    }
}
__device__ __forceinline__ void p10_token(Frame& F, int t, rsrc_t rsU, rsrc_t rsV, rsrc_t rsX, rsrc_t rsO) {
    const int lane = F.lane, lane16 = lane * 16;
    const int* EIDp = wsp<int>(F, WS_EID) + (size_t)t * 128; const float* GWp = wsp<float>(F, WS_GW) + (size_t)t * 128;
    const int e0 = EIDp[lane], e1 = EIDp[64 + lane]; const float g0 = GWp[lane], g1 = GWp[64 + lane];
    float w0, w1;
    {   v4u x[8];
        load_row(x, rsX, lane16, t);
        const float a0 = u_half(x, rsU, lane16, e0, lane); SBAR();
        const float a1 = u_half(x, rsU, lane16, e1, lane); SBAR();
        w0 = g0 * gelu1(a0); w1 = g1 * gelu1(a1);
    }
    SBAR();
    float acc[64];
#pragma unroll
    for (int i = 0; i < 64; ++i) acc[i] = 0.f;
    v_half(acc, rsV, lane16, e0, w0); SBAR();
    v_half(acc, rsV, lane16, e1, w1); SBAR();
    const int lane32 = lane * 32, so = t * (DM * 4);
#pragma unroll
    for (int j = 0; j < 8; ++j) {
        v4u h0 = __builtin_amdgcn_raw_buffer_load_b128(rsO, lane32, so + j * 2048, 0), h1 = __builtin_amdgcn_raw_buffer_load_b128(rsO, lane32, so + j * 2048 + 16, 0);
        h0[0] = __float_as_uint(__uint_as_float(h0[0]) + acc[8 * j + 0]); h0[1] = __float_as_uint(__uint_as_float(h0[1]) + acc[8 * j + 1]);
        h0[2] = __float_as_uint(__uint_as_float(h0[2]) + acc[8 * j + 2]); h0[3] = __float_as_uint(__uint_as_float(h0[3]) + acc[8 * j + 3]);
        h1[0] = __float_as_uint(__uint_as_float(h1[0]) + acc[8 * j + 4]); h1[1] = __float_as_uint(__uint_as_float(h1[1]) + acc[8 * j + 5]);
        h1[2] = __float_as_uint(__uint_as_float(h1[2]) + acc[8 * j + 6]); h1[3] = __float_as_uint(__uint_as_float(h1[3]) + acc[8 * j + 7]);
        unsigned char* const op = (unsigned char*)F.out + (size_t)(unsigned)(so + j * 2048) + (unsigned)lane32;
        *(v4u*)op = h0; *(v4u*)(op + 16) = h1; }
}
__device__ __forceinline__ void p10_phase(Frame& F) {
    const int gw = F.vcu * 8 + F.wave, NGW = F.G * 8;
    const rsrc_t rsU = mk_rsrc(wsp<bf16>(F, WS_U16), (unsigned)MTOK * DM * 2), rsV = mk_rsrc(wsp<bf16>(F, WS_V16), (unsigned)MTOK * DM * 2);
    const rsrc_t rsX = mk_rsrc(wsp<bf16>(F, WS_XN), (unsigned)MTOK * DM * 2), rsO = mk_rsrc(F.out, (unsigned)MTOK * DM * 4);
    for (int t = gw; t < MTOK; t += NGW) p10_token(F, t, rsU, rsV, rsX, rsO);
}
constexpr int NPHASE = 11;
constexpr int N_LAUNCHES = MK_N_LAUNCHES;
#ifndef MK_CUT
#define MK_CUT 1
#endif
struct Args { const float* in[17]; float* out; unsigned char* ws; int ph_lo, ph_hi, li, pad; };
__device__ __forceinline__ void cvt_table(const float* src, bf16* dst, size_t n8, int gt, int NT) {
    for (size_t i = gt; i < n8; i += NT) { const f32x4 a = ((const GAS f32x4*)src)[2 * i], b = ((const GAS f32x4*)src)[2 * i + 1];
        v4u o; o.x = pk2(a[0], a[1]); o.y = pk2(a[2], a[3]); o.z = pk2(b[0], b[1]); o.w = pk2(b[2], b[3]); ((GAS v4u*)dst)[i] = o; }
}
#ifndef DBG_DUMP
#define DBG_DUMP -1
#endif
__device__ __forceinline__ void dbg_dump(Frame& F, size_t o0, size_t n0, size_t o1, size_t n1, size_t o2, size_t n2, bool f32_2) {
    const size_t gt = (size_t)F.vcu * 512 + F.tid, NT = (size_t)F.G * 512;
    for (size_t i = gt; i < (size_t)MTOK * DM; i += NT) {
        float v = 0.f;
        if (n0) v += __uint_as_float((unsigned)wsp<bf16>(F, o0)[i % n0] << 16);
        if (n1) v += __uint_as_float((unsigned)wsp<bf16>(F, o1)[i % n1] << 16);
        if (n2) v += f32_2 ? wsp<float>(F, o2)[i % n2] : __uint_as_float((unsigned)wsp<bf16>(F, o2)[i % n2] << 16);
        F.out[i] = v;
    }
}
__global__ void __launch_bounds__(512, 2) fwd(Args args) {
    extern __shared__ __attribute__((aligned(16))) unsigned char lds[];
    Frame F;
    F.lds = (LAS unsigned char*)lds;
    F.MISC = (volatile LAS unsigned*)(F.lds + MISC_OFF);
    F.tid = threadIdx.x; F.lane = F.tid & 63; F.wave = __builtin_amdgcn_readfirstlane(F.tid >> 6);
    F.G = gridDim.x; { const int bx = blockIdx.x; F.vcu = (F.G % 8 == 0) ? (bx % 8) * (F.G / 8) + bx / 8 : bx; }
    F.ws = args.ws; F.ctl = (gu32*)(args.ws + WS_CTL);
    F.x = args.in[0]; F.meta = args.in[1]; F.g_mix = args.in[2]; F.w_in = args.in[3]; F.b_forget = args.in[4]; F.g_q = args.in[5]; F.g_k = args.in[6]; F.g_ret = args.in[7];
    F.w_fox = args.in[8]; F.w_ret = args.in[9]; F.w_out = args.in[10]; F.g_ffn = args.in[11]; F.w_q = args.in[12]; F.keys1 = args.in[13]; F.keys2 = args.in[14]; F.pu = args.in[15]; F.pv = args.in[16];
    F.out = args.out;
    for (int u = F.tid; u < (LDS_BYTES - LDSCTL_OFF) / 4; u += 512) ((LAS unsigned*)(F.lds + LDSCTL_OFF))[u] = 0u;
    __syncthreads();
    XcdBarrier bar; bar.bar = (unsigned*)(F.ctl + CW_BAR) + args.li * XCD_BAR_WORDS; bar.x = 0; bar.st = nullptr;
    if (args.ph_hi - args.ph_lo > 1) bar = xcd_barrier_post((unsigned*)(F.ctl + CW_BAR) + args.li * XCD_BAR_WORDS, F.MISC + 8);
    const int lo = args.ph_lo, hi = args.ph_hi;
#ifndef PH_MASK
#define PH_MASK 0x7ff
#endif
#define IN(k) ((((PH_MASK) >> (k)) & 1) && lo <= (k) && (k) < hi)
#define SEAM(k) do { if (IN(k) && IN((k) + 1)) xcd_barrier(bar); } while (0)

    if (IN(0)) { p0_prologue(F); } SEAM(0);

    if (IN(1)) {
        pg8::Gemm g{wsp<bf16>(F, WS_UX), wsp<bf16>(F, WS_WZ), MROWS, NZ, DM}; pg8::StaticOrder S; S.init(MROWS, NZ, F.G, (int)blockIdx.x);
#if DBG_DUMP == 100
        pg8::EpiGate<2> E{wsp<bf16>(F, WS_QA), nullptr, NZ};
        pg8::gemm_phase<pg8::EpiGate<2>, pg8::StaticOrder, true, true>(F.lds + RING_OFF, g, S, E);
#else
        pg8::EpiZ E{F.ws, F.b_forget};
        pg8::gemm_phase<pg8::EpiZ, pg8::StaticOrder, true, true>(F.lds + RING_OFF, g, S, E);
#endif
    } SEAM(1);

    if (DBG_DUMP == 0) { dbg_dump(F, WS_UX, (size_t)MROWS * DM, WS_WZ, (size_t)NZ * DM, WS_WFOX, (size_t)48 * MiB, false); return; }
    if (DBG_DUMP == 100) { const size_t gt = (size_t)F.vcu * 512 + F.tid, NT = (size_t)F.G * 512, TOT = (size_t)MROWS * NZ;
        for (size_t i = gt; i < (size_t)MTOK * DM; i += NT) { float v = 0.f;
            for (int j = 0; j < 7; ++j) { const size_t k = i + (size_t)j * MTOK * DM; if (k < TOT) v += __uint_as_float((unsigned)wsp<bf16>(F, WS_QA)[k] << 16); }
            F.out[i] = v; } return; }
    if (DBG_DUMP == 1) { dbg_dump(F, WS_GR, (size_t)3 * MTOK * DM, 0, 0, 0, 0, false); return; }
    if (IN(2)) { p2_phase(F); } SEAM(2);
    if (DBG_DUMP == 2) { dbg_dump(F, WS_QA, (size_t)NB * NH * SEQ * HD, WS_GR, (size_t)3 * MTOK * DM, WS_KVT, (size_t)NB * NH * NCHUNK * 32768, true); return; }

    if (IN(3)) {
#ifndef NO_SCAN
        p3_scan(F);
#endif
#ifndef NO_ATT
        p3_attention(F, (char*)lds);
#endif
    } SEAM(3);

    if (IN(4)) { p4_phase(F); } SEAM(4);
    if (DBG_DUMP == 4) { dbg_dump(F, WS_YA, (size_t)MTOK * 2048, WS_YR, (size_t)MTOK * DM, WS_ST, (size_t)NB * NH * NCHUNK * 32768, false); return; }

    if (IN(5)) {
        { const int gt = F.vcu * 512 + F.tid, NT = F.G * 512;
          cvt_table(F.pu, wsp<bf16>(F, WS_U16), (size_t)MTOK * DM / 8, gt, NT); cvt_table(F.pv, wsp<bf16>(F, WS_V16), (size_t)MTOK * DM / 8, gt, NT); }
        { pg8::Gemm g{wsp<bf16>(F, WS_YA), wsp<bf16>(F, WS_WFOX), MTOK, DM, 2048}; pg8::StaticOrder S; S.init(MTOK, DM, F.G, (int)blockIdx.x);
          pg8::EpiGate<0> E{wsp<bf16>(F, WS_MRG), wsp<bf16>(F, WS_GA), DM};
          pg8::gemm_phase<pg8::EpiGate<0>, pg8::StaticOrder, true, true>(F.lds + RING_OFF, g, S, E); }
        { pg8::Gemm g{wsp<bf16>(F, WS_YR), wsp<bf16>(F, WS_WRET), MTOK, DM, DM}; pg8::StaticOrder S; S.init(MTOK, DM, F.G, (int)blockIdx.x);
          pg8::EpiGate<1> E{wsp<bf16>(F, WS_MRG), wsp<bf16>(F, WS_GT), DM};
          pg8::gemm_phase<pg8::EpiGate<1>, pg8::StaticOrder, true, true>(F.lds + RING_OFF, g, S, E); }
    } SEAM(5);

    if (DBG_DUMP == 5) { dbg_dump(F, WS_MRG, (size_t)MTOK * DM, WS_U16, (size_t)2 * MTOK * DM, 0, 0, false); return; }
    if (IN(6)) {
        pg8::Gemm g{wsp<bf16>(F, WS_MRG), wsp<bf16>(F, WS_WOUT), MTOK, DM, DM}; pg8::StaticOrder S; S.init(MTOK, DM, F.G, (int)blockIdx.x);
        pg8::EpiResF32 E{F.x, F.out, DM};
        pg8::gemm_phase<pg8::EpiResF32, pg8::StaticOrder, true, true>(F.lds + RING_OFF, g, S, E);
    } SEAM(6);

    if (IN(7)) { const int gw = F.vcu * 8 + F.wave, NGW = F.G * 8; bf16* XN = wsp<bf16>(F, WS_XN);
        for (int m = gw; m < MTOK; m += NGW) rms_row_to_bf16(F.out + (size_t)m * DM, F.g_ffn, XN + (size_t)m * DM, F.lane);
    } SEAM(7);

    if (IN(8)) {
        pg8::Gemm g{wsp<bf16>(F, WS_XN), wsp<bf16>(F, WS_WQ), MTOK, PQ, DM}; pg8::StaticOrder S; S.init(MTOK, PQ, F.G, (int)blockIdx.x);
        pg8::EpiGate<2> E{wsp<bf16>(F, WS_QP), nullptr, PQ};
        pg8::gemm_phase<pg8::EpiGate<2>, pg8::StaticOrder, true, true>(F.lds + RING_OFF, g, S, E);
    } SEAM(8);

    if (IN(9)) { p9_phase(F); } SEAM(9);
    if (DBG_DUMP == 9) { dbg_dump(F, WS_XN, (size_t)MTOK * DM, WS_QP, (size_t)MTOK * PQ, WS_GW, (size_t)MTOK * 128, true); return; }

    if (IN(10)) { p10_phase(F); }
#undef IN
#undef SEAM
}

extern "C" void kernel_launch(void* const* d_in, const int* in_sizes, int n_in, void* d_out, int out_size, void* d_ws, size_t ws_size, hipStream_t stream) {
    static int grid = 0;
    if (grid == 0) {
        if (n_in != 17 || in_sizes[0] != MTOK * DM || out_size != MTOK * DM || ws_size < WS_END) {
            fprintf(stderr, "kernel_launch: unexpected shapes (n_in %d, in0 %d, out %d, ws %zu; need ws >= %zu); nothing launched\n", n_in, n_in > 0 ? in_sizes[0] : -1, out_size, ws_size, (size_t)WS_END); grid = -1; return; }
        int dev = 0, cus = 0, per_cu = 0;
        if (hipGetDevice(&dev) != hipSuccess || hipDeviceGetAttribute(&cus, hipDeviceAttributeMultiprocessorCount, dev) != hipSuccess) { grid = -1; return; }
        if (hipFuncSetAttribute((const void*)fwd, hipFuncAttributeMaxDynamicSharedMemorySize, LDS_BYTES) != hipSuccess) { fprintf(stderr, "kernel_launch: hipFuncSetAttribute failed\n"); grid = -1; return; }
        if (hipOccupancyMaxActiveBlocksPerMultiprocessor(&per_cu, (const void*)fwd, 512, LDS_BYTES) != hipSuccess || per_cu < 1) { fprintf(stderr, "kernel_launch: occupancy query says %d blocks per CU\n", per_cu); }
        (void)hipGetLastError();
        grid = cus;
    }
    if (grid < 0) return;
    (void)hipMemsetAsync((char*)d_ws + WS_CTL, 0, CTL_ZERO_BYTES, stream);
    Args a{};
    for (int i = 0; i < 17; ++i) a.in[i] = (const float*)d_in[i];
    a.out = (float*)d_out; a.ws = (unsigned char*)d_ws; a.pad = 0;
    if (N_LAUNCHES == 1) { a.ph_lo = 0; a.ph_hi = NPHASE; a.li = 0; hipLaunchKernelGGL(fwd, dim3(grid), dim3(512), LDS_BYTES, stream, a); }
    else if (N_LAUNCHES == 2) { a.ph_lo = 0; a.ph_hi = MK_CUT; a.li = 0; hipLaunchKernelGGL(fwd, dim3(grid), dim3(512), LDS_BYTES, stream, a);
        a.ph_lo = MK_CUT; a.ph_hi = NPHASE; a.li = 1; hipLaunchKernelGGL(fwd, dim3(grid), dim3(512), LDS_BYTES, stream, a); }
    else { for (int p = 0; p < NPHASE; ++p) { a.ph_lo = p; a.ph_hi = p + 1; a.li = p; hipLaunchKernelGGL(fwd, dim3(grid), dim3(512), LDS_BYTES, stream, a); } }
}
```

```cpp
#include <hip/hip_runtime.h>
#include <cstdio>
#include <cstdint>

#ifndef MK_N_LAUNCHES
#define MK_N_LAUNCHES 1
#endif
#ifndef DBG_CHECK
#define DBG_CHECK 0
#endif

constexpr int DM = 4096, NB = 2, SEQ = 8192, MTOK = NB * SEQ;
constexpr int NMETA = 16, MROWS = MTOK + 256;
constexpr int NH = 16, HD = 128, RDV = 256;
constexpr int SKV = 64 + SEQ;
constexpr int LR = 128 + SEQ;
constexpr int NZ = 26880;
constexpr int NCHUNK = 64;
constexpr int PH = 8, PK = 128, PTOP = 16, PQ = 2048;
constexpr float EPS = 1e-6f;
constexpr int Z_QA = 0, Z_KA = 2048, Z_VA = 4096, Z_QR = 6144, Z_KR = 8192, Z_VR = 10240, Z_GR = 14336, Z_GA = 18432, Z_GT = 22528, Z_F = 26624;

constexpr size_t MiB = 1u << 20;
constexpr size_t WS_CTL = 0, CTL_ZERO_BYTES = 1 * MiB;
constexpr size_t WS_WFOX = 2 * MiB;
constexpr size_t WS_WRET = WS_WFOX + 16 * MiB;
constexpr size_t WS_WOUT = WS_WRET + 32 * MiB;
constexpr size_t WS_WQ   = WS_WOUT + 32 * MiB;
constexpr size_t WS_KEYS = WS_WQ + 16 * MiB;
constexpr size_t WS_T1   = WS_KEYS + 1 * MiB;
constexpr size_t WS_WZ   = WS_T1;
constexpr size_t WS_UX   = WS_T1 + 210 * MiB;
constexpr size_t WS_KVT  = WS_T1;
constexpr size_t WS_MRG  = WS_T1;
constexpr size_t WS_XN   = WS_T1 + 128 * MiB;
constexpr size_t WS_QP   = WS_T1 + 256 * MiB;
constexpr size_t WS_P1   = WS_T1 + 340 * MiB;
constexpr size_t WS_QA   = WS_P1;
constexpr size_t WS_KA   = WS_QA + 64 * MiB;
constexpr size_t WS_VA   = WS_KA + 65 * MiB;
constexpr size_t WS_QR   = WS_VA + 65 * MiB;
constexpr size_t WS_KR   = WS_QR + 65 * MiB;
constexpr size_t WS_VR   = WS_KR + 65 * MiB;
constexpr size_t WS_CUM  = WS_VR + 130 * MiB;
constexpr size_t WS_GR   = WS_CUM + 2 * MiB;
constexpr size_t WS_GA   = WS_GR + 128 * MiB;
constexpr size_t WS_GT   = WS_GA + 128 * MiB;
constexpr size_t WS_ST   = WS_GT + 128 * MiB;
constexpr size_t WS_YA   = WS_ST + 128 * MiB;
constexpr size_t WS_YR   = WS_YA + 64 * MiB;
constexpr size_t WS_END  = WS_YR + 128 * MiB;
constexpr size_t WS_U8   = WS_QA;
constexpr size_t WS_V8   = WS_QA + 64 * MiB;
constexpr size_t WS_SCU  = WS_QA + 128 * MiB;
constexpr size_t WS_SCV  = WS_QA + 129 * MiB;
constexpr size_t WS_EID  = WS_QA + 256 * MiB;
constexpr size_t WS_GW   = WS_QA + 264 * MiB;
static_assert(WS_GW + 8 * MiB <= WS_CUM, "overlay fits in the dead QA..VR region");
static_assert(WS_END <= 1745879040ull, "workspace map fits 4 x sizeof(w_in)");
static_assert(WS_QP + 64 * MiB <= WS_P1 && WS_UX + 130 * MiB <= WS_P1, "T1 map");

constexpr int CW_TMO = 0, CW_CODE = 1;
constexpr int CW_BAR = 4096;
constexpr int CW_DBG = 65536;

constexpr int RING_OFF = 0, RING_BYTES = 131072;
constexpr int LDSX_OFF = RING_BYTES;
constexpr int LDSCTL_OFF = RING_BYTES + 24576, MISC_OFF = LDSCTL_OFF + 320;
constexpr int LDS_BYTES = LDSCTL_OFF + 1024;
static_assert(LDS_BYTES <= 163840, "LDS");

#define GAS __attribute__((address_space(1)))
#define LAS __attribute__((address_space(3)))
typedef unsigned short bf16;
typedef unsigned v4u __attribute__((ext_vector_type(4)));
typedef unsigned v2u __attribute__((ext_vector_type(2)));
typedef float f32x4 __attribute__((ext_vector_type(4)));
typedef float f32x2 __attribute__((ext_vector_type(2)));
typedef float f32x16 __attribute__((ext_vector_type(16)));
typedef short bf16x8 __attribute__((ext_vector_type(8)));
typedef short s16x4 __attribute__((ext_vector_type(4)));
typedef __bf16 bf16x2_t __attribute__((ext_vector_type(2)));
typedef GAS unsigned gu32;
#define RLX_AGENT __ATOMIC_RELAXED, __HIP_MEMORY_SCOPE_AGENT
#define LDS_WAIT() asm volatile("s_waitcnt lgkmcnt(0)" ::: "memory")
#define VM_WAIT() asm volatile("s_waitcnt vmcnt(0)" ::: "memory")
#define SBAR() __builtin_amdgcn_sched_barrier(0)
__device__ __forceinline__ unsigned f2bf(float f) { unsigned u = __builtin_bit_cast(unsigned, f); return (u + 0x7fffu + ((u >> 16) & 1u)) >> 16; }
__device__ __forceinline__ unsigned pk2(float lo, float hi) { return f2bf(lo) | (f2bf(hi) << 16); }
__device__ __forceinline__ unsigned cvtpk(float lo, float hi) { unsigned r; asm volatile("v_cvt_pk_bf16_f32 %0, %1, %2" : "=v"(r) : "v"(lo), "v"(hi)); return r; }
__device__ __forceinline__ float bflo(unsigned w) { return __uint_as_float(w << 16); }
__device__ __forceinline__ float bfhi(unsigned w) { return __uint_as_float(w & 0xffff0000u); }
__device__ __forceinline__ float fast_exp2(float x) { return __builtin_amdgcn_exp2f(x); }
__device__ __forceinline__ float fast_rcp(float x) { return __builtin_amdgcn_rcpf(x); }
__device__ __forceinline__ float sigmoidf_(float x) { return fast_rcp(1.f + fast_exp2(-1.4426950408889634f * x)); }
__device__ __forceinline__ float wave_sum(float v) {
#pragma unroll
    for (int o = 1; o < 64; o <<= 1) v += __shfl_xor(v, o);
    return v;
}
namespace pg8 {
#define PG8_LAS __attribute__((address_space(3)))
typedef unsigned short bf16_t;
typedef short bf16x8 __attribute__((ext_vector_type(8)));
typedef float f32x4 __attribute__((ext_vector_type(4)));
typedef unsigned u32x4 __attribute__((ext_vector_type(4)));
constexpr int BM = 256, BK = 64, HALF = 128, HTB = HALF * BK * 2  , STAGE_BYTES = 8 * HTB, NXCD = 8, WGM = 8;

__host__ __device__ __forceinline__ int lds_byte(int r, int c) { const int st = (r >> 4) * 2 + (c >> 5), rr = r & 15, cc = c & 31, ob = rr * 64 + cc * 2; return st * 1024 + (ob ^ (((ob >> 9) & 1) << 5)); }
__host__ __device__ __forceinline__ void stage_rc(int b, int& R, int& C) { const int st = b / 1024, sb = b % 1024, swz = sb ^ (((sb >> 9) & 1) << 5); R = (st >> 1) * 16 + swz / 64; C = (st & 1) * 32 + (swz % 64) / 2; }
__host__ __device__ __forceinline__ int perm32(int rho) { const int n = rho >> 4, i = rho & 15; return 8 * (i >> 2) + 4 * n + (i & 3); }

struct Unit { int pm, pn; };
struct Gemm { const bf16_t* A; const bf16_t* Bt; int M, N, K; };

struct StaticOrder {
    int nM, nN, nwg, G, c;
    __host__ __device__ void init(int M, int N, int G_, int c_) { nM = M / BM; nN = N / BM; nwg = nM * nN; G = G_; c = c_; }
    __host__ __device__ bool next(int i, Unit& u) const {
        const long L = (long)i * G + c; if (L >= nwg) return false;
        int wgid = (int)L; { const int q = nwg / NXCD, r = nwg % NXCD, xcd = wgid % NXCD, off = wgid / NXCD; wgid = (xcd < r ? xcd * (q + 1) : r * (q + 1) + (xcd - r) * q) + off; }
        const int nig = WGM * nN, gid = wgid / nig, fm = gid * WGM, gsz = (nM - fm) < WGM ? (nM - fm) : WGM;
        u.pm = fm + ((wgid % nig) % gsz); u.pn = (wgid % nig) / gsz; return true;
    }
    __device__ __forceinline__ void a_ready(const Unit&) const {}
    __device__ __forceinline__ void done(const Unit&) const {}
};

__device__ __forceinline__ unsigned cvt_pk_bf16(float lo, float hi) { unsigned r; asm volatile("v_cvt_pk_bf16_f32 %0, %1, %2" : "=v"(r) : "v"(lo), "v"(hi)); return r; }
typedef float f32x2 __attribute__((ext_vector_type(2)));
}
__device__ const double ROT_REV[64] = {
    1.59154943091895346e-01, 1.37822502603982849e-01, 1.19349370211248862e-01, 1.03352296618434064e-01,
    8.94994016088910133e-02, 7.75032887553740585e-02, 6.71150830052272551e-02, 5.81192674418762462e-02,
    5.03292121044870353e-02, 4.35833021053073297e-02, 3.77415847174197711e-02, 3.26828658723569976e-02,
    2.83021958306233987e-02, 2.45086918620698521e-02, 2.12236527647776604e-02, 1.83789261056796667e-02,
    1.59154943091895339e-02, 1.37822502603982839e-02, 1.19349370211248862e-02, 1.03352296618434061e-02,
    8.94994016088910237e-03, 7.75032887553740550e-03, 6.71150830052272534e-03, 5.81192674418762410e-03,
    5.03292121044870370e-03, 4.35833021053073314e-03, 3.77415847174197719e-03, 3.26828658723569932e-03,
    2.83021958306233987e-03, 2.45086918620698521e-03, 2.12236527647776622e-03, 1.83789261056796667e-03,
    1.59154943091895356e-03, 1.37822502603982878e-03, 1.19349370211248849e-03, 1.03352296618434048e-03,
    8.94994016088910237e-04, 7.75032887553740507e-04, 6.71150830052272599e-04, 5.81192674418762388e-04,
    5.03292121044870326e-04, 4.35833021053073292e-04, 3.77415847174197741e-04, 3.26828658723569922e-04,
    2.83021958306233954e-04, 2.45086918620698543e-04, 2.12236527647776605e-04, 1.83789261056796662e-04,
    1.59154943091895351e-04, 1.37822502603982856e-04, 1.19349370211248862e-04, 1.03352296618434061e-04,
    8.94994016088910182e-05, 7.75032887553740561e-05, 6.71150830052272545e-05, 5.81192674418762388e-05,
    5.03292121044870354e-05, 4.35833021053073225e-05, 3.77415847174197768e-05, 3.26828658723569989e-05,
    2.83021958306233961e-05, 2.45086918620698523e-05, 2.12236527647776592e-05, 1.83789261056796682e-05,
};
namespace pg8 {
#if 1
typedef unsigned char* rsrc_t;
__device__ __forceinline__ rsrc_t mk_rsrc(const void* p, unsigned) { return (unsigned char*)p; }
#else
typedef __amdgpu_buffer_rsrc_t rsrc_t;
__device__ __forceinline__ rsrc_t mk_rsrc(const void* p, unsigned bytes) { return __builtin_amdgcn_make_buffer_rsrc((void*)p, 0, bytes, 0x00020000); }
#endif
__device__ __forceinline__ void st8b(rsrc_t rs, int voff, int soff, const f32x4& a, const f32x4& b) {
    u32x4 w; w.x = cvt_pk_bf16(a[0], a[1]); w.y = cvt_pk_bf16(a[2], a[3]); w.z = cvt_pk_bf16(b[0], b[1]); w.w = cvt_pk_bf16(b[2], b[3]);
#if 1
    *(u32x4*)((rs + (size_t)(unsigned)soff) + (unsigned)voff) = w;
#else
    __builtin_amdgcn_raw_buffer_store_b128(w, rs, voff, soff, 0);
#endif
}
__device__ __forceinline__ float silu1(float x) { return x * __builtin_amdgcn_rcpf(1.f + __builtin_amdgcn_exp2f(-1.4426950408889634f * x)); }
__device__ __forceinline__ float sigm1(float x) { return __builtin_amdgcn_rcpf(1.f + __builtin_amdgcn_exp2f(-1.4426950408889634f * x)); }
__device__ __forceinline__ float logsig1(float x) {
    const float e = __builtin_amdgcn_exp2f(-1.4426950408889634f * __builtin_fabsf(x));
    return fminf(x, 0.f) - 0.6931471805599453f * __builtin_amdgcn_logf(1.f + e);
}
#if 1
#define ST1(so) (*(float*)((rs + (size_t)(unsigned)(so)) + (unsigned)voff) = lf)
#else
#define ST1(so) __builtin_amdgcn_raw_buffer_store_b32(__float_as_uint(lf), rs, voff, (so), 0)
#endif
#ifndef EPIZ_SECS
#define EPIZ_SECS 31
#endif
struct EpiZ {
    static constexpr bool PERM = true, AFTER_DRAIN = false;
    unsigned char* ws; const float* b_forget;
    __device__ __forceinline__ void operator()(const f32x4 (&acc)[2][2][4][2], const Unit& u, int wr, int wc, int fr, int fq) const {
        int fr_ = fr, fq_ = fq; asm volatile("" : "+v"(fr_), "+v"(fq_));
        body(acc, u, wr, wc, fr_, fq_);
    }
    __device__ __forceinline__ void body(const f32x4 (&acc)[2][2][4][2], const Unit& u, int wr, int wc, int fr, int fq) const {
        const int pn = u.pn, pm = u.pm;
        const bool meta_tile = (pm == MTOK / 256);
        const int b = pm >> 5;
        const int tu0 = (pm & 31) * 256 + wr * 64;
        if (pn < 24) {
            const int sec = pn >> 3, hb = (pn & 7) * 2;
            if (!(EPIZ_SECS & 1)) return;
            if (meta_tile && (sec == 0 || wr != 0)) return;
            const int rows_per = sec == 0 ? SEQ : SKV, roff = sec == 0 ? 0 : 64;
            const rsrc_t rs = mk_rsrc(ws + (sec == 0 ? WS_QA : (sec == 1 ? WS_KA : WS_VA)), (unsigned)(NB * NH) * rows_per * HD * 2);
            const int voff = (fr * HD + 8 * fq) * 2;
            if (!meta_tile) {
#pragma unroll
                for (int ai = 0; ai < 2; ++ai)
#pragma unroll
                    for (int m = 0; m < 4; ++m)
#pragma unroll
                        for (int bj = 0; bj < 2; ++bj)
                            st8b(rs, voff, (((b * NH + hb + bj) * rows_per + roff + tu0 + ai * 128 + m * 16) * HD + wc * 32) * 2, acc[ai][bj][m][0], acc[ai][bj][m][1]);
            } else {
#pragma unroll
                for (int bj = 0; bj < 2; ++bj)
#pragma unroll
                    for (int bb = 0; bb < NB; ++bb) st8b(rs, voff, (((bb * NH + hb + bj) * rows_per + 48) * HD + wc * 32) * 2, acc[0][bj][0][0], acc[0][bj][0][1]);
            }
        } else if (pn < 40) {
            const bool isk = pn >= 32; const int hb = ((pn - 24) & 7) * 2;
            if (!(EPIZ_SECS & 2)) return;
            if (meta_tile && (!isk || wr != 0)) return;
            const rsrc_t rs = mk_rsrc(ws + (isk ? WS_KR : WS_QR), (unsigned)(NB * NH) * LR * HD * 2);
            const float sc = isk ? 0.08838834764831845f : 1.f;
            const int voff = (fr * HD + 8 * fq) * 2;
            double rr[4];
#pragma unroll
            for (int p = 0; p < 4; ++p) rr[p] = ROT_REV[wc * 16 + 4 * fq + p];
#pragma unroll
            for (int ai = 0; ai < 2; ++ai)
#pragma unroll
                for (int m = 0; m < 4; ++m) {
                    if (meta_tile && (ai != 0 || m != 0)) continue;
                    const int pos = meta_tile ? fr : (NMETA + tu0 + ai * 128 + m * 16 + fr);
                    float cs[4], sn[4];
#pragma unroll
                    for (int p = 0; p < 4; ++p) { double rv = (double)pos * rr[p]; rv -= __builtin_floor(rv); const float rf = (float)rv; sn[p] = __builtin_amdgcn_sinf(rf) * sc; cs[p] = __builtin_amdgcn_cosf(rf) * sc; }
#pragma unroll
                    for (int bj = 0; bj < 2; ++bj) {
                        const f32x4 a = acc[ai][bj][m][0], c = acc[ai][bj][m][1];
                        f32x4 oa, oc;
                        oa[0] = a[0] * cs[0] - a[1] * sn[0]; oa[1] = a[0] * sn[0] + a[1] * cs[0];
                        oa[2] = a[2] * cs[1] - a[3] * sn[1]; oa[3] = a[2] * sn[1] + a[3] * cs[1];
                        oc[0] = c[0] * cs[2] - c[1] * sn[2]; oc[1] = c[0] * sn[2] + c[1] * cs[2];
                        oc[2] = c[2] * cs[3] - c[3] * sn[3]; oc[3] = c[2] * sn[3] + c[3] * cs[3];
                        if (!meta_tile) st8b(rs, voff, (((b * NH + hb + bj) * LR + 128 + tu0 + ai * 128 + m * 16) * HD + wc * 32) * 2, oa, oc);
                        else {
#pragma unroll
                            for (int bb = 0; bb < NB; ++bb) st8b(rs, voff, (((bb * NH + hb + bj) * LR + 112) * HD + wc * 32) * 2, oa, oc);
                        }
                    }
                    __builtin_amdgcn_sched_barrier(0);
                }
        } else if (pn < 56) {
            const int h = pn - 40;
            if (!(EPIZ_SECS & 4)) return;
            if (meta_tile && wr != 0) return;
            const rsrc_t rs = mk_rsrc(ws + WS_VR, (unsigned)(NB * NH) * LR * RDV * 2);
            const int voff = (fr * RDV + 8 * fq) * 2;
            if (!meta_tile) {
#pragma unroll
                for (int ai = 0; ai < 2; ++ai)
#pragma unroll
                    for (int m = 0; m < 4; ++m)
#pragma unroll
                        for (int bj = 0; bj < 2; ++bj)
                            st8b(rs, voff, (((b * NH + h) * LR + 128 + tu0 + ai * 128 + m * 16) * RDV + bj * 128 + wc * 32) * 2, acc[ai][bj][m][0], acc[ai][bj][m][1]);
            } else {
#pragma unroll
                for (int bj = 0; bj < 2; ++bj)
#pragma unroll
                    for (int bb = 0; bb < NB; ++bb) st8b(rs, voff, (((bb * NH + h) * LR + 112) * RDV + bj * 128 + wc * 32) * 2, acc[0][bj][0][0], acc[0][bj][0][1]);
            }
        } else if (pn < 104) {
            if (meta_tile || !(EPIZ_SECS & 8)) return;
            const int sec = (pn - 56) >> 4;
            const rsrc_t rs = mk_rsrc(ws + (sec == 0 ? WS_GR : (sec == 1 ? WS_GA : WS_GT)), (unsigned)MTOK * DM * 2);
            const int voff = (fr * DM + 8 * fq) * 2, c0 = ((pn - 56) & 15) * 256 + wc * 32;
#pragma unroll
            for (int ai = 0; ai < 2; ++ai)
#pragma unroll
                for (int m = 0; m < 4; ++m) {
#pragma unroll
                    for (int bj = 0; bj < 2; ++bj) { f32x4 a = acc[ai][bj][m][0], c = acc[ai][bj][m][1];
                        if (sec == 0) {
#pragma unroll
                            for (int k = 0; k < 4; ++k) { a[k] = silu1(a[k]); c[k] = silu1(c[k]); }
                        } else {
#pragma unroll
                            for (int k = 0; k < 4; ++k) { a[k] = sigm1(a[k]); c[k] = sigm1(c[k]); }
                        }
                        st8b(rs, voff, ((pm * 256 + wr * 64 + ai * 128 + m * 16) * DM + c0 + bj * 128) * 2, a, c); }
                    __builtin_amdgcn_sched_barrier(0);
                }
        } else {
            if (!(EPIZ_SECS & 16)) return;
            if (wc != 0 || fq >= 2 || (meta_tile && wr != 0)) return;
            const rsrc_t rs = mk_rsrc(ws + WS_CUM, (unsigned)(NB * NH) * SKV * 4);
            const f32x4 b0 = *(const f32x4*)(b_forget + 8 * fq), b1 = *(const f32x4*)(b_forget + 8 * fq + 4);
            const int voff = (8 * fq * SKV + fr) * 4;
#pragma unroll
            for (int ai = 0; ai < 2; ++ai)
#pragma unroll
                for (int m = 0; m < 4; ++m) {
                    if (meta_tile && (ai != 0 || m != 0)) continue;
                    const f32x4 a = acc[ai][0][m][0] + b0, c = acc[ai][0][m][1] + b1;
#pragma unroll
                    for (int k = 0; k < 8; ++k) { const float lf = logsig1(k < 4 ? a[k] : c[k - 4]);
                        if (!meta_tile) ST1(((b * NH + k) * SKV + 64 + tu0 + ai * 128 + m * 16) * 4);
                        else { ST1(((0 * NH + k) * SKV + 48) * 4); ST1(((1 * NH + k) * SKV + 48) * 4); } }
                }
        }
    }
};
}
namespace pg8 {
__device__ __forceinline__ void unpack8(const u32x4 w, float (&f)[8]) {
    f[0] = __uint_as_float(w.x << 16); f[1] = __uint_as_float(w.x & 0xffff0000u); f[2] = __uint_as_float(w.y << 16); f[3] = __uint_as_float(w.y & 0xffff0000u);
    f[4] = __uint_as_float(w.z << 16); f[5] = __uint_as_float(w.z & 0xffff0000u); f[6] = __uint_as_float(w.w << 16); f[7] = __uint_as_float(w.w & 0xffff0000u);
}
template <int MODE> struct EpiGate {
    static constexpr bool PERM = true, AFTER_DRAIN = false;
    bf16_t* O; const bf16_t* G; int ldc;
    __device__ __forceinline__ void operator()(const f32x4 (&acc)[2][2][4][2], const Unit& u, int wr, int wc, int fr, int fq) const {
        const int row0 = u.pm * BM + wr * 64 + fr, col0 = u.pn * BM + wc * 32 + 8 * fq;
#pragma unroll
        for (int ai = 0; ai < 2; ++ai)
#pragma unroll
            for (int m = 0; m < 4; ++m) { const size_t off = (size_t)(row0 + ai * HALF + m * 16) * ldc + col0;
#pragma unroll
                for (int bj = 0; bj < 2; ++bj) { f32x4 v0 = acc[ai][bj][m][0], v1 = acc[ai][bj][m][1];
                    if (MODE != 2) { float g[8]; unpack8(*(const u32x4*)(G + off + bj * HALF), g);
                        v0[0] *= g[0]; v0[1] *= g[1]; v0[2] *= g[2]; v0[3] *= g[3]; v1[0] *= g[4]; v1[1] *= g[5]; v1[2] *= g[6]; v1[3] *= g[7]; }
                    if (MODE == 1) { float t[8]; unpack8(*(const u32x4*)(O + off + bj * HALF), t);
                        v0[0] += t[0]; v0[1] += t[1]; v0[2] += t[2]; v0[3] += t[3]; v1[0] += t[4]; v1[1] += t[5]; v1[2] += t[6]; v1[3] += t[7]; }
                    u32x4 w; w.x = cvt_pk_bf16(v0[0], v0[1]); w.y = cvt_pk_bf16(v0[2], v0[3]); w.z = cvt_pk_bf16(v1[0], v1[1]); w.w = cvt_pk_bf16(v1[2], v1[3]);
                    *(u32x4*)(O + off + bj * HALF) = w; } }
    }
};
struct EpiResF32 {
    static constexpr bool PERM = false, AFTER_DRAIN = false;
    const float* base; float* out; int ldc;
    __device__ __forceinline__ void operator()(const f32x4 (&acc)[2][2][4][2], const Unit& u, int wr, int wc, int fr, int fq) const {
        const int row0 = u.pm * BM + wr * 64 + fr, col0 = u.pn * BM + wc * 32 + 4 * fq;
#pragma unroll
        for (int ai = 0; ai < 2; ++ai)
#pragma unroll
            for (int m = 0; m < 4; ++m) { const size_t off = (size_t)(row0 + ai * HALF + m * 16) * ldc + col0;
#pragma unroll
                for (int bj = 0; bj < 2; ++bj)
#pragma unroll
                    for (int n = 0; n < 2; ++n) { const f32x4 bs = *(const f32x4*)(base + off + bj * HALF + n * 16); *(f32x4*)(out + off + bj * HALF + n * 16) = bs + acc[ai][bj][m][n]; } }
    }
};
}
namespace pg8 {
template <class Epi, class Sched, bool ALIGN_EPI = false, bool SP2 = false>
__device__ __forceinline__ void gemm_phase(PG8_LAS unsigned char* lds, const Gemm g, const Sched& S, const Epi& E) {
    const int tid = threadIdx.x, wid = __builtin_amdgcn_readfirstlane(tid >> 6), lane = tid & 63, wr = wid >> 2, wc = wid & 3, fr = lane & 15, fq = lane >> 4;
    const int K = g.K, nt = K / BK;
    unsigned voffA[2], voffB[2];
#pragma unroll
    for (int i = 0; i < 2; ++i) { int R, C; stage_rc(tid * 16 + i * 8192, R, C); const int Rb = Epi::PERM ? ((R & ~31) + perm32(R & 31)) : R;
        voffA[i] = (unsigned)(R * K + C) * 2u; voffB[i] = (unsigned)(Rb * K + C) * 2u; }
    const size_t kstep = (size_t)(BK * 2);
    const size_t hstep = (size_t)HALF * K * 2;
    const size_t tstep = 2 * hstep;
    const unsigned ldsw = (unsigned)wid * 1024u;
    const int aoff = lds_byte(wr * 64 + fr, fq * 8), boff = lds_byte(wc * 32 + fr, fq * 8);
#define PG8_SA(b, h) (((b) * 2 + (h)) * HTB)
#define PG8_SB(b, h) ((4 + (b) * 2 + (h)) * HTB)
#define PG8_STAGE(bufoff, gbase, voff) do { _Pragma("unroll") for (int _i = 0; _i < 2; ++_i) \
        __builtin_amdgcn_global_load_lds((const unsigned*)((const char*)(gbase) + (voff)[_i]), (PG8_LAS unsigned*)(lds + (bufoff) + ldsw + _i * 8192), 16, 0, 0); } while (0)
#define PG8_LDA(dst, b, h) do { _Pragma("unroll") for (int m = 0; m < 4; ++m) _Pragma("unroll") for (int k = 0; k < 2; ++k) dst[m][k] = *(const PG8_LAS bf16x8*)(lds + PG8_SA(b, h) + aoff + m * 2048 + k * 1024); } while (0)
#define PG8_LDB(dst, b, h) do { _Pragma("unroll") for (int n = 0; n < 2; ++n) _Pragma("unroll") for (int k = 0; k < 2; ++k) dst[n][k] = *(const PG8_LAS bf16x8*)(lds + PG8_SB(b, h) + boff + n * 2048 + k * 1024); } while (0)
#define PG8_MMA(ai, bj, At, Bt) do { __builtin_amdgcn_s_setprio(1); _Pragma("unroll") for (int m = 0; m < 4; ++m) _Pragma("unroll") for (int n = 0; n < 2; ++n) _Pragma("unroll") for (int k = 0; k < 2; ++k) \
        acc[ai][bj][m][n] = __builtin_amdgcn_mfma_f32_16x16x32_bf16(Bt[n][k], At[m][k], acc[ai][bj][m][n], 0, 0, 0); __builtin_amdgcn_s_setprio(0); } while (0)
#define PG8_WAIT_V(n) asm volatile("s_waitcnt vmcnt(" #n ")" ::: "memory")
#define PG8_WAIT_L(n) asm volatile("s_waitcnt lgkmcnt(" #n ")" ::: "memory")
#define PG8_BAR __builtin_amdgcn_s_barrier()
#define PG8_SCHED __builtin_amdgcn_sched_barrier(0)
    Unit cur, nxt; int ui = 0;
    if (!S.next(0, cur)) return;
    f32x4 acc[2][2][4][2];
#pragma unroll
    for (int a = 0; a < 2; ++a)
#pragma unroll
        for (int b = 0; b < 2; ++b)
#pragma unroll
            for (int m = 0; m < 4; ++m)
#pragma unroll
                for (int n = 0; n < 2; ++n) acc[a][b][m][n] = (f32x4){0.f, 0.f, 0.f, 0.f};
    bf16x8 At[4][2], B0[2][2], B1[2][2];
    const char* cA = (const char*)g.A + (size_t)cur.pm * tstep; const char* cB = (const char*)g.Bt + (size_t)cur.pn * tstep;
    S.a_ready(cur);
    if constexpr (SP2) {
        PG8_STAGE(PG8_SB(0, 0), cB, voffB); PG8_STAGE(PG8_SB(0, 1), cB + hstep, voffB); PG8_STAGE(PG8_SA(0, 0), cA, voffA); PG8_STAGE(PG8_SA(0, 1), cA + hstep, voffA);
        if (wr == 1) PG8_BAR;
        PG8_WAIT_V(2); PG8_BAR;
        PG8_STAGE(PG8_SB(1, 0), cB + kstep, voffB); PG8_STAGE(PG8_SA(1, 0), cA + kstep, voffA); PG8_STAGE(PG8_SB(1, 1), cB + hstep + kstep, voffB);
        PG8_WAIT_V(6); PG8_BAR;
    } else {
        PG8_STAGE(PG8_SB(0, 0), cB, voffB); PG8_STAGE(PG8_SA(0, 0), cA, voffA); PG8_STAGE(PG8_SB(0, 1), cB + hstep, voffB); PG8_STAGE(PG8_SA(0, 1), cA + hstep, voffA);
        if (wr == 1) PG8_BAR;
        PG8_WAIT_V(4); PG8_BAR;
        PG8_STAGE(PG8_SB(1, 0), cB + kstep, voffB); PG8_STAGE(PG8_SA(1, 0), cA + kstep, voffA); PG8_STAGE(PG8_SB(1, 1), cB + hstep + kstep, voffB);
        PG8_WAIT_V(6); PG8_BAR;
    }
    for (;;) {
        const bool has_next = S.next(ui + 1, nxt);
        const char* nA = has_next ? (const char*)g.A + (size_t)nxt.pm * tstep : cA; const char* nB = has_next ? (const char*)g.Bt + (size_t)nxt.pn * tstep : cB;
        for (int t = 0; t < nt; t += 2) {
            const bool last = (t == nt - 2);
            const char* a1 = cA + (size_t)(t + 1) * kstep;
            const char* a2 = last ? nA : cA + (size_t)(t + 2) * kstep; const char* b2 = last ? nB : cB + (size_t)(t + 2) * kstep;
            const char* a3 = a2 + kstep; const char* b3 = b2 + kstep;
            if (last && has_next) S.a_ready(nxt);
            if constexpr (SP2) {
            PG8_LDB(B0, 0, 0); PG8_LDB(B1, 0, 1); PG8_SCHED; PG8_LDA(At, 0, 0); PG8_STAGE(PG8_SA(1, 1), a1 + hstep, voffA);
            PG8_WAIT_V(8); PG8_WAIT_L(0); PG8_BAR; PG8_MMA(0, 0, At, B0); PG8_MMA(0, 1, At, B1); PG8_BAR; PG8_SCHED;
            PG8_LDA(At, 0, 1); PG8_STAGE(PG8_SB(0, 0), b2, voffB); PG8_STAGE(PG8_SB(0, 1), b2 + hstep, voffB); PG8_STAGE(PG8_SA(0, 0), a2, voffA);
            PG8_WAIT_V(8); PG8_WAIT_L(0); PG8_BAR; PG8_MMA(1, 0, At, B0); PG8_MMA(1, 1, At, B1); PG8_BAR; PG8_SCHED;
            PG8_LDB(B0, 1, 0); PG8_LDB(B1, 1, 1); PG8_SCHED; PG8_LDA(At, 1, 0); PG8_STAGE(PG8_SA(0, 1), a2 + hstep, voffA);
            PG8_WAIT_V(8); PG8_WAIT_L(0); PG8_BAR; PG8_MMA(0, 0, At, B0); PG8_MMA(0, 1, At, B1); PG8_BAR; PG8_SCHED;
            PG8_LDA(At, 1, 1); PG8_STAGE(PG8_SB(1, 0), b3, voffB); PG8_STAGE(PG8_SB(1, 1), b3 + hstep, voffB); PG8_STAGE(PG8_SA(1, 0), a3, voffA);
            PG8_WAIT_V(8); PG8_WAIT_L(0); PG8_BAR; PG8_MMA(1, 0, At, B0); PG8_MMA(1, 1, At, B1); PG8_BAR; PG8_SCHED;
            } else {
            PG8_LDB(B0, 0, 0); PG8_SCHED; PG8_LDA(At, 0, 0); PG8_STAGE(PG8_SA(1, 1), a1 + hstep, voffA);
            PG8_WAIT_L(8); PG8_BAR; PG8_WAIT_L(0); PG8_MMA(0, 0, At, B0); PG8_BAR; PG8_SCHED;
            PG8_LDB(B1, 0, 1); PG8_STAGE(PG8_SB(0, 0), b2, voffB);
            PG8_BAR; PG8_WAIT_L(0); PG8_MMA(0, 1, At, B1); PG8_BAR;
            PG8_LDA(At, 0, 1); PG8_STAGE(PG8_SA(0, 0), a2, voffA);
            PG8_BAR; PG8_WAIT_L(0); PG8_MMA(1, 0, At, B0); PG8_BAR; PG8_SCHED;
            PG8_STAGE(PG8_SB(0, 1), b2 + hstep, voffB);
            PG8_WAIT_V(6); PG8_BAR; PG8_MMA(1, 1, At, B1); PG8_BAR;
            PG8_LDB(B0, 1, 0); PG8_SCHED; PG8_LDA(At, 1, 0); PG8_STAGE(PG8_SA(0, 1), a2 + hstep, voffA);
            PG8_WAIT_L(8); PG8_BAR; PG8_WAIT_L(0); PG8_MMA(0, 0, At, B0); PG8_BAR; PG8_SCHED;
            PG8_LDB(B1, 1, 1); PG8_STAGE(PG8_SB(1, 0), b3, voffB);
            PG8_BAR; PG8_WAIT_L(0); PG8_MMA(0, 1, At, B1); PG8_BAR;
            PG8_LDA(At, 1, 1); PG8_STAGE(PG8_SA(1, 0), a3, voffA);
            PG8_BAR; PG8_WAIT_L(0); PG8_MMA(1, 0, At, B0); PG8_BAR; PG8_SCHED;
            PG8_STAGE(PG8_SB(1, 1), b3 + hstep, voffB);
            PG8_WAIT_V(6); PG8_BAR; PG8_MMA(1, 1, At, B1); PG8_BAR;
            }
        }
        if constexpr (ALIGN_EPI) { if (wr == 0) PG8_BAR; }
        if constexpr (!Epi::AFTER_DRAIN) { E(acc, cur, wr, wc, fr, fq); S.done(cur); }
        if (!has_next) break;
#pragma unroll
        for (int a = 0; a < 2; ++a)
#pragma unroll
            for (int b = 0; b < 2; ++b)
#pragma unroll
                for (int m = 0; m < 4; ++m)
#pragma unroll
                    for (int n = 0; n < 2; ++n) acc[a][b][m][n] = (f32x4){0.f, 0.f, 0.f, 0.f};
        cur = nxt; cA = nA; cB = nB; ++ui;
        if constexpr (ALIGN_EPI) { if (wr == 1) PG8_BAR; }
    }
    PG8_WAIT_V(0);
    if constexpr (!ALIGN_EPI) { if (wr == 0) PG8_BAR; }
    PG8_BAR;
    if constexpr (Epi::AFTER_DRAIN) { E.fused(acc, cur, wr, wc, fr, fq, lds, wid, lane); S.done(cur); }
#undef PG8_SA
#undef PG8_SB
#undef PG8_STAGE
#undef PG8_LDA
#undef PG8_LDB
#undef PG8_MMA
#undef PG8_WAIT_V
#undef PG8_WAIT_L
#undef PG8_BAR
#undef PG8_SCHED
}
}
#define XB_TMO      128
#define XB_XCNT(j)  (256  + 64 * (j))
#define XB_XSUB(j)  (1280 + 64 * (j))
#define XB_XGEN(j)  (2304 + 64 * (j))
#define XB_TOP      3328
#define XB_TOPGEN   3392
#define XCD_BAR_WORDS 3456
#define XB_SPIN_CAP (1u << 22)

__device__ __forceinline__ unsigned xb_ld(unsigned* p)              { return __hip_atomic_load(p, __ATOMIC_RELAXED, __HIP_MEMORY_SCOPE_AGENT); }
__device__ __forceinline__ unsigned xb_add(unsigned* p, unsigned v) { return __hip_atomic_fetch_add(p, v, __ATOMIC_RELAXED, __HIP_MEMORY_SCOPE_AGENT); }
__device__ __forceinline__ unsigned xb_xcc_id() { return (unsigned)__builtin_amdgcn_s_getreg((3 << 11) | 20) & 0xFu; }
#define XB_SPIN(cond, bar) do { unsigned _sp = 0; while (cond) { __builtin_amdgcn_s_sleep(1); \
    if ((++_sp & 255u) == 0u) { if (xb_ld(&(bar)[XB_TMO])) break; if (_sp > XB_SPIN_CAP) { atomicAdd(&(bar)[XB_TMO], 1u); break; } } } } while (0)

struct XcdBarrier {
    unsigned* bar; unsigned x;
    volatile LAS unsigned* st;
};

__device__ __forceinline__ XcdBarrier xcd_barrier_post(unsigned* bar, volatile LAS unsigned* st) {
    XcdBarrier b; b.bar = bar; b.x = xb_xcc_id(); b.st = st;
    if (threadIdx.x == 0) (void)xb_add(&bar[XB_XCNT(b.x)], 1u);
    return b;
}
__device__ __forceinline__ void xcd_barrier_complete(unsigned* bar, unsigned x, unsigned& nloc, unsigned& nx) {
    const unsigned G = gridDim.x * gridDim.y * gridDim.z;
    unsigned sum, cnt, mine, sp = 0u;
    for (;;) {
        sum = 0u; cnt = 0u; mine = 0u;
#pragma unroll
        for (unsigned j = 0; j < 16; ++j) { const unsigned c = xb_ld(&bar[XB_XCNT(j)]); sum += c; cnt += (c > 0u) ? 1u : 0u; mine = (j == x) ? c : mine; }
        if (sum == G) break;
        __builtin_amdgcn_s_sleep(1);
        if ((++sp & 255u) == 0u) { if (xb_ld(&bar[XB_TMO])) break; if (sp > XB_SPIN_CAP) { atomicAdd(&bar[XB_TMO], 1u); break; } }
    }
    nloc = mine > 0u ? mine : 1u; nx = cnt > 0u ? cnt : 1u;
}

__device__ __forceinline__ void xcd_barrier(const XcdBarrier& b) {
    asm volatile("s_waitcnt vmcnt(0)" ::: "memory");
    __syncthreads();
    if (threadIdx.x == 0) {
        unsigned* bar = b.bar;
        __builtin_amdgcn_s_waitcnt(0);
        unsigned nloc = b.st[0], nx = b.st[1];
        if (nloc == 0u) { xcd_barrier_complete(bar, b.x, nloc, nx); b.st[0] = nloc; b.st[1] = nx; }
        const unsigned old = xb_add(&bar[XB_XSUB(b.x)], 1u);
        const unsigned gen = old / nloc;
        if (old + 1u == (gen + 1u) * nloc) {
            __builtin_amdgcn_fence(__ATOMIC_RELEASE, "agent");
            asm volatile("s_waitcnt vmcnt(0)" ::: "memory");
            const unsigned og = xb_add(&bar[XB_TOP], 1u);
            const unsigned tg = og / nx;
            if (og + 1u == (tg + 1u) * nx) xb_add(&bar[XB_TOPGEN], 1u);
            else XB_SPIN(xb_ld(&bar[XB_TOPGEN]) == tg, bar);
            __builtin_amdgcn_fence(__ATOMIC_ACQUIRE, "agent");
            xb_add(&bar[XB_XGEN(b.x)], 1u);
            asm volatile("s_waitcnt vmcnt(0)" ::: "memory");
        } else {
            XB_SPIN(xb_ld(&bar[XB_XGEN(b.x)]) == gen, bar);
            __builtin_amdgcn_fence(__ATOMIC_ACQUIRE, "agent");
            asm volatile("s_waitcnt vmcnt(0)" ::: "memory");
        }
    }
    __syncthreads();
}
struct Frame {
    LAS unsigned char* lds;
    volatile LAS unsigned* MISC;
    gu32* ctl;
    int tid, lane, wave;
    int vcu, G;
    unsigned char* ws;
    const float *x, *meta, *g_mix, *w_in, *b_forget, *g_q, *g_k, *g_ret, *w_fox, *w_ret, *w_out, *g_ffn, *w_q, *keys1, *keys2, *pu, *pv;
    float* out;
};
template <class T> __device__ __forceinline__ T* wsp(const Frame& F, size_t off) { return (T*)(F.ws + off); }

__device__ __forceinline__ int z_src_col(int n) {
    if (n < Z_QR) return n;
    if (n < Z_VR) { const int np = n - Z_QR, j = np & 127, base = np - j; return 6160 + base + ((j & 1) ? 64 + (j >> 1) : (j >> 1)); }
    if (n < Z_F) return n + 16;
    if (n < Z_F + 16) return 6144 + (n - Z_F);
    return -1;
}
template <bool ZMAP>
__device__ __forceinline__ void p0_transpose_item(const float* W, int K, int Nsrc, int Ndst, bf16* WT, LAS float* scr, int item, int lane) {
    const int nblk = Ndst / 32, kb = item / nblk, nb = item % nblk, k0 = 64 * kb, n0 = 32 * nb;
    const int sc = ZMAP ? z_src_col(n0 + (lane & 31)) : (n0 + (lane & 31));
#pragma unroll 8
    for (int i = 0; i < 32; ++i) { const int kk = 2 * i + (lane >> 5); scr[kk * 33 + (lane & 31)] = (sc >= 0) ? W[(size_t)(k0 + kk) * Nsrc + sc] : 0.f; }
    LDS_WAIT(); asm volatile("" ::: "memory");
    const int c = lane & 7;
#pragma unroll
    for (int j = 0; j < 4; ++j) { const int n = (lane >> 3) + 8 * j; const LAS float* s = scr + (8 * c) * 33 + n;
        v4u o; o.x = pk2(s[0 * 33], s[1 * 33]); o.y = pk2(s[2 * 33], s[3 * 33]); o.z = pk2(s[4 * 33], s[5 * 33]); o.w = pk2(s[6 * 33], s[7 * 33]);
        *(GAS v4u*)(WT + (size_t)(n0 + n) * K + k0 + 8 * c) = o; }
    LDS_WAIT(); asm volatile("" ::: "memory");
}
__device__ __forceinline__ void rms_row_to_bf16(const float* xrow, const float* g, bf16* orow, int lane) {
    const GAS f32x4* xr = (const GAS f32x4*)xrow + lane;
    f32x4 v[16]; float s = 0.f;
#pragma unroll
    for (int j = 0; j < 16; ++j) { v[j] = xr[64 * j]; s += (v[j].x * v[j].x + v[j].y * v[j].y) + (v[j].z * v[j].z + v[j].w * v[j].w); }
    const float r = 1.f / sqrtf(wave_sum(s) * (1.f / DM) + EPS);
    const GAS f32x4* gr = (const GAS f32x4*)g + lane;
    GAS v2u* o8 = (GAS v2u*)orow + lane;
#pragma unroll
    for (int j = 0; j < 16; ++j) { const f32x4 gg = gr[64 * j]; v2u w; w.x = pk2(v[j].x * r * gg.x, v[j].y * r * gg.y); w.y = pk2(v[j].z * r * gg.z, v[j].w * r * gg.w); o8[64 * j] = w; }
}
__device__ __forceinline__ void zero_bytes16(unsigned char* p, size_t n16, int gt, int NT) {
    const v4u z = {0u, 0u, 0u, 0u};
    for (size_t i = gt; i < n16; i += NT) ((GAS v4u*)p)[i] = z;
}
__device__ __forceinline__ void p0_prologue(Frame& F) {
    LAS float* scr = (LAS float*)(F.lds + RING_OFF + F.wave * 16384);
    const int gw = F.vcu * 8 + F.wave, NGW = F.G * 8;
    bf16* WZ = wsp<bf16>(F, WS_WZ); bf16* WFOX = wsp<bf16>(F, WS_WFOX); bf16* WRET = wsp<bf16>(F, WS_WRET); bf16* WOUT = wsp<bf16>(F, WS_WOUT); bf16* WQ = wsp<bf16>(F, WS_WQ);
    constexpr int I_Z = (DM / 64) * (NZ / 32), I_FOX = (2048 / 64) * (DM / 32), I_RET = (DM / 64) * (DM / 32), I_OUT = I_RET, I_Q = (DM / 64) * (PQ / 32);
    constexpr int NITEMS = I_Z + I_FOX + I_RET + I_OUT + I_Q;
    for (int it = gw; it < NITEMS; it += NGW) {
        int r = it;
        if (r < I_Z) { p0_transpose_item<true>(F.w_in, DM, 26640, NZ, WZ, scr, r, F.lane); continue; } r -= I_Z;
        if (r < I_FOX) { p0_transpose_item<false>(F.w_fox, 2048, DM, DM, WFOX, scr, r, F.lane); continue; } r -= I_FOX;
        if (r < I_RET) { p0_transpose_item<false>(F.w_ret, DM, DM, DM, WRET, scr, r, F.lane); continue; } r -= I_RET;
        if (r < I_OUT) { p0_transpose_item<false>(F.w_out, DM, DM, DM, WOUT, scr, r, F.lane); continue; } r -= I_OUT;
        p0_transpose_item<false>(F.w_q, DM, PQ, PQ, WQ, scr, r, F.lane);
    }
    bf16* UX = wsp<bf16>(F, WS_UX);
    for (int m = gw; m < MTOK + NMETA; m += NGW) {
        const float* src = (m < MTOK) ? F.x + (size_t)m * DM : F.meta + (size_t)(m - MTOK) * DM;
        rms_row_to_bf16(src, F.g_mix, UX + (size_t)m * DM, F.lane);
    }
    const int gt = F.vcu * 512 + F.tid, NT = F.G * 512;
    zero_bytes16((unsigned char*)(UX + (size_t)(MTOK + NMETA) * DM), (size_t)(256 - NMETA) * DM * 2 / 16, gt, NT);
    { bf16* KB = wsp<bf16>(F, WS_KEYS); constexpr int NKE = PH * PK * PK;
      for (int i = gt; i < 2 * NKE / 4; i += NT) { const float* s = (i < NKE / 4) ? F.keys1 + 4 * (size_t)i : F.keys2 + 4 * (size_t)(i - NKE / 4); const f32x4 v = *(const GAS f32x4*)s;
          v2u w; w.x = pk2(v.x, v.y); w.y = pk2(v.z, v.w); *(GAS v2u*)(KB + 4 * (size_t)i) = w; } }
    for (int bh = 0; bh < NB * NH; ++bh) {
        zero_bytes16((unsigned char*)(wsp<bf16>(F, WS_KA) + (size_t)bh * SKV * HD), 48 * HD * 2 / 16, gt, NT);
        zero_bytes16((unsigned char*)(wsp<bf16>(F, WS_VA) + (size_t)bh * SKV * HD), 48 * HD * 2 / 16, gt, NT);
        zero_bytes16((unsigned char*)(wsp<bf16>(F, WS_KR) + (size_t)bh * LR * HD), 112 * HD * 2 / 16, gt, NT);
        zero_bytes16((unsigned char*)(wsp<bf16>(F, WS_VR) + (size_t)bh * LR * RDV), 112 * RDV * 2 / 16, gt, NT);
    }
}
typedef short v4i16_t __attribute__((ext_vector_type(4)));
__device__ __forceinline__ int v_st(int k, int c) { const int kk = (k & ~0xC) | ((k & 4) << 1) | ((k & 8) >> 1); return ((kk >> 3) * 4 + (c >> 5)) * 512 + ((kk & 7) * 32 + (c & 31)) * 2; }
__device__ __forceinline__ int v_rd_base(int lane) { return ((lane & 3) << 3) | (((lane >> 2) & 3) << 6) | (((lane >> 4) & 1) << 5) | (((lane >> 5) & 1) << 8); }
__device__ __forceinline__ s16x4 vtr(const LAS unsigned char* p) { return __builtin_bit_cast(s16x4, __builtin_amdgcn_ds_read_tr16_b64_v4i16((LAS v4i16_t*)p)); }
__device__ __forceinline__ bf16x8 tr_frag(const LAS unsigned char* p) {
    const s16x4 l = vtr(p), h = vtr(p + 2048);
    return (bf16x8){l[0], l[1], l[2], l[3], h[0], h[1], h[2], h[3]};
}
__device__ __forceinline__ int crow(int r, int hi) { return (r & 3) + 8 * (r >> 2) + 4 * hi; }
__device__ const float LG2GAM[16] = { -4.580368961e-02f, -2.272007650e-02f, -1.131531323e-02f, -5.646563141e-03f, -2.820519062e-03f, -1.409570255e-03f, -7.046129766e-04f, -3.522634716e-04f,
    -1.761209843e-04f, -8.805780458e-05f, -4.402823044e-05f, -2.201394726e-05f, -1.100693164e-05f, -5.503455325e-06f, -2.751725038e-06f, -1.375861863e-06f };

__device__ __forceinline__ void p2_cumsum(float* CUMp, int lane) {
    float carry = 0.f;
    constexpr int NIT = (SKV - 48 + 255) / 256;
    const GAS f32x4* src = (const GAS f32x4*)(CUMp + 48) + lane;
    f32x4 v = *src, vn;
    for (int it = 0; it < NIT; ++it) {
        const int j0n = 48 + (it + 1) * 256 + lane * 4;
        vn = (f32x4){0.f, 0.f, 0.f, 0.f};
        if (it + 1 < NIT && j0n < SKV) vn = src[(it + 1) * 64];
        const float p0 = v.x, p1 = p0 + v.y, p2 = p1 + v.z, p3 = p2 + v.w;
        float x = p3;
#pragma unroll
        for (int o = 1; o < 64; o <<= 1) { const float t = __shfl_up(x, o); if (lane >= o) x += t; }
        const float excl = carry + (x - p3);
        const int j0 = 48 + it * 256 + lane * 4;
        if (j0 < SKV) *((GAS f32x4*)(CUMp + j0)) = (f32x4){-(excl + p0), -(excl + p1), -(excl + p2), -(excl + p3)};
        carry += __shfl(x, 63);
        v = vn;
    }
    if (lane < 12) *((GAS f32x4*)CUMp + lane) = (f32x4){-__builtin_inff(), -__builtin_inff(), -__builtin_inff(), -__builtin_inff()};
}
__device__ __forceinline__ void p2_qknorm(Frame& F, int gw, int NGW) {
    constexpr int R_Q = NB * NH * SEQ, RK_PER = SKV - 48, R_K = NB * NH * RK_PER, NSTEP = (R_Q + R_K) / 4;
    bf16* QA = wsp<bf16>(F, WS_QA); bf16* KA = wsp<bf16>(F, WS_KA);
    const int sub = F.lane >> 4, c8 = (F.lane & 15) * 8;
    float gq[8], gk[8];
#pragma unroll
    for (int k = 0; k < 8; ++k) { gq[k] = F.g_q[c8 + k] * 0.08838834764831845f; gk[k] = F.g_k[c8 + k]; }
    for (int s0 = gw; s0 < NSTEP; s0 += 4 * NGW) {
        v4u w[4]; bf16* ptr[4]; bool isq[4], ok[4];
#pragma unroll
        for (int u = 0; u < 4; ++u) { const int s = s0 + u * NGW; ok[u] = s < NSTEP; const int r = 4 * s + sub;
            if (r < R_Q) { isq[u] = true; ptr[u] = QA + (size_t)r * HD + c8; }
            else { const int rp = r - R_Q, bh = rp / RK_PER, j = 48 + rp % RK_PER; isq[u] = false; ptr[u] = KA + ((size_t)bh * SKV + j) * HD + c8; }
            if (ok[u]) w[u] = *(const GAS v4u*)ptr[u]; else w[u] = (v4u){0u, 0u, 0u, 0u}; }
#pragma unroll
        for (int u = 0; u < 4; ++u) {
            float f[8] = {bflo(w[u].x), bfhi(w[u].x), bflo(w[u].y), bfhi(w[u].y), bflo(w[u].z), bfhi(w[u].z), bflo(w[u].w), bfhi(w[u].w)};
            float ss = 0.f;
#pragma unroll
            for (int k = 0; k < 8; ++k) ss += f[k] * f[k];
            ss += __shfl_xor(ss, 1); ss += __shfl_xor(ss, 2); ss += __shfl_xor(ss, 4); ss += __shfl_xor(ss, 8);
            const float rs = 1.f / sqrtf(ss * (1.f / HD) + EPS);
#pragma unroll
            for (int k = 0; k < 8; ++k) f[k] = f[k] * rs * (isq[u] ? gq[k] : gk[k]);
            v4u o; o.x = pk2(f[0], f[1]); o.y = pk2(f[2], f[3]); o.z = pk2(f[4], f[5]); o.w = pk2(f[6], f[7]);
            if (ok[u]) *(GAS v4u*)ptr[u] = o;
        }
    }
}
__device__ __forceinline__ void p2_kv_item(Frame& F, int item) {
    const int bh = item >> 6, n = item & 63, h = bh & (NH - 1);
    const float lg2 = LG2GAM[h];
    const bf16* Kg = wsp<bf16>(F, WS_KR) + ((size_t)bh * LR + 128 * n) * HD;
    const bf16* Vg = wsp<bf16>(F, WS_VR) + ((size_t)bh * LR + 128 * n) * RDV;
    LAS unsigned char* ldsV = F.lds; LAS unsigned char* ldsK = F.lds + 65536;
    const int sr = F.tid >> 4, sc = (F.tid & 15) * 8;
    v4u kw[4], vw[2][4];
#pragma unroll
    for (int q = 0; q < 4; ++q) { const int j = sr + 32 * q; kw[q] = *(const GAS v4u*)(Kg + (size_t)j * HD + sc);
        vw[0][q] = *(const GAS v4u*)(Vg + (size_t)j * RDV + sc); vw[1][q] = *(const GAS v4u*)(Vg + (size_t)j * RDV + 128 + sc); }
#pragma unroll
    for (int q = 0; q < 4; ++q) { const int j = sr + 32 * q; const float z = fast_exp2(lg2 * (float)(127 - j));
        v4u o; o.x = pk2(bflo(kw[q].x) * z, bfhi(kw[q].x) * z); o.y = pk2(bflo(kw[q].y) * z, bfhi(kw[q].y) * z); o.z = pk2(bflo(kw[q].z) * z, bfhi(kw[q].z) * z); o.w = pk2(bflo(kw[q].w) * z, bfhi(kw[q].w) * z);
        const int so = v_st(j & 63, sc);
        *(LAS v4u*)(ldsK + (j >> 6) * 16384 + so) = o;
        *(LAS v4u*)(ldsV + ((j >> 6) * 2 + 0) * 16384 + so) = vw[0][q];
        *(LAS v4u*)(ldsV + ((j >> 6) * 2 + 1) * 16384 + so) = vw[1][q]; }
    __syncthreads();
    const int w = F.wave, r32 = F.lane & 31, hi = F.lane >> 5;
    const LAS unsigned char* pa = ldsV + v_rd_base(F.lane) + (w >> 2) * 16384 + (w & 3) * 512;
    const LAS unsigned char* pb = ldsK + v_rd_base(F.lane);
    f32x16 acc[4] = {};
#pragma unroll
    for (int jh = 0; jh < 2; ++jh)
#pragma unroll
        for (int ks = 0; ks < 4; ++ks) {
            const bf16x8 a = tr_frag(pa + jh * 32768 + ks * 4096);
#pragma unroll
            for (int dt = 0; dt < 4; ++dt) { const bf16x8 b = tr_frag(pb + jh * 16384 + dt * 512 + ks * 4096); acc[dt] = __builtin_amdgcn_mfma_f32_32x32x16_bf16(a, b, acc[dt], 0, 0, 0); }
        }
    float* outp = wsp<float>(F, WS_KVT) + (size_t)item * (RDV * HD);
#pragma unroll
    for (int dt = 0; dt < 4; ++dt)
#pragma unroll
        for (int r = 0; r < 16; ++r) outp[(size_t)(32 * w + crow(r, hi)) * HD + 32 * dt + r32] = acc[dt][r];
    __syncthreads();
}
__device__ __forceinline__ void p2_phase(Frame& F) {
    const int gw = F.vcu * 8 + F.wave, NGW = F.G * 8;
    if (gw < NB * NH) p2_cumsum(wsp<float>(F, WS_CUM) + (size_t)gw * SKV, F.lane);
    p2_qknorm(F, gw, NGW);
    for (int item = F.vcu; item < NB * NH * NCHUNK; item += F.G) p2_kv_item(F, item);
}
__device__ __forceinline__ void p3_scan(Frame& F) {
    const int gt = F.vcu * 512 + F.tid, NT = F.G * 512;
    const float* KVT = wsp<float>(F, WS_KVT); bf16* ST = wsp<bf16>(F, WS_ST);
    for (int g = gt; g < NB * NH * 4096; g += NT) {
        const int bh = g >> 12, off = (g & 4095) * 8, h = bh & (NH - 1);
        const float cd = fast_exp2(LG2GAM[h] * 128.f);
        const float* src = KVT + (size_t)bh * NCHUNK * 32768 + off; bf16* dst = ST + (size_t)bh * NCHUNK * 32768 + off;
        float s[8] = {0.f, 0.f, 0.f, 0.f, 0.f, 0.f, 0.f, 0.f};
        for (int n0 = 0; n0 < NCHUNK; n0 += 4) {
            f32x4 a[4], b[4];
#pragma unroll
            for (int u = 0; u < 4; ++u) { a[u] = *(const GAS f32x4*)(src + (size_t)(n0 + u) * 32768); b[u] = *(const GAS f32x4*)(src + (size_t)(n0 + u) * 32768 + 4); }
#pragma unroll
            for (int u = 0; u < 4; ++u) {
#pragma unroll
                for (int k = 0; k < 4; ++k) { s[k] = s[k] * cd + a[u][k]; s[4 + k] = s[4 + k] * cd + b[u][k]; }
                v4u o; o.x = pk2(s[0], s[1]); o.y = pk2(s[2], s[3]); o.z = pk2(s[4], s[5]); o.w = pk2(s[6], s[7]);
                *(GAS v4u*)(dst + (size_t)(n0 + u) * 32768) = o; }
        }
    }
}

namespace fox {
constexpr int D = 128, NW = 8, QBLK = 32, KVBLK = 64, QB = NW * QBLK;
constexpr int SHM_V = KVBLK * D * 2, SHM_K = KVBLK * D * 2;
constexpr int LDS_ATT = 2 * SHM_V + 2 * SHM_K + NW * 64 * 4;
constexpr float THR = 8.f;
constexpr int OSTRIDE = NH * HD;
#define KSWZ(row, colB) ((row) * 256 + ((colB) ^ (((row) & 7) << 4)))
constexpr int v_rd_off(int d0, int ks, int half) { return d0 * 512 + ks * 4096 + half * 2048; }
__device__ __forceinline__ bf16x8 load8(const bf16* p) { return *reinterpret_cast<const bf16x8*>(p); }
__device__ __forceinline__ void mask_tile(f32x16& p0, f32x16& p1, int dq) {
    const float NEG = -__builtin_inff();
#pragma unroll
    for (int r = 0; r < 16; ++r) {
        const int c = (r & 3) + 8 * (r >> 2);
        if (dq - c < 0) p0[r] = NEG;
        if (dq - c - 32 < 0) p1[r] = NEG;
    }
}
__device__ __forceinline__ void partialSM(f32x16& p0, f32x16& p1, float& m_reg, float& mn, float& alpha) {
    float pmax = p0[0];
#pragma unroll
    for (int r = 1; r < 16; ++r) pmax = fmaxf(pmax, p0[r]);
#pragma unroll
    for (int r = 0; r < 16; ++r) pmax = fmaxf(pmax, p1[r]);
    { auto rr = __builtin_amdgcn_permlane32_swap(__float_as_uint(pmax), __float_as_uint(pmax), false, false);
      pmax = fmaxf(__uint_as_float(rr[0]), __uint_as_float(rr[1])); }
    constexpr float C2 = 1.4426950408889634f;
    if (__builtin_expect(__all((pmax - m_reg) <= THR), 1)) { mn = m_reg; alpha = 1.f; }
    else { mn = fmaxf(m_reg, pmax); alpha = __builtin_amdgcn_exp2f((m_reg - mn) * C2); m_reg = mn; }
    const float mnL = -mn * C2;
#pragma unroll
    for (int r = 0; r < 16; ++r) p0[r] = fmaf(p0[r], C2, mnL);
#pragma unroll
    for (int r = 0; r < 16; ++r) p1[r] = fmaf(p1[r], C2, mnL);
#pragma unroll
    for (int r = 0; r < 16; ++r) p0[r] = __builtin_amdgcn_exp2f(p0[r]);
}
__device__ __forceinline__ void finishSM(f32x16& p0, f32x16& p1, float alpha, float& l_reg, bf16x8& pa0, bf16x8& pa1, bf16x8& pa2, bf16x8& pa3) {
#pragma unroll
    for (int r = 0; r < 16; ++r) p1[r] = __builtin_amdgcn_exp2f(p1[r]);
    float ps = 0;
#pragma unroll
    for (int r = 0; r < 16; ++r) ps += p0[r];
#pragma unroll
    for (int r = 0; r < 16; ++r) ps += p1[r];
    { auto rr = __builtin_amdgcn_permlane32_swap(__float_as_uint(ps), __float_as_uint(ps), false, false);
      ps = __uint_as_float(rr[0]) + __uint_as_float(rr[1]); }
    l_reg = l_reg * alpha + ps;
#define PK4(P, B_, OUT) do { unsigned a0 = cvtpk(P[B_+0], P[B_+1]), a1 = cvtpk(P[B_+2], P[B_+3]);                          \
        unsigned b0 = cvtpk(P[B_+4], P[B_+5]), b1 = cvtpk(P[B_+6], P[B_+7]);                                             \
        auto r0 = __builtin_amdgcn_permlane32_swap(a0, b0, false, false); auto r1 = __builtin_amdgcn_permlane32_swap(a1, b1, false, false); \
        v4u w = {r0[0], r1[0], r0[1], r1[1]}; OUT = *reinterpret_cast<bf16x8*>(&w); } while (0)
    PK4(p0, 0, pa0); PK4(p0, 8, pa1); PK4(p1, 0, pa2); PK4(p1, 8, pa3);
}
__device__ __forceinline__ void load_bias(f32x16& p0, f32x16& p1, __amdgpu_buffer_rsrc_t rs, int kb, int hi) {
    const int vo = hi * 16, so = kb * 4;
#pragma unroll
    for (int g = 0; g < 4; ++g) { const v4u x = __builtin_amdgcn_raw_buffer_load_b128(rs, vo, so + 32 * g, 0), y = __builtin_amdgcn_raw_buffer_load_b128(rs, vo, so + 32 * g + 128, 0);
        p0[4 * g] = __uint_as_float(x[0]); p0[4 * g + 1] = __uint_as_float(x[1]); p0[4 * g + 2] = __uint_as_float(x[2]); p0[4 * g + 3] = __uint_as_float(x[3]);
        p1[4 * g] = __uint_as_float(y[0]); p1[4 * g + 1] = __uint_as_float(y[1]); p1[4 * g + 2] = __uint_as_float(y[2]); p1[4 * g + 3] = __uint_as_float(y[3]); }
}
template <int KB>
__device__ __forceinline__ void qkt(f32x16& p0, f32x16& p1, const char* K_lds, int r32, int hi, const bf16x8* qr) {
    const char* kb[4];
#pragma unroll
    for (int dd = 0; dd < 4; ++dd) kb[dd] = K_lds + KB * SHM_K + KSWZ(r32, (dd * 16 + hi * 8) * 2);
#pragma unroll
    for (int d0 = 0; d0 < 8; ++d0) { const char* a = kb[d0 & 3] + (d0 >> 2) * 128;
        bf16x8 b0 = *reinterpret_cast<const bf16x8*>(a);
        bf16x8 b1 = *reinterpret_cast<const bf16x8*>(a + 32 * 256);
        p0 = __builtin_amdgcn_mfma_f32_32x32x16_bf16(b0, qr[d0], p0, 0, 0, 0);
        p1 = __builtin_amdgcn_mfma_f32_32x32x16_bf16(b1, qr[d0], p1, 0, 0, 0); }
}
template <int VB>
__device__ __forceinline__ void pv_tile(f32x16* o, int vb0, bf16x8 pa0, bf16x8 pa1, bf16x8 pa2, bf16x8 pa3) {
#define TRRD(dst, off) asm volatile("ds_read_b64_tr_b16 %0, %1 offset:%2" : "=&v"(dst) : "v"(vb0), "i"(off) : "memory")
#define PV_D0(d0) do { s16x4 l0, l1, l2, l3, h0, h1, h2, h3; constexpr int b_ = VB * SHM_V + v_rd_off(d0, 0, 0); \
        TRRD(l0, b_); TRRD(h0, b_ + 2048); TRRD(l1, b_ + 4096); TRRD(h1, b_ + 6144); TRRD(l2, b_ + 8192); TRRD(h2, b_ + 10240); TRRD(l3, b_ + 12288); TRRD(h3, b_ + 14336); \
        asm volatile("s_waitcnt lgkmcnt(0)" ::: "memory"); SBAR();   \
        o[d0] = __builtin_amdgcn_mfma_f32_32x32x16_bf16(pa0, (bf16x8){l0[0], l0[1], l0[2], l0[3], h0[0], h0[1], h0[2], h0[3]}, o[d0], 0, 0, 0);   \
        o[d0] = __builtin_amdgcn_mfma_f32_32x32x16_bf16(pa1, (bf16x8){l1[0], l1[1], l1[2], l1[3], h1[0], h1[1], h1[2], h1[3]}, o[d0], 0, 0, 0);   \
        o[d0] = __builtin_amdgcn_mfma_f32_32x32x16_bf16(pa2, (bf16x8){l2[0], l2[1], l2[2], l2[3], h2[0], h2[1], h2[2], h2[3]}, o[d0], 0, 0, 0);   \
        o[d0] = __builtin_amdgcn_mfma_f32_32x32x16_bf16(pa3, (bf16x8){l3[0], l3[1], l3[2], l3[3], h3[0], h3[1], h3[2], h3[3]}, o[d0], 0, 0, 0); } while (0)
    PV_D0(0); PV_D0(1); PV_D0(2); PV_D0(3);
#undef PV_D0
#undef TRRD
}
struct BlockRef { const bf16* Q; const bf16* K; const bf16* V; bf16* O; const float* Bz; int P0; };
struct Seam { bf16x8 qr[8]; bf16x8 st_v0, st_v1, st_k0, st_k1; };
#define VMW() asm volatile("s_waitcnt vmcnt(0)" ::: "memory")
#define VMWN(n) asm volatile("s_waitcnt vmcnt(%0)" :: "i"(n) : "memory")
#define BL16(rs, so) __builtin_bit_cast(bf16x8, __builtin_amdgcn_raw_buffer_load_b128(rs, lkvB, (so), 0))
#define SLOAD_H(rK, rV, k0) do { S.st_v0 = BL16(rV, (k0) * (D * 2)); S.st_v1 = BL16(rV, ((k0) + 32) * (D * 2));              \
                         S.st_k0 = BL16(rK, (k0) * (D * 2)); S.st_k1 = BL16(rK, ((k0) + 32) * (D * 2)); } while (0)
#define SWRITE_HK(bf) do { *(bf16x8*)(K_lds + (bf) * SHM_K + kws) = S.st_k0; *(bf16x8*)(K_lds + (bf) * SHM_K + kws + 32 * 256) = S.st_k1; } while (0)
#define SWRITE_HV(bf) do { *(bf16x8*)(V_lds + (bf) * SHM_V + vst0) = S.st_v0; *(bf16x8*)(V_lds + (bf) * SHM_V + vst1) = S.st_v1; } while (0)
#define SWRITE_H(bf) do { SWRITE_HV(bf); SWRITE_HK(bf); } while (0)
__device__ __forceinline__ void attn_prime(const BlockRef& cur, char* lds, Seam& S) {
    const int tid = threadIdx.x, wid = __builtin_amdgcn_readfirstlane(tid >> 6), lane = tid & 63, r32 = lane & 31, hi = lane >> 5;
    const int sr = tid >> 4, sc = (tid & 15) * 8, kws = KSWZ(sr, sc * 2); char* K_lds = lds + 2 * SHM_V; const int lkvB = (sr * D + sc) * 2;
    const __amdgpu_buffer_rsrc_t rsK = __builtin_amdgcn_make_buffer_rsrc((void*)cur.K, 0, SKV * D * 2, 0x00020000), rsV = __builtin_amdgcn_make_buffer_rsrc((void*)cur.V, 0, SKV * D * 2, 0x00020000);
    { const bf16* qp = (cur.Q + (size_t)(wid * QBLK) * D) + (unsigned)(r32 * D + hi * 8);
#pragma unroll
      for (int d0 = 0; d0 < 8; ++d0) S.qr[d0] = load8(qp + d0 * 16); }
    SLOAD_H(rsK, rsV, 0); VMW(); SWRITE_HK(0);
    __syncthreads();
}
__device__ __forceinline__ void attn_block(const BlockRef& cur, int skv, char* lds, Seam& S) {
    const int tid = threadIdx.x, wid = __builtin_amdgcn_readfirstlane(tid >> 6), lane = tid & 63, r32 = lane & 31, hi = lane >> 5;
    int j_hi = (cur.P0 + QB - 1) / KVBLK + 1; if (j_hi > skv / KVBLK) j_hi = skv / KVBLK;
    const int NT = j_hi;
    const int qlo = cur.P0 + wid * QBLK, qm = qlo + r32 - 4 * hi;
    char* V_lds = lds; char* K_lds = lds + 2 * SHM_V;
    float* ws = (float*)(lds + 2 * SHM_V + 2 * SHM_K) + wid * 64; float* li_l = ws, * al_l = ws + 32;
    float m_reg = -1e30f, l_reg = 0; f32x16 o[4] = {};
    const int sr = tid >> 4, sc = (tid & 15) * 8, vst0 = v_st(sr, sc), vst1 = v_st(32 + sr, sc), kws = KSWZ(sr, sc * 2); const int lkvB = (sr * D + sc) * 2;
    const int vb0 = (int)(uintptr_t)V_lds + v_rd_base(lane);
    const __amdgpu_buffer_rsrc_t Kh = __builtin_amdgcn_make_buffer_rsrc((void*)cur.K, 0, SKV * D * 2, 0x00020000), Vh = __builtin_amdgcn_make_buffer_rsrc((void*)cur.V, 0, SKV * D * 2, 0x00020000);
    const __amdgpu_buffer_rsrc_t Bz = __builtin_amdgcn_make_buffer_rsrc((void*)cur.Bz, 0, SKV * 4, 0x00020000);
#define RESC(a) do { if (__any((a) < 1.f)) { if (hi == 0) al_l[r32] = (a); asm volatile("s_waitcnt lgkmcnt(0)" ::: "memory");              \
                     for (int d_ = 0; d_ < 4; ++d_) for (int r = 0; r < 16; ++r) o[d_][r] *= al_l[crow(r, hi)]; } } while (0)
#define KBASE(t) ((t) * KVBLK)
#define MASKT(P0_, P1_, t) do { const int kb_ = KBASE(t); if (kb_ + KVBLK - 1 > qlo) mask_tile(P0_, P1_, qm - kb_); } while (0)
    f32x16 pA0, pA1, pB0, pB1; float mnA, mnB, alA, alB; bf16x8 pa0, pa1, pa2, pa3;
    SWRITE_HV(0); SBAR();
    load_bias(pA0, pA1, Bz, KBASE(0), hi);
    if (NT > 1) { load_bias(pB0, pB1, Bz, KBASE(1), hi); SLOAD_H(Kh, Vh, KBASE(1)); }
    SBAR(); qkt<0>(pA0, pA1, K_lds, r32, hi, S.qr);
    MASKT(pA0, pA1, 0); partialSM(pA0, pA1, m_reg, mnA, alA);
    if (NT > 1) { VMW(); SWRITE_H(1); }
    __syncthreads();
#define HALF_STEP(PX0, PX1, mnX, alX, PY0, PY1, alY, t, KB, VB, SB) do {                                                      \
        SBAR(); qkt<KB>(PX0, PX1, K_lds, r32, hi, S.qr);                                                                      \
        finishSM(PY0, PY1, alY, l_reg, pa0, pa1, pa2, pa3); SBAR();                                                           \
        if ((t) + 1 < NT) { load_bias(PY0, PY1, Bz, KBASE((t) + 1), hi); SLOAD_H(Kh, Vh, KBASE((t) + 1)); SBAR(); }            \
        pv_tile<VB>(o, vb0, pa0, pa1, pa2, pa3); MASKT(PX0, PX1, (t)); partialSM(PX0, PX1, m_reg, mnX, alX);                  \
        __syncthreads();                                                                                                      \
        if ((t) + 1 < NT) { VMW(); SWRITE_H(SB); }                                                                            \
        RESC(alX); __syncthreads(); } while (0)
    for (int t = 1; t + 1 < NT; t += 2) {
        HALF_STEP(pB0, pB1, mnB, alB, pA0, pA1, alA, t, 1, 0, 0);
        HALF_STEP(pA0, pA1, mnA, alA, pB0, pB1, alB, t + 1, 0, 1, 1);
    }
    const bool even = (NT & 1) == 0;
    if (even) { SBAR(); qkt<1>(pB0, pB1, K_lds, r32, hi, S.qr); SBAR(); }
    finishSM(pA0, pA1, alA, l_reg, pa0, pa1, pa2, pa3); SBAR();
    pv_tile<0>(o, vb0, pa0, pa1, pa2, pa3);
    if (even) { MASKT(pB0, pB1, NT - 1); partialSM(pB0, pB1, m_reg, mnB, alB); __syncthreads(); RESC(alB);
        finishSM(pB0, pB1, alB, l_reg, pa0, pa1, pa2, pa3); SBAR(); pv_tile<1>(o, vb0, pa0, pa1, pa2, pa3); }
    SBAR();
    if (hi == 0) li_l[r32] = l_reg; asm volatile("s_waitcnt lgkmcnt(0)" ::: "memory");
    float rli[16];
#pragma unroll
    for (int r = 0; r < 16; ++r) rli[r] = __builtin_amdgcn_rcpf(li_l[crow(r, hi)]);
    unsigned char* const Ow = (unsigned char*)(cur.O + (size_t)(wid * QBLK) * OSTRIDE); const unsigned lo_ = (unsigned)((4 * hi * OSTRIDE + r32) * 2);
#pragma unroll
    for (int r = 0; r < 16; ++r) { const int orow = crow(r, hi);
#pragma unroll
        for (int d0 = 0; d0 < 4; ++d0) { const float v = o[d0][r] * rli[r];
            const float vn = __shfl_xor(v, 1);
            if ((r32 & 1) == 0) *(unsigned*)((Ow + (size_t)((((r & 3) + 8 * (r >> 2)) * OSTRIDE + d0 * 32) * 2)) + lo_) = cvtpk(v, vn); } }
    __syncthreads();
#undef RESC
#undef KBASE
#undef MASKT
#undef HALF_STEP
}
#undef BL16
#undef VMW
#undef VMWN
#undef SLOAD_H
#undef SWRITE_HK
#undef SWRITE_HV
#undef SWRITE_H
#undef PK4
#undef KSWZ
}

__device__ __forceinline__ fox::BlockRef attn_ref(const Frame& F, int L, int pass) {
    const int bh = L >> 4, x = L & 15, qb = pass ? 31 - x : x, b = bh >> 4, h = bh & 15;
    fox::BlockRef r;
    r.Q = wsp<bf16>(F, WS_QA) + ((size_t)bh * SEQ + (size_t)qb * 256) * HD;
    r.K = wsp<bf16>(F, WS_KA) + (size_t)bh * SKV * HD; r.V = wsp<bf16>(F, WS_VA) + (size_t)bh * SKV * HD;
    r.O = wsp<bf16>(F, WS_YA) + ((size_t)b * SEQ + (size_t)qb * 256) * (NH * HD) + h * HD;
    r.Bz = wsp<float>(F, WS_CUM) + (size_t)bh * SKV; r.P0 = 64 + qb * 256;
    return r;
}
__device__ __forceinline__ void p3_attention(Frame& F, char* ldsg) {
    constexpr int TOTAL = NB * NH * 16;
    char* lds = ldsg + RING_OFF;
    for (int L = F.vcu; L < TOTAL; L += F.G)
#pragma unroll 1
        for (int pass = 0; pass < 2; ++pass) {
            const fox::BlockRef cur = attn_ref(F, L, pass);
            fox::Seam S;
            fox::attn_prime(cur, lds, S);
            fox::attn_block(cur, SKV, lds, S);
        }
}
template <int B_> __device__ __forceinline__ bf16x8 pk4(const f32x16& P) {
    unsigned a0 = cvtpk(P[B_ + 0], P[B_ + 1]), a1 = cvtpk(P[B_ + 2], P[B_ + 3]), b0 = cvtpk(P[B_ + 4], P[B_ + 5]), b1 = cvtpk(P[B_ + 6], P[B_ + 7]);
    auto r0 = __builtin_amdgcn_permlane32_swap(a0, b0, false, false); auto r1 = __builtin_amdgcn_permlane32_swap(a1, b1, false, false);
    v4u w = {r0[0], r1[0], r0[1], r1[1]}; return *reinterpret_cast<bf16x8*>(&w);
}
__device__ __forceinline__ void p4_ret_item(Frame& F, int item) {
    const int bh = item >> 6, c = (item & 63) + 1, b = bh >> 4, h = bh & (NH - 1);
    const float lg2 = LG2GAM[h];
    const bf16* Qg = wsp<bf16>(F, WS_QR) + ((size_t)bh * LR + 128 * c) * HD;
    const bf16* Kg = wsp<bf16>(F, WS_KR) + ((size_t)bh * LR + 128 * c) * HD;
    const bf16* Vg = wsp<bf16>(F, WS_VR) + ((size_t)bh * LR + 128 * c) * RDV;
    const bf16* STg = wsp<bf16>(F, WS_ST) + ((size_t)bh * NCHUNK + (c - 1)) * 32768;
    LAS unsigned char* ldsV = F.lds; LAS f32x2* stats = (LAS f32x2*)(F.lds + 65536);
    const int sr = F.tid >> 4, sc = (F.tid & 15) * 8;
    {   v4u vw[2][4];
#pragma unroll
        for (int q = 0; q < 4; ++q) { const int j = sr + 32 * q; vw[0][q] = *(const GAS v4u*)(Vg + (size_t)j * RDV + sc); vw[1][q] = *(const GAS v4u*)(Vg + (size_t)j * RDV + 128 + sc); }
#pragma unroll
        for (int q = 0; q < 4; ++q) { const int j = sr + 32 * q, so = v_st(j & 63, sc);
            *(LAS v4u*)(ldsV + ((j >> 6) * 2 + 0) * 16384 + so) = vw[0][q]; *(LAS v4u*)(ldsV + ((j >> 6) * 2 + 1) * 16384 + so) = vw[1][q]; } }
    __syncthreads();
    const int w = F.wave, ib = w & 3, eh = w >> 2, r32 = F.lane & 31, hi = F.lane >> 5;
    bf16x8 qr[8];
#pragma unroll
    for (int ks = 0; ks < 8; ++ks) qr[ks] = *(const GAS bf16x8*)(Qg + (size_t)(32 * ib + r32) * HD + 16 * ks + 8 * hi);
    f32x16 acc[4] = {};
#pragma unroll
    for (int ks = 0; ks < 8; ++ks)
#pragma unroll
        for (int et = 0; et < 4; ++et) { const bf16x8 a = *(const GAS bf16x8*)(STg + (size_t)(128 * eh + 32 * et + r32) * HD + 16 * ks + 8 * hi);
            acc[et] = __builtin_amdgcn_mfma_f32_32x32x16_bf16(a, qr[ks], acc[et], 0, 0, 0); }
    { const float xi = fast_exp2(lg2 * (float)(32 * ib + r32 + 1));
#pragma unroll
      for (int et = 0; et < 4; ++et)
#pragma unroll
          for (int r = 0; r < 16; ++r) acc[et][r] *= xi; }
    const LAS unsigned char* pv = ldsV + v_rd_base(F.lane) + eh * 16384;
    for (int jt = 0; jt <= ib; ++jt) {
        f32x16 p = {};
#pragma unroll
        for (int ks = 0; ks < 8; ++ks) { const bf16x8 a = *(const GAS bf16x8*)(Kg + (size_t)(32 * jt + r32) * HD + 16 * ks + 8 * hi);
            p = __builtin_amdgcn_mfma_f32_32x32x16_bf16(a, qr[ks], p, 0, 0, 0); }
        const int ibase = 32 * ib + r32 - 32 * jt - 4 * hi;
#pragma unroll
        for (int r = 0; r < 16; ++r) { const int dl = ibase - ((r & 3) + 8 * (r >> 2)); p[r] = dl >= 0 ? p[r] * fast_exp2(lg2 * (float)dl) : 0.f; }
        const bf16x8 pa0 = pk4<0>(p), pa1 = pk4<8>(p);
        const LAS unsigned char* pvj = pv + (jt >> 1) * 32768 + (jt & 1) * 8192;
#pragma unroll
        for (int et = 0; et < 4; ++et) { const bf16x8 a0 = tr_frag(pvj + et * 512), a1 = tr_frag(pvj + et * 512 + 4096);
            acc[et] = __builtin_amdgcn_mfma_f32_32x32x16_bf16(a0, pa0, acc[et], 0, 0, 0);
            acc[et] = __builtin_amdgcn_mfma_f32_32x32x16_bf16(a1, pa1, acc[et], 0, 0, 0); }
    }
    float s1 = 0.f, s2 = 0.f;
#pragma unroll
    for (int et = 0; et < 4; ++et)
#pragma unroll
        for (int r = 0; r < 16; ++r) { s1 += acc[et][r]; s2 += acc[et][r] * acc[et][r]; }
    s1 += __shfl_xor(s1, 32); s2 += __shfl_xor(s2, 32);
    if (hi == 0) stats[eh * 128 + 32 * ib + r32] = (f32x2){s1, s2};
    __syncthreads();
    const f32x2 sa = stats[32 * ib + r32], sb = stats[128 + 32 * ib + r32];
    const float mean = (sa.x + sb.x) * (1.f / RDV), var = fmaxf((sa.y + sb.y) * (1.f / RDV) - mean * mean, 0.f), rstd = 1.f / sqrtf(var + EPS);
    const size_t tok = (size_t)b * SEQ + 128 * (c - 1) + 32 * ib + r32;
    const bf16* GRp = wsp<bf16>(F, WS_GR) + tok * DM + h * RDV + 128 * eh + 4 * hi;
    bf16* YRp = wsp<bf16>(F, WS_YR) + tok * DM + h * RDV + 128 * eh + 4 * hi;
    const float* gp = F.g_ret + h * RDV + 128 * eh + 4 * hi;
#pragma unroll
    for (int et = 0; et < 4; ++et)
#pragma unroll
        for (int g4 = 0; g4 < 4; ++g4) { const int eo = 32 * et + 8 * g4;
            const f32x4 gn = *(const GAS f32x4*)(gp + eo); const v2u gt = *(const GAS v2u*)(GRp + eo);
            const float o0 = (acc[et][4 * g4 + 0] - mean) * rstd * gn[0] * bflo(gt.x), o1 = (acc[et][4 * g4 + 1] - mean) * rstd * gn[1] * bfhi(gt.x);
            const float o2 = (acc[et][4 * g4 + 2] - mean) * rstd * gn[2] * bflo(gt.y), o3 = (acc[et][4 * g4 + 3] - mean) * rstd * gn[3] * bfhi(gt.y);
            v2u ov; ov.x = pk2(o0, o1); ov.y = pk2(o2, o3); *(GAS v2u*)(YRp + eo) = ov; }
    __syncthreads();
}
__device__ __forceinline__ void p4_phase(Frame& F) {
    for (int item = F.vcu; item < NB * NH * NCHUNK; item += F.G) p4_ret_item(F, item);
}
__device__ __forceinline__ int f2key(float x) { const int i = __float_as_int(x); return i ^ ((i >> 31) & 0x7fffffff); }
__device__ __forceinline__ float key2f(int k) { return __int_as_float(k ^ ((k >> 31) & 0x7fffffff)); }
__device__ __forceinline__ int imax(int a, int b) { return a > b ? a : b; }
__device__ __forceinline__ int imin(int a, int b) { return a < b ? a : b; }
__device__ __forceinline__ void ins16(int (&a)[16], int x) {
#pragma unroll
    for (int i = 0; i < 16; ++i) { const int t = imax(a[i], x); x = imin(a[i], x); a[i] = t; }
}
__device__ __forceinline__ void merge_partner16(int (&a)[16]) {
    int c[16];
#pragma unroll
    for (int i = 0; i < 16; ++i) c[i] = __shfl_xor(a[15 - i], 32);
#pragma unroll
    for (int i = 0; i < 16; ++i) c[i] = imax(a[i], c[i]);
#pragma unroll
    for (int st = 8; st >= 1; st >>= 1)
#pragma unroll
        for (int i = 0; i < 16; ++i) if (!(i & st)) { const int hi_ = imax(c[i], c[i + st]), lo_ = imin(c[i], c[i + st]); c[i] = hi_; c[i + st] = lo_; }
#pragma unroll
    for (int i = 0; i < 16; ++i) a[i] = c[i];
}
struct CandTab { int a[50], b[50]; };
constexpr CandTab make_cands() { CandTab t{}; int n = 0; for (int a = 0; a < 16; ++a) for (int b = 0; b < 16; ++b) if ((a + 1) * (b + 1) <= 16) { t.a[n] = a; t.b[n] = b; ++n; } return t; }
constexpr CandTab CANDS = make_cands();

__device__ __forceinline__ void p9_unit(Frame& F, int unit) {
    const int tt = unit >> 3, h = unit & 7;
    const int w = F.wave, r32 = F.lane & 31, hi = F.lane >> 5;
    const int t = tt * 256 + 32 * w + r32;
    const bf16* QPp = wsp<bf16>(F, WS_QP) + (size_t)t * PQ + h * 256 + 8 * hi;
    const bf16* KB = wsp<bf16>(F, WS_KEYS);
    LAS int* mylds = (LAS int*)(F.lds + RING_OFF) + (size_t)F.tid * 32;
#pragma unroll 1
    for (int half = 0; half < 2; ++half) {
        bf16x8 qf[8];
#pragma unroll
        for (int ks = 0; ks < 8; ++ks) qf[ks] = *(const GAS bf16x8*)(QPp + half * 128 + 16 * ks);
        int top[16];
#pragma unroll
        for (int i = 0; i < 16; ++i) top[i] = (int)0x80000000;
        const bf16* Kh = KB + ((size_t)half * PH + h) * PK * 128 + (size_t)r32 * 128 + 8 * hi;
#pragma unroll 1
        for (int nt = 0; nt < 4; ++nt) {
            f32x16 p = {};
#pragma unroll
            for (int ks = 0; ks < 8; ++ks) { const bf16x8 a = *(const GAS bf16x8*)(Kh + (size_t)nt * 32 * 128 + 16 * ks); p = __builtin_amdgcn_mfma_f32_32x32x16_bf16(a, qf[ks], p, 0, 0, 0); }
            const int nb = 32 * nt + 4 * hi;
#pragma unroll
            for (int r = 0; r < 16; ++r) { const int n = nb + (r & 3) + 8 * (r >> 2); ins16(top, (f2key(p[r]) & ~127) | n); }
        }
        merge_partner16(top);
#pragma unroll
        for (int i = 0; i < 4; ++i) *(LAS v4u*)(mylds + half * 16 + 4 * i) = (v4u){(unsigned)top[4 * i], (unsigned)top[4 * i + 1], (unsigned)top[4 * i + 2], (unsigned)top[4 * i + 3]};
    }
    float f1[16], f2[16];
#pragma unroll
    for (int i = 0; i < 4; ++i) { const v4u a = *(LAS v4u*)(mylds + 4 * i), b = *(LAS v4u*)(mylds + 16 + 4 * i);
#pragma unroll
        for (int k = 0; k < 4; ++k) { f1[4 * i + k] = key2f((int)a[k] & ~127); f2[4 * i + k] = key2f((int)b[k] & ~127); } }
    int fin[16];
#pragma unroll
    for (int i = 0; i < 16; ++i) fin[i] = (int)0x80000000;
#pragma unroll
    for (int s = 0; s < 25; ++s) {
        const float ve = f1[CANDS.a[2 * s]] + f2[CANDS.b[2 * s]], vo = f1[CANDS.a[2 * s + 1]] + f2[CANDS.b[2 * s + 1]];
        const int ie = (CANDS.a[2 * s] << 4) | CANDS.b[2 * s], io = (CANDS.a[2 * s + 1] << 4) | CANDS.b[2 * s + 1];
        const float v = hi ? vo : ve; const int id = hi ? io : ie;
        ins16(fin, (f2key(v) & ~255) | id);
    }
    merge_partner16(fin);
    float sv[16], e[16]; float den = 0.f;
#pragma unroll
    for (int i = 0; i < 16; ++i) sv[i] = key2f(fin[i] & ~255);
#pragma unroll
    for (int i = 0; i < 16; ++i) { e[i] = fast_exp2((sv[i] - sv[0]) * 1.4426950408889634f); den += e[i]; }
    const float rden = 1.f / den;
    int eid[8]; float gw[8];
#pragma unroll
    for (int k = 0; k < 8; ++k) { const int key = hi ? fin[8 + k] : fin[k]; const int a = (key >> 4) & 15, b = key & 15;
        const int n1 = mylds[a] & 127, n2 = mylds[16 + b] & 127; eid[k] = n1 * PK + n2; gw[k] = (hi ? e[8 + k] : e[k]) * rden; }
    int* EIDp = wsp<int>(F, WS_EID) + (size_t)t * 128 + h * 16 + 8 * hi; float* GWp = wsp<float>(F, WS_GW) + (size_t)t * 128 + h * 16 + 8 * hi;
    *(GAS v4u*)EIDp = (v4u){(unsigned)eid[0], (unsigned)eid[1], (unsigned)eid[2], (unsigned)eid[3]}; *(GAS v4u*)(EIDp + 4) = (v4u){(unsigned)eid[4], (unsigned)eid[5], (unsigned)eid[6], (unsigned)eid[7]};
    *(GAS f32x4*)GWp = (f32x4){gw[0], gw[1], gw[2], gw[3]}; *(GAS f32x4*)(GWp + 4) = (f32x4){gw[4], gw[5], gw[6], gw[7]};
}
__device__ __forceinline__ void p9_phase(Frame& F) {
    for (int unit = F.vcu; unit < (MTOK / 256) * PH; unit += F.G) p9_unit(F, unit);
}
typedef __amdgpu_buffer_rsrc_t rsrc_t;
__device__ __forceinline__ rsrc_t mk_rsrc(const void* p, unsigned bytes) { return __builtin_amdgcn_make_buffer_rsrc((void*)p, 0, bytes, 0x00020000); }
__device__ __forceinline__ void load_row8(v4u (&r)[4], rsrc_t rs, int lane16, int e) {
    const int so = e * DM;
#pragma unroll
    for (int j = 0; j < 4; ++j) r[j] = __builtin_amdgcn_raw_buffer_load_b128(rs, lane16, so + j * 1024, 0);
}
__device__ __forceinline__ float dot_row8(const v4u (&r)[4], const float (&x)[64]) {
    float a0 = 0.f, a1 = 0.f, a2 = 0.f, a3 = 0.f;
#pragma unroll
    for (int j = 0; j < 4; ++j)
#pragma unroll
        for (int d = 0; d < 4; ++d) { const f32x2 lo = __builtin_amdgcn_cvt_pk_f32_fp8((int)r[j][d], false), hi = __builtin_amdgcn_cvt_pk_f32_fp8((int)r[j][d], true);
            a0 = fmaf(lo.x, x[16 * j + 4 * d], a0); a1 = fmaf(lo.y, x[16 * j + 4 * d + 1], a1); a2 = fmaf(hi.x, x[16 * j + 4 * d + 2], a2); a3 = fmaf(hi.y, x[16 * j + 4 * d + 3], a3);
            asm volatile("" : "+v"(a0), "+v"(a1), "+v"(a2), "+v"(a3)); }
    return wave_sum((a0 + a1) + (a2 + a3));
}
__device__ __forceinline__ void axpy_row8(float (&acc)[64], const v4u (&r)[4], float w) {
#pragma unroll
    for (int j = 0; j < 4; ++j)
#pragma unroll
        for (int d = 0; d < 4; ++d) { const f32x2 lo = __builtin_amdgcn_cvt_pk_f32_fp8((int)r[j][d], false), hi = __builtin_amdgcn_cvt_pk_f32_fp8((int)r[j][d], true);
            acc[16 * j + 4 * d] = fmaf(w, lo.x, acc[16 * j + 4 * d]); acc[16 * j + 4 * d + 1] = fmaf(w, lo.y, acc[16 * j + 4 * d + 1]);
            acc[16 * j + 4 * d + 2] = fmaf(w, hi.x, acc[16 * j + 4 * d + 2]); acc[16 * j + 4 * d + 3] = fmaf(w, hi.y, acc[16 * j + 4 * d + 3]);
            asm volatile("" : "+v"(acc[16 * j + 4 * d]), "+v"(acc[16 * j + 4 * d + 1]), "+v"(acc[16 * j + 4 * d + 2]), "+v"(acc[16 * j + 4 * d + 3])); }
}
__device__ __forceinline__ int imin_(int a, int b) { return a < b ? a : b; }
__device__ __forceinline__ float gelu1(float v) {
    const float av = __builtin_fabsf(v), t = fast_rcp(av * 0.2316418882f + 1.0f);
    float q = t * 0.5307027145f + (-0.7265760135f); q = q * t + 0.7107068705f; q = q * t + (-0.142248368f); q = q * t + 0.127414796f; q = q * t;
    const float e = fast_exp2((v * v) * (-0.72134752044f)), m = v * (q * e);
    return v < 0.f ? m : v - m;
}
#define RLI(v, k) __builtin_amdgcn_readlane((v), (k))
__device__ __forceinline__ float u_half(const float (&x)[64], rsrc_t rs, int lane16, int ev, int lane) {
    float a = 0.f;
    v4u R0[4], R1[4], R2[4], R3[4];
    load_row8(R0, rs, lane16, RLI(ev, 0)); load_row8(R1, rs, lane16, RLI(ev, 1)); load_row8(R2, rs, lane16, RLI(ev, 2));
#pragma unroll 1
    for (int k = 0; k < 64; k += 4) {
        load_row8(R3, rs, lane16, RLI(ev, k + 3));             SBAR(); { const float d = dot_row8(R0, x); a = (lane == k) ? d : a; } SBAR();
        load_row8(R0, rs, lane16, RLI(ev, imin_(k + 4, 63))); SBAR(); { const float d = dot_row8(R1, x); a = (lane == k + 1) ? d : a; } SBAR();
        load_row8(R1, rs, lane16, RLI(ev, imin_(k + 5, 63))); SBAR(); { const float d = dot_row8(R2, x); a = (lane == k + 2) ? d : a; } SBAR();
        load_row8(R2, rs, lane16, RLI(ev, imin_(k + 6, 63))); SBAR(); { const float d = dot_row8(R3, x); a = (lane == k + 3) ? d : a; } SBAR();
    }
    return a;
}
__device__ __forceinline__ float rlf(float v, int k) { return __int_as_float(__builtin_amdgcn_readlane(__float_as_int(v), k)); }
__device__ __forceinline__ void v_half(float (&acc)[64], rsrc_t rs, int lane16, int ev, float wv) {
    v4u R0[4], R1[4], R2[4], R3[4];
    load_row8(R0, rs, lane16, RLI(ev, 0)); load_row8(R1, rs, lane16, RLI(ev, 1)); load_row8(R2, rs, lane16, RLI(ev, 2));
#pragma unroll 1
    for (int k = 0; k < 64; k += 4) {
        load_row8(R3, rs, lane16, RLI(ev, k + 3));             SBAR(); axpy_row8(acc, R0, rlf(wv, k)); SBAR();
        load_row8(R0, rs, lane16, RLI(ev, imin_(k + 4, 63))); SBAR(); axpy_row8(acc, R1, rlf(wv, k + 1)); SBAR();
        load_row8(R1, rs, lane16, RLI(ev, imin_(k + 5, 63))); SBAR(); axpy_row8(acc, R2, rlf(wv, k + 2)); SBAR();
        load_row8(R2, rs, lane16, RLI(ev, imin_(k + 6, 63))); SBAR(); axpy_row8(acc, R3, rlf(wv, k + 3)); SBAR();
    }
}
__device__ __forceinline__ void p10_token(Frame& F, int t, rsrc_t rsU, rsrc_t rsV) {
    const int lane = F.lane, lane16 = lane * 16;
    const int* EIDp = wsp<int>(F, WS_EID) + (size_t)t * 128; const float* GWp = wsp<float>(F, WS_GW) + (size_t)t * 128;
    const int e0 = EIDp[lane], e1 = EIDp[64 + lane]; const float g0 = GWp[lane], g1 = GWp[64 + lane];
    const float* SCU = wsp<float>(F, WS_SCU); const float* SCV = wsp<float>(F, WS_SCV);
    const float su0 = SCU[e0], su1 = SCU[e1], sv0 = SCV[e0], sv1 = SCV[e1];
    float w0, w1;
    {   float x[64];
        { const GAS v4u* xp = (const GAS v4u*)(wsp<bf16>(F, WS_XN) + (size_t)t * DM) + 2 * lane;
#pragma unroll
          for (int j = 0; j < 4; ++j) { const v4u a = xp[128 * j], b = xp[128 * j + 1];
              x[16 * j + 0] = bflo(a.x); x[16 * j + 1] = bfhi(a.x); x[16 * j + 2] = bflo(a.y); x[16 * j + 3] = bfhi(a.y); x[16 * j + 4] = bflo(a.z); x[16 * j + 5] = bfhi(a.z); x[16 * j + 6] = bflo(a.w); x[16 * j + 7] = bfhi(a.w);
              x[16 * j + 8] = bflo(b.x); x[16 * j + 9] = bfhi(b.x); x[16 * j + 10] = bflo(b.y); x[16 * j + 11] = bfhi(b.y); x[16 * j + 12] = bflo(b.z); x[16 * j + 13] = bfhi(b.z); x[16 * j + 14] = bflo(b.w); x[16 * j + 15] = bfhi(b.w); } }
        const float a0 = u_half(x, rsU, lane16, e0, lane); SBAR();
        const float a1 = u_half(x, rsU, lane16, e1, lane); SBAR();
        w0 = g0 * gelu1(a0 * su0) * sv0; w1 = g1 * gelu1(a1 * su1) * sv1;
    }
    SBAR();
    float acc[64];
#pragma unroll
    for (int i = 0; i < 64; ++i) acc[i] = 0.f;
    v_half(acc, rsV, lane16, e0, w0); SBAR();
    v_half(acc, rsV, lane16, e1, w1); SBAR();
    GAS f32x4* op = (GAS f32x4*)(F.out + (size_t)t * DM) + 4 * lane;
#pragma unroll
    for (int j = 0; j < 4; ++j)
#pragma unroll
        for (int q = 0; q < 4; ++q) { f32x4 h = op[256 * j + q]; h[0] += acc[16 * j + 4 * q]; h[1] += acc[16 * j + 4 * q + 1]; h[2] += acc[16 * j + 4 * q + 2]; h[3] += acc[16 * j + 4 * q + 3]; op[256 * j + q] = h; }
}
__device__ __forceinline__ void p10_phase(Frame& F) {
    const int gw = F.vcu * 8 + F.wave, NGW = F.G * 8;
    const rsrc_t rsU = mk_rsrc(wsp<unsigned char>(F, WS_U8), (unsigned)MTOK * DM), rsV = mk_rsrc(wsp<unsigned char>(F, WS_V8), (unsigned)MTOK * DM);
    for (int t = gw; t < MTOK; t += NGW) p10_token(F, t, rsU, rsV);
}
constexpr int NPHASE = 11;
constexpr int N_LAUNCHES = MK_N_LAUNCHES;
#ifndef MK_CUT
#define MK_CUT 1
#endif
struct Args { const float* in[17]; float* out; unsigned char* ws; int ph_lo, ph_hi, li, pad; };
__device__ __forceinline__ void cvt_table(const float* src, bf16* dst, size_t n8, int gt, int NT) {
    for (size_t i = gt; i < n8; i += NT) { const f32x4 a = ((const GAS f32x4*)src)[2 * i], b = ((const GAS f32x4*)src)[2 * i + 1];
        v4u o; o.x = pk2(a[0], a[1]); o.y = pk2(a[2], a[3]); o.z = pk2(b[0], b[1]); o.w = pk2(b[2], b[3]); ((GAS v4u*)dst)[i] = o; }
}
#ifndef DBG_DUMP
#define DBG_DUMP -1
#endif
__device__ __forceinline__ void dbg_dump(Frame& F, size_t o0, size_t n0, size_t o1, size_t n1, size_t o2, size_t n2, bool f32_2) {
    const size_t gt = (size_t)F.vcu * 512 + F.tid, NT = (size_t)F.G * 512;
    for (size_t i = gt; i < (size_t)MTOK * DM; i += NT) {
        float v = 0.f;
        if (n0) v += __uint_as_float((unsigned)wsp<bf16>(F, o0)[i % n0] << 16);
        if (n1) v += __uint_as_float((unsigned)wsp<bf16>(F, o1)[i % n1] << 16);
        if (n2) v += f32_2 ? wsp<float>(F, o2)[i % n2] : __uint_as_float((unsigned)wsp<bf16>(F, o2)[i % n2] << 16);
        F.out[i] = v;
    }
}
__device__ __forceinline__ void cvt_row_fp8(const float* src, unsigned char* dst, float* scale_out, int lane) {
    const GAS f32x4* p = (const GAS f32x4*)src + lane;
    f32x4 v[16]; float am = 0.f;
#pragma unroll
    for (int j = 0; j < 16; ++j) { v[j] = p[64 * j]; am = fmaxf(fmaxf(am, fmaxf(__builtin_fabsf(v[j].x), __builtin_fabsf(v[j].y))), fmaxf(__builtin_fabsf(v[j].z), __builtin_fabsf(v[j].w))); }
#pragma unroll
    for (int o = 1; o < 64; o <<= 1) am = fmaxf(am, __shfl_xor(am, o));
    const float s = am > 0.f ? 224.f / am : 1.f;
    GAS unsigned* d = (GAS unsigned*)dst + lane;
#pragma unroll
    for (int j = 0; j < 16; ++j) { int w = 0; w = __builtin_amdgcn_cvt_pk_fp8_f32(v[j].x * s, v[j].y * s, w, false); w = __builtin_amdgcn_cvt_pk_fp8_f32(v[j].z * s, v[j].w * s, w, true); d[64 * j] = (unsigned)w; }
    if (lane == 0) *scale_out = am > 0.f ? am * (1.f / 224.f) : 1.f;
}
__global__ void __launch_bounds__(512, 2) fwd(Args args) {
    extern __shared__ __attribute__((aligned(16))) unsigned char lds[];
    Frame F;
    F.lds = (LAS unsigned char*)lds;
    F.MISC = (volatile LAS unsigned*)(F.lds + MISC_OFF);
    F.tid = threadIdx.x; F.lane = F.tid & 63; F.wave = __builtin_amdgcn_readfirstlane(F.tid >> 6);
    F.G = gridDim.x; { const int bx = blockIdx.x; F.vcu = (F.G % 8 == 0) ? (bx % 8) * (F.G / 8) + bx / 8 : bx; }
    F.ws = args.ws; F.ctl = (gu32*)(args.ws + WS_CTL);
    F.x = args.in[0]; F.meta = args.in[1]; F.g_mix = args.in[2]; F.w_in = args.in[3]; F.b_forget = args.in[4]; F.g_q = args.in[5]; F.g_k = args.in[6]; F.g_ret = args.in[7];
    F.w_fox = args.in[8]; F.w_ret = args.in[9]; F.w_out = args.in[10]; F.g_ffn = args.in[11]; F.w_q = args.in[12]; F.keys1 = args.in[13]; F.keys2 = args.in[14]; F.pu = args.in[15]; F.pv = args.in[16];
    F.out = args.out;
    for (int u = F.tid; u < (LDS_BYTES - LDSCTL_OFF) / 4; u += 512) ((LAS unsigned*)(F.lds + LDSCTL_OFF))[u] = 0u;
    __syncthreads();
    XcdBarrier bar; bar.bar = (unsigned*)(F.ctl + CW_BAR) + args.li * XCD_BAR_WORDS; bar.x = 0; bar.st = nullptr;
    if (args.ph_hi - args.ph_lo > 1) bar = xcd_barrier_post((unsigned*)(F.ctl + CW_BAR) + args.li * XCD_BAR_WORDS, F.MISC + 8);
    const int lo = args.ph_lo, hi = args.ph_hi;
#ifndef PH_MASK
#define PH_MASK 0x7ff
#endif
#define IN(k) ((((PH_MASK) >> (k)) & 1) && lo <= (k) && (k) < hi)
#define SEAM(k) do { if (IN(k) && IN((k) + 1)) xcd_barrier(bar); } while (0)

    if (IN(0)) { p0_prologue(F); } SEAM(0);

    if (IN(1)) {
        pg8::Gemm g{wsp<bf16>(F, WS_UX), wsp<bf16>(F, WS_WZ), MROWS, NZ, DM}; pg8::StaticOrder S; S.init(MROWS, NZ, F.G, (int)blockIdx.x);
#if DBG_DUMP == 100
        pg8::EpiGate<2> E{wsp<bf16>(F, WS_QA), nullptr, NZ};
        pg8::gemm_phase<pg8::EpiGate<2>, pg8::StaticOrder, true, true>(F.lds + RING_OFF, g, S, E);
#else
        pg8::EpiZ E{F.ws, F.b_forget};
        pg8::gemm_phase<pg8::EpiZ, pg8::StaticOrder, true, true>(F.lds + RING_OFF, g, S, E);
#ifdef TWICE_P1
        __syncthreads(); pg8::gemm_phase<pg8::EpiZ, pg8::StaticOrder, true, true>(F.lds + RING_OFF, g, S, E);
#endif
#endif
    } SEAM(1);

    if (DBG_DUMP == 0) { dbg_dump(F, WS_UX, (size_t)MROWS * DM, WS_WZ, (size_t)NZ * DM, WS_WFOX, (size_t)48 * MiB, false); return; }
    if (DBG_DUMP == 100) { const size_t gt = (size_t)F.vcu * 512 + F.tid, NT = (size_t)F.G * 512, TOT = (size_t)MROWS * NZ;
        for (size_t i = gt; i < (size_t)MTOK * DM; i += NT) { float v = 0.f;
            for (int j = 0; j < 7; ++j) { const size_t k = i + (size_t)j * MTOK * DM; if (k < TOT) v += __uint_as_float((unsigned)wsp<bf16>(F, WS_QA)[k] << 16); }
            F.out[i] = v; } return; }
    if (DBG_DUMP == 1) { dbg_dump(F, WS_GR, (size_t)3 * MTOK * DM, 0, 0, 0, 0, false); return; }
    if (IN(2)) { p2_phase(F); } SEAM(2);
    if (DBG_DUMP == 2) { dbg_dump(F, WS_QA, (size_t)NB * NH * SEQ * HD, WS_GR, (size_t)3 * MTOK * DM, WS_KVT, (size_t)NB * NH * NCHUNK * 32768, true); return; }

    if (IN(3)) {
#ifndef NO_SCAN
        p3_scan(F);
#endif
#ifndef NO_ATT
        p3_attention(F, (char*)lds);
#endif
    } SEAM(3);

    if (IN(4)) { p4_phase(F); } SEAM(4);
    if (DBG_DUMP == 4) { dbg_dump(F, WS_YA, (size_t)MTOK * 2048, WS_YR, (size_t)MTOK * DM, WS_ST, (size_t)NB * NH * NCHUNK * 32768, false); return; }

    if (IN(5)) {
        { const int gt = F.vcu * 512 + F.tid, NT = F.G * 512;
          (void)gt; (void)NT; const int gw = F.vcu * 8 + F.wave, NGW = F.G * 8;
          for (int r = gw; r < 2 * MTOK; r += NGW) { const bool isv = r >= MTOK; const int e = isv ? r - MTOK : r;
              cvt_row_fp8((isv ? F.pv : F.pu) + (size_t)e * DM, wsp<unsigned char>(F, isv ? WS_V8 : WS_U8) + (size_t)e * DM, wsp<float>(F, isv ? WS_SCV : WS_SCU) + e, F.lane); } }
        { pg8::Gemm g{wsp<bf16>(F, WS_YA), wsp<bf16>(F, WS_WFOX), MTOK, DM, 2048}; pg8::StaticOrder S; S.init(MTOK, DM, F.G, (int)blockIdx.x);
          pg8::EpiGate<0> E{wsp<bf16>(F, WS_MRG), wsp<bf16>(F, WS_GA), DM};
          pg8::gemm_phase<pg8::EpiGate<0>, pg8::StaticOrder, true, true>(F.lds + RING_OFF, g, S, E); }
        { pg8::Gemm g{wsp<bf16>(F, WS_YR), wsp<bf16>(F, WS_WRET), MTOK, DM, DM}; pg8::StaticOrder S; S.init(MTOK, DM, F.G, (int)blockIdx.x);
          pg8::EpiGate<1> E{wsp<bf16>(F, WS_MRG), wsp<bf16>(F, WS_GT), DM};
          pg8::gemm_phase<pg8::EpiGate<1>, pg8::StaticOrder, true, true>(F.lds + RING_OFF, g, S, E); }
    } SEAM(5);

    if (IN(6)) {
        pg8::Gemm g{wsp<bf16>(F, WS_MRG), wsp<bf16>(F, WS_WOUT), MTOK, DM, DM}; pg8::StaticOrder S; S.init(MTOK, DM, F.G, (int)blockIdx.x);
        pg8::EpiResF32 E{F.x, F.out, DM};
        pg8::gemm_phase<pg8::EpiResF32, pg8::StaticOrder, true, true>(F.lds + RING_OFF, g, S, E);
    } SEAM(6);

    if (IN(7)) { const int gw = F.vcu * 8 + F.wave, NGW = F.G * 8; bf16* XN = wsp<bf16>(F, WS_XN);
        for (int m = gw; m < MTOK; m += NGW) rms_row_to_bf16(F.out + (size_t)m * DM, F.g_ffn, XN + (size_t)m * DM, F.lane);
    } SEAM(7);

    if (IN(8)) {
        pg8::Gemm g{wsp<bf16>(F, WS_XN), wsp<bf16>(F, WS_WQ), MTOK, PQ, DM}; pg8::StaticOrder S; S.init(MTOK, PQ, F.G, (int)blockIdx.x);
        pg8::EpiGate<2> E{wsp<bf16>(F, WS_QP), nullptr, PQ};
        pg8::gemm_phase<pg8::EpiGate<2>, pg8::StaticOrder, true, true>(F.lds + RING_OFF, g, S, E);
    } SEAM(8);

    if (IN(9)) { p9_phase(F); } SEAM(9);
    if (DBG_DUMP == 9) { dbg_dump(F, WS_XN, (size_t)MTOK * DM, WS_QP, (size_t)MTOK * PQ, WS_GW, (size_t)MTOK * 128, true); return; }

    if (IN(10)) { p10_phase(F); }
#undef IN
#undef SEAM
}

extern "C" void kernel_launch(void* const* d_in, const int* in_sizes, int n_in, void* d_out, int out_size, void* d_ws, size_t ws_size, hipStream_t stream) {
    static int grid = 0;
    if (grid == 0) {
        if (n_in != 17 || in_sizes[0] != MTOK * DM || out_size != MTOK * DM || ws_size < WS_END) {
            fprintf(stderr, "kernel_launch: unexpected shapes (n_in %d, in0 %d, out %d, ws %zu; need ws >= %zu); nothing launched\n", n_in, n_in > 0 ? in_sizes[0] : -1, out_size, ws_size, (size_t)WS_END); grid = -1; return; }
        int dev = 0, cus = 0, per_cu = 0;
        if (hipGetDevice(&dev) != hipSuccess || hipDeviceGetAttribute(&cus, hipDeviceAttributeMultiprocessorCount, dev) != hipSuccess) { grid = -1; return; }
        if (hipFuncSetAttribute((const void*)fwd, hipFuncAttributeMaxDynamicSharedMemorySize, LDS_BYTES) != hipSuccess) { fprintf(stderr, "kernel_launch: hipFuncSetAttribute failed\n"); grid = -1; return; }
        if (hipOccupancyMaxActiveBlocksPerMultiprocessor(&per_cu, (const void*)fwd, 512, LDS_BYTES) != hipSuccess || per_cu < 1) { fprintf(stderr, "kernel_launch: occupancy query says %d blocks per CU\n", per_cu); }
        (void)hipGetLastError();
        grid = cus;
    }
    if (grid < 0) return;
    (void)hipMemsetAsync((char*)d_ws + WS_CTL, 0, CTL_ZERO_BYTES, stream);
    Args a{};
    for (int i = 0; i < 17; ++i) a.in[i] = (const float*)d_in[i];
    a.out = (float*)d_out; a.ws = (unsigned char*)d_ws; a.pad = 0;
    if (N_LAUNCHES == 1) { a.ph_lo = 0; a.ph_hi = NPHASE; a.li = 0; hipLaunchKernelGGL(fwd, dim3(grid), dim3(512), LDS_BYTES, stream, a); }
    else if (N_LAUNCHES == 2) { a.ph_lo = 0; a.ph_hi = MK_CUT; a.li = 0; hipLaunchKernelGGL(fwd, dim3(grid), dim3(512), LDS_BYTES, stream, a);
        a.ph_lo = MK_CUT; a.ph_hi = NPHASE; a.li = 1; hipLaunchKernelGGL(fwd, dim3(grid), dim3(512), LDS_BYTES, stream, a); }
    else { for (int p = 0; p < NPHASE; ++p) { a.ph_lo = p; a.ph_hi = p + 1; a.li = p; hipLaunchKernelGGL(fwd, dim3(grid), dim3(512), LDS_BYTES, stream, a); } }
}
```

```cpp
#include <hip/hip_runtime.h>
#include <cstdio>
#include <cstdint>

#ifndef MK_N_LAUNCHES
#define MK_N_LAUNCHES 1
#endif
#ifndef DBG_CHECK
#define DBG_CHECK 0
#endif

constexpr int DM = 4096, NB = 2, SEQ = 8192, MTOK = NB * SEQ;
constexpr int NMETA = 16, MROWS = MTOK + 256;
constexpr int NH = 16, HD = 128, RDV = 256;
constexpr int SKV = 64 + SEQ;
constexpr int LR = 128 + SEQ;
constexpr int NZ = 26880;
constexpr int NCHUNK = 64;
constexpr int PH = 8, PK = 128, PTOP = 16, PQ = 2048;
constexpr float EPS = 1e-6f;
constexpr int Z_QA = 0, Z_KA = 2048, Z_VA = 4096, Z_QR = 6144, Z_KR = 8192, Z_VR = 10240, Z_GR = 14336, Z_GA = 18432, Z_GT = 22528, Z_F = 26624;

constexpr size_t MiB = 1u << 20;
constexpr size_t WS_CTL = 0, CTL_ZERO_BYTES = 1 * MiB;
constexpr size_t WS_WFOX = 2 * MiB;
constexpr size_t WS_WRET = WS_WFOX + 16 * MiB;
constexpr size_t WS_WOUT = WS_WRET + 32 * MiB;
constexpr size_t WS_WQ   = WS_WOUT + 32 * MiB;
constexpr size_t WS_KEYS = WS_WQ + 16 * MiB;
constexpr size_t WS_T1   = WS_KEYS + 1 * MiB;
constexpr size_t WS_WZ   = WS_T1;
constexpr size_t WS_UX   = WS_T1 + 210 * MiB;
constexpr size_t WS_KVT  = WS_T1;
constexpr size_t WS_MRG  = WS_T1;
constexpr size_t WS_XN   = WS_T1 + 128 * MiB;
constexpr size_t WS_QP   = WS_T1 + 256 * MiB;
constexpr size_t WS_SSP  = WS_T1 + 320 * MiB;
constexpr size_t WS_P1   = WS_T1 + 340 * MiB;
constexpr size_t WS_QA   = WS_P1;
constexpr size_t WS_KA   = WS_QA + 64 * MiB;
constexpr size_t WS_VA   = WS_KA + 65 * MiB;
constexpr size_t WS_QR   = WS_VA + 65 * MiB;
constexpr size_t WS_KR   = WS_QR + 65 * MiB;
constexpr size_t WS_VR   = WS_KR + 65 * MiB;
constexpr size_t WS_CUM  = WS_VR + 130 * MiB;
constexpr size_t WS_GR   = WS_CUM + 2 * MiB;
constexpr size_t WS_GA   = WS_GR + 128 * MiB;
constexpr size_t WS_GT   = WS_GA + 128 * MiB;
constexpr size_t WS_ST   = WS_GT + 128 * MiB;
constexpr size_t WS_YA   = WS_ST + 128 * MiB;
constexpr size_t WS_YR   = WS_YA + 64 * MiB;
constexpr size_t WS_END  = WS_YR + 128 * MiB;
constexpr size_t WS_U8   = WS_QA;
constexpr size_t WS_V8   = WS_QA + 64 * MiB;
constexpr size_t WS_SCU  = WS_QA + 128 * MiB;
constexpr size_t WS_SCV  = WS_QA + 129 * MiB;
constexpr size_t WS_EID  = WS_QA + 256 * MiB;
constexpr size_t WS_GW   = WS_QA + 264 * MiB;
static_assert(WS_GW + 8 * MiB <= WS_CUM, "overlay fits in the dead QA..VR region");
static_assert(WS_END <= 1745879040ull, "workspace map fits 4 x sizeof(w_in)");
static_assert(WS_QP + 64 * MiB <= WS_P1 && WS_UX + 130 * MiB <= WS_P1, "T1 map");

constexpr int CW_TMO = 0, CW_CODE = 1;
constexpr int CW_BAR = 4096;
constexpr int CW_DBG = 65536;

constexpr int RING_OFF = 0, RING_BYTES = 131072;
constexpr int LDSX_OFF = RING_BYTES;
constexpr int LDSCTL_OFF = RING_BYTES + 24576, MISC_OFF = LDSCTL_OFF + 320;
constexpr int LDS_BYTES = LDSCTL_OFF + 1024;
static_assert(LDS_BYTES <= 163840, "LDS");

#define GAS __attribute__((address_space(1)))
#define LAS __attribute__((address_space(3)))
typedef unsigned short bf16;
typedef unsigned v4u __attribute__((ext_vector_type(4)));
typedef unsigned v2u __attribute__((ext_vector_type(2)));
typedef float f32x4 __attribute__((ext_vector_type(4)));
typedef float f32x2 __attribute__((ext_vector_type(2)));
typedef float f32x16 __attribute__((ext_vector_type(16)));
typedef short bf16x8 __attribute__((ext_vector_type(8)));
typedef short s16x4 __attribute__((ext_vector_type(4)));
typedef __bf16 bf16x2_t __attribute__((ext_vector_type(2)));
typedef GAS unsigned gu32;
#define RLX_AGENT __ATOMIC_RELAXED, __HIP_MEMORY_SCOPE_AGENT
#define LDS_WAIT() asm volatile("s_waitcnt lgkmcnt(0)" ::: "memory")
#define VM_WAIT() asm volatile("s_waitcnt vmcnt(0)" ::: "memory")
#define SBAR() __builtin_amdgcn_sched_barrier(0)
__device__ __forceinline__ unsigned f2bf(float f) { unsigned u = __builtin_bit_cast(unsigned, f); return (u + 0x7fffu + ((u >> 16) & 1u)) >> 16; }
__device__ __forceinline__ unsigned pk2(float lo, float hi) { return f2bf(lo) | (f2bf(hi) << 16); }
__device__ __forceinline__ unsigned cvtpk(float lo, float hi) { unsigned r; asm volatile("v_cvt_pk_bf16_f32 %0, %1, %2" : "=v"(r) : "v"(lo), "v"(hi)); return r; }
__device__ __forceinline__ float bflo(unsigned w) { return __uint_as_float(w << 16); }
__device__ __forceinline__ float bfhi(unsigned w) { return __uint_as_float(w & 0xffff0000u); }
__device__ __forceinline__ float fast_exp2(float x) { return __builtin_amdgcn_exp2f(x); }
__device__ __forceinline__ float fast_rcp(float x) { return __builtin_amdgcn_rcpf(x); }
__device__ __forceinline__ float sigmoidf_(float x) { return fast_rcp(1.f + fast_exp2(-1.4426950408889634f * x)); }
__device__ __forceinline__ float wave_sum(float v) {
#pragma unroll
    for (int o = 1; o < 64; o <<= 1) v += __shfl_xor(v, o);
    return v;
}
#ifndef PG8_WGM
#define PG8_WGM 8
#endif
namespace pg8 {
#define PG8_LAS __attribute__((address_space(3)))
typedef unsigned short bf16_t;
typedef short bf16x8 __attribute__((ext_vector_type(8)));
typedef float f32x4 __attribute__((ext_vector_type(4)));
typedef unsigned u32x4 __attribute__((ext_vector_type(4)));
constexpr int BM = 256, BK = 64, HALF = 128, HTB = HALF * BK * 2  , STAGE_BYTES = 8 * HTB, NXCD = 8, WGM = PG8_WGM;

__host__ __device__ __forceinline__ int lds_byte(int r, int c) { const int st = (r >> 4) * 2 + (c >> 5), rr = r & 15, cc = c & 31, ob = rr * 64 + cc * 2; return st * 1024 + (ob ^ (((ob >> 9) & 1) << 5)); }
__host__ __device__ __forceinline__ void stage_rc(int b, int& R, int& C) { const int st = b / 1024, sb = b % 1024, swz = sb ^ (((sb >> 9) & 1) << 5); R = (st >> 1) * 16 + swz / 64; C = (st & 1) * 32 + (swz % 64) / 2; }
__host__ __device__ __forceinline__ int perm32(int rho) { const int n = rho >> 4, i = rho & 15; return 8 * (i >> 2) + 4 * n + (i & 3); }

struct Unit { int pm, pn, idx; };
struct Gemm { const bf16_t* A; const bf16_t* Bt; int M, N, K; };

struct StaticOrder {
    int nM, nN, nwg, G, c, wgm;
    __host__ __device__ void init(int M, int N, int G_, int c_, int wgm_ = WGM) { nM = M / BM; nN = N / BM; nwg = nM * nN; G = G_; c = c_; wgm = wgm_; }
    __host__ __device__ bool next(int i, Unit& u) const {
        const long L = (long)i * G + c; if (L >= nwg) return false;
        int wgid = (int)L; { const int q = nwg / NXCD, r = nwg % NXCD, xcd = wgid % NXCD, off = wgid / NXCD; wgid = (xcd < r ? xcd * (q + 1) : r * (q + 1) + (xcd - r) * q) + off; }
        const int nig = wgm * nN, gid = wgid / nig, fm = gid * wgm, gsz = (nM - fm) < wgm ? (nM - fm) : wgm;
        u.pm = fm + ((wgid % nig) % gsz); u.pn = (wgid % nig) / gsz; u.idx = i; return true;
    }
    __device__ __forceinline__ void a_ready(const Unit&) const {}
    __device__ __forceinline__ void done(const Unit&) const {}
};

__device__ __forceinline__ unsigned cvt_pk_bf16(float lo, float hi) { unsigned r; asm volatile("v_cvt_pk_bf16_f32 %0, %1, %2" : "=v"(r) : "v"(lo), "v"(hi)); return r; }
typedef float f32x2 __attribute__((ext_vector_type(2)));
}
__device__ const double ROT_REV[64] = {
    1.59154943091895346e-01, 1.37822502603982849e-01, 1.19349370211248862e-01, 1.03352296618434064e-01,
    8.94994016088910133e-02, 7.75032887553740585e-02, 6.71150830052272551e-02, 5.81192674418762462e-02,
    5.03292121044870353e-02, 4.35833021053073297e-02, 3.77415847174197711e-02, 3.26828658723569976e-02,
    2.83021958306233987e-02, 2.45086918620698521e-02, 2.12236527647776604e-02, 1.83789261056796667e-02,
    1.59154943091895339e-02, 1.37822502603982839e-02, 1.19349370211248862e-02, 1.03352296618434061e-02,
    8.94994016088910237e-03, 7.75032887553740550e-03, 6.71150830052272534e-03, 5.81192674418762410e-03,
    5.03292121044870370e-03, 4.35833021053073314e-03, 3.77415847174197719e-03, 3.26828658723569932e-03,
    2.83021958306233987e-03, 2.45086918620698521e-03, 2.12236527647776622e-03, 1.83789261056796667e-03,
    1.59154943091895356e-03, 1.37822502603982878e-03, 1.19349370211248849e-03, 1.03352296618434048e-03,
    8.94994016088910237e-04, 7.75032887553740507e-04, 6.71150830052272599e-04, 5.81192674418762388e-04,
    5.03292121044870326e-04, 4.35833021053073292e-04, 3.77415847174197741e-04, 3.26828658723569922e-04,
    2.83021958306233954e-04, 2.45086918620698543e-04, 2.12236527647776605e-04, 1.83789261056796662e-04,
    1.59154943091895351e-04, 1.37822502603982856e-04, 1.19349370211248862e-04, 1.03352296618434061e-04,
    8.94994016088910182e-05, 7.75032887553740561e-05, 6.71150830052272545e-05, 5.81192674418762388e-05,
    5.03292121044870354e-05, 4.35833021053073225e-05, 3.77415847174197768e-05, 3.26828658723569989e-05,
    2.83021958306233961e-05, 2.45086918620698523e-05, 2.12236527647776592e-05, 1.83789261056796682e-05,
};
namespace pg8 {
#if 1
typedef unsigned char* rsrc_t;
__device__ __forceinline__ rsrc_t mk_rsrc(const void* p, unsigned) { return (unsigned char*)p; }
#else
typedef __amdgpu_buffer_rsrc_t rsrc_t;
__device__ __forceinline__ rsrc_t mk_rsrc(const void* p, unsigned bytes) { return __builtin_amdgcn_make_buffer_rsrc((void*)p, 0, bytes, 0x00020000); }
#endif
__device__ __forceinline__ void st8b(rsrc_t rs, int voff, int soff, const f32x4& a, const f32x4& b) {
    u32x4 w; w.x = cvt_pk_bf16(a[0], a[1]); w.y = cvt_pk_bf16(a[2], a[3]); w.z = cvt_pk_bf16(b[0], b[1]); w.w = cvt_pk_bf16(b[2], b[3]);
#if 1
    *(u32x4*)((rs + (size_t)(unsigned)soff) + (unsigned)voff) = w;
#else
    __builtin_amdgcn_raw_buffer_store_b128(w, rs, voff, soff, 0);
#endif
}
__device__ __forceinline__ float silu1(float x) { return x * __builtin_amdgcn_rcpf(1.f + __builtin_amdgcn_exp2f(-1.4426950408889634f * x)); }
__device__ __forceinline__ float sigm1(float x) { return __builtin_amdgcn_rcpf(1.f + __builtin_amdgcn_exp2f(-1.4426950408889634f * x)); }
__device__ __forceinline__ float logsig1(float x) {
    const float e = __builtin_amdgcn_exp2f(-1.4426950408889634f * __builtin_fabsf(x));
    return fminf(x, 0.f) - 0.6931471805599453f * __builtin_amdgcn_logf(1.f + e);
}
#if 1
#define ST1(so) (*(float*)((rs + (size_t)(unsigned)(so)) + (unsigned)voff) = lf)
#else
#define ST1(so) __builtin_amdgcn_raw_buffer_store_b32(__float_as_uint(lf), rs, voff, (so), 0)
#endif
#ifndef EPIZ_SECS
#define EPIZ_SECS 31
#endif
struct EpiZ {
    static constexpr bool PERM = true, AFTER_DRAIN = false;
    unsigned char* ws; const float* b_forget; const float* g_q; const float* g_k; LAS float* nrm;
    __device__ __forceinline__ void operator()(const f32x4 (&acc)[2][2][4][2], const Unit& u, int wr, int wc, int fr, int fq) const {
        int fr_ = fr, fq_ = fq; asm volatile("" : "+v"(fr_), "+v"(fq_));
        body(acc, u, wr, wc, fr_, fq_);
    }
    __device__ __forceinline__ void body(const f32x4 (&acc)[2][2][4][2], const Unit& u, int wr, int wc, int fr, int fq) const {
        const int pn = u.pn, pm = u.pm;
        const bool meta_tile = (pm == MTOK / 256);
        const int b = pm >> 5;
        const int tu0 = (pm & 31) * 256 + wr * 64;
        if (pn < 24) {
            const int sec = pn >> 3, hb = (pn & 7) * 2;
            if (!(EPIZ_SECS & 1)) return;
            if (meta_tile && sec == 0) return;
            const bool st_ok = !(meta_tile && wr != 0);
            const int rows_per = sec == 0 ? SEQ : SKV, roff = sec == 0 ? 0 : 64;
            const rsrc_t rs = mk_rsrc(ws + (sec == 0 ? WS_QA : (sec == 1 ? WS_KA : WS_VA)), (unsigned)(NB * NH) * rows_per * HD * 2);
            const int voff = (fr * HD + 8 * fq) * 2;
            if (sec < 2) {
                LAS float* part = nrm;
#pragma unroll
                for (int ai = 0; ai < 2; ++ai)
#pragma unroll
                    for (int m = 0; m < 4; ++m)
#pragma unroll
                        for (int bj = 0; bj < 2; ++bj) { const f32x4 a = acc[ai][bj][m][0], c = acc[ai][bj][m][1];
                            float q = ((a[0] * a[0] + a[1] * a[1]) + (a[2] * a[2] + a[3] * a[3])) + ((c[0] * c[0] + c[1] * c[1]) + (c[2] * c[2] + c[3] * c[3]));
                            q += __shfl_xor(q, 16); q += __shfl_xor(q, 32);
                            if (fq == 0) part[((((wr * 2 + ai) * 4 + m) * 2 + bj) * 16 + fr) * 4 + wc] = q; }
                asm volatile("s_waitcnt lgkmcnt(0)" ::: "memory"); __builtin_amdgcn_s_barrier();
                const float* gp = (sec == 0 ? g_q : g_k) + wc * 32 + 8 * fq; const float gs = sec == 0 ? 0.08838834764831845f : 1.f;
                const f32x4 g0 = *(const f32x4*)gp * gs, g1 = *(const f32x4*)(gp + 4) * gs;
#pragma unroll
                for (int ai = 0; ai < 2; ++ai)
#pragma unroll
                    for (int m = 0; m < 4; ++m)
#pragma unroll
                        for (int bj = 0; bj < 2; ++bj) {
                            if (meta_tile && (ai != 0 || m != 0)) continue;
                            const f32x4 p4 = *(const LAS f32x4*)(part + ((((wr * 2 + ai) * 4 + m) * 2 + bj) * 16 + fr) * 4);
                            const float rn = 1.f / sqrtf(((p4[0] + p4[1]) + (p4[2] + p4[3])) * (1.f / HD) + EPS);
                            const f32x4 oa = acc[ai][bj][m][0] * rn * g0, oc = acc[ai][bj][m][1] * rn * g1;
                            if (!meta_tile) st8b(rs, voff, (((b * NH + hb + bj) * rows_per + roff + tu0 + ai * 128 + m * 16) * HD + wc * 32) * 2, oa, oc);
                            else if (st_ok) {
#pragma unroll
                                for (int bb = 0; bb < NB; ++bb) st8b(rs, voff, (((bb * NH + hb + bj) * rows_per + 48) * HD + wc * 32) * 2, oa, oc);
                            }
                        }
            } else if (st_ok) {
                if (!meta_tile) {
#pragma unroll
                    for (int ai = 0; ai < 2; ++ai)
#pragma unroll
                        for (int m = 0; m < 4; ++m)
#pragma unroll
                            for (int bj = 0; bj < 2; ++bj)
                                st8b(rs, voff, (((b * NH + hb + bj) * rows_per + roff + tu0 + ai * 128 + m * 16) * HD + wc * 32) * 2, acc[ai][bj][m][0], acc[ai][bj][m][1]);
                } else {
#pragma unroll
                    for (int bj = 0; bj < 2; ++bj)
#pragma unroll
                        for (int bb = 0; bb < NB; ++bb) st8b(rs, voff, (((bb * NH + hb + bj) * rows_per + 48) * HD + wc * 32) * 2, acc[0][bj][0][0], acc[0][bj][0][1]);
                }
            }
        } else if (pn < 40) {
            const bool isk = pn >= 32; const int hb = ((pn - 24) & 7) * 2;
            if (!(EPIZ_SECS & 2)) return;
            if (meta_tile && (!isk || wr != 0)) return;
            const rsrc_t rs = mk_rsrc(ws + (isk ? WS_KR : WS_QR), (unsigned)(NB * NH) * LR * HD * 2);
            const float sc = isk ? 0.08838834764831845f : 1.f;
            const int voff = (fr * HD + 8 * fq) * 2;
            double rr[4];
#pragma unroll
            for (int p = 0; p < 4; ++p) rr[p] = ROT_REV[wc * 16 + 4 * fq + p];
#pragma unroll
            for (int ai = 0; ai < 2; ++ai)
#pragma unroll
                for (int m = 0; m < 4; ++m) {
                    if (meta_tile && (ai != 0 || m != 0)) continue;
                    const int pos = meta_tile ? fr : (NMETA + tu0 + ai * 128 + m * 16 + fr);
                    float cs[4], sn[4];
#pragma unroll
                    for (int p = 0; p < 4; ++p) { double rv = (double)pos * rr[p]; rv -= __builtin_floor(rv); const float rf = (float)rv; sn[p] = __builtin_amdgcn_sinf(rf) * sc; cs[p] = __builtin_amdgcn_cosf(rf) * sc; }
#pragma unroll
                    for (int bj = 0; bj < 2; ++bj) {
                        const f32x4 a = acc[ai][bj][m][0], c = acc[ai][bj][m][1];
                        f32x4 oa, oc;
                        oa[0] = a[0] * cs[0] - a[1] * sn[0]; oa[1] = a[0] * sn[0] + a[1] * cs[0];
                        oa[2] = a[2] * cs[1] - a[3] * sn[1]; oa[3] = a[2] * sn[1] + a[3] * cs[1];
                        oc[0] = c[0] * cs[2] - c[1] * sn[2]; oc[1] = c[0] * sn[2] + c[1] * cs[2];
                        oc[2] = c[2] * cs[3] - c[3] * sn[3]; oc[3] = c[2] * sn[3] + c[3] * cs[3];
                        if (!meta_tile) st8b(rs, voff, (((b * NH + hb + bj) * LR + 128 + tu0 + ai * 128 + m * 16) * HD + wc * 32) * 2, oa, oc);
                        else {
#pragma unroll
                            for (int bb = 0; bb < NB; ++bb) st8b(rs, voff, (((bb * NH + hb + bj) * LR + 112) * HD + wc * 32) * 2, oa, oc);
                        }
                    }
                    __builtin_amdgcn_sched_barrier(0);
                }
        } else if (pn < 56) {
            const int h = pn - 40;
            if (!(EPIZ_SECS & 4)) return;
            if (meta_tile && wr != 0) return;
            const rsrc_t rs = mk_rsrc(ws + WS_VR, (unsigned)(NB * NH) * LR * RDV * 2);
            const int voff = (fr * RDV + 8 * fq) * 2;
            if (!meta_tile) {
#pragma unroll
                for (int ai = 0; ai < 2; ++ai)
#pragma unroll
                    for (int m = 0; m < 4; ++m)
#pragma unroll
                        for (int bj = 0; bj < 2; ++bj)
                            st8b(rs, voff, (((b * NH + h) * LR + 128 + tu0 + ai * 128 + m * 16) * RDV + bj * 128 + wc * 32) * 2, acc[ai][bj][m][0], acc[ai][bj][m][1]);
            } else {
#pragma unroll
                for (int bj = 0; bj < 2; ++bj)
#pragma unroll
                    for (int bb = 0; bb < NB; ++bb) st8b(rs, voff, (((bb * NH + h) * LR + 112) * RDV + bj * 128 + wc * 32) * 2, acc[0][bj][0][0], acc[0][bj][0][1]);
            }
        } else if (pn < 104) {
            if (meta_tile || !(EPIZ_SECS & 8)) return;
            const int sec = (pn - 56) >> 4;
            const rsrc_t rs = mk_rsrc(ws + (sec == 0 ? WS_GR : (sec == 1 ? WS_GA : WS_GT)), (unsigned)MTOK * DM * 2);
            const int voff = (fr * DM + 8 * fq) * 2, c0 = ((pn - 56) & 15) * 256 + wc * 32;
#pragma unroll
            for (int ai = 0; ai < 2; ++ai)
#pragma unroll
                for (int m = 0; m < 4; ++m) {
#pragma unroll
                    for (int bj = 0; bj < 2; ++bj) { f32x4 a = acc[ai][bj][m][0], c = acc[ai][bj][m][1];
                        if (sec == 0) {
#pragma unroll
                            for (int k = 0; k < 4; ++k) { a[k] = silu1(a[k]); c[k] = silu1(c[k]); }
                        } else {
#pragma unroll
                            for (int k = 0; k < 4; ++k) { a[k] = sigm1(a[k]); c[k] = sigm1(c[k]); }
                        }
                        st8b(rs, voff, ((pm * 256 + wr * 64 + ai * 128 + m * 16) * DM + c0 + bj * 128) * 2, a, c); }
                    __builtin_amdgcn_sched_barrier(0);
                }
        } else {
            if (!(EPIZ_SECS & 16)) return;
            if (wc != 0 || fq >= 2 || (meta_tile && wr != 0)) return;
            const rsrc_t rs = mk_rsrc(ws + WS_CUM, (unsigned)(NB * NH) * SKV * 4);
            const f32x4 b0 = *(const f32x4*)(b_forget + 8 * fq), b1 = *(const f32x4*)(b_forget + 8 * fq + 4);
            const int voff = (8 * fq * SKV + fr) * 4;
#pragma unroll
            for (int ai = 0; ai < 2; ++ai)
#pragma unroll
                for (int m = 0; m < 4; ++m) {
                    if (meta_tile && (ai != 0 || m != 0)) continue;
                    const f32x4 a = acc[ai][0][m][0] + b0, c = acc[ai][0][m][1] + b1;
#pragma unroll
                    for (int k = 0; k < 8; ++k) { const float lf = logsig1(k < 4 ? a[k] : c[k - 4]);
                        if (!meta_tile) ST1(((b * NH + k) * SKV + 64 + tu0 + ai * 128 + m * 16) * 4);
                        else { ST1(((0 * NH + k) * SKV + 48) * 4); ST1(((1 * NH + k) * SKV + 48) * 4); } }
                }
        }
    }
};
}
namespace pg8 {
__device__ __forceinline__ void unpack8(const u32x4 w, float (&f)[8]) {
    f[0] = __uint_as_float(w.x << 16); f[1] = __uint_as_float(w.x & 0xffff0000u); f[2] = __uint_as_float(w.y << 16); f[3] = __uint_as_float(w.y & 0xffff0000u);
    f[4] = __uint_as_float(w.z << 16); f[5] = __uint_as_float(w.z & 0xffff0000u); f[6] = __uint_as_float(w.w << 16); f[7] = __uint_as_float(w.w & 0xffff0000u);
}
template <int MODE> struct EpiGate {
    static constexpr bool PERM = true, AFTER_DRAIN = false;
    bf16_t* O; const bf16_t* G; int ldc;
    __device__ __forceinline__ void operator()(const f32x4 (&acc)[2][2][4][2], const Unit& u, int wr, int wc, int fr, int fq) const {
        const int row0 = u.pm * BM + wr * 64 + fr, col0 = u.pn * BM + wc * 32 + 8 * fq;
#pragma unroll
        for (int ai = 0; ai < 2; ++ai)
#pragma unroll
            for (int m = 0; m < 4; ++m) { const size_t off = (size_t)(row0 + ai * HALF + m * 16) * ldc + col0;
#pragma unroll
                for (int bj = 0; bj < 2; ++bj) { f32x4 v0 = acc[ai][bj][m][0], v1 = acc[ai][bj][m][1];
                    if (MODE != 2) { float g[8]; unpack8(*(const u32x4*)(G + off + bj * HALF), g);
                        v0[0] *= g[0]; v0[1] *= g[1]; v0[2] *= g[2]; v0[3] *= g[3]; v1[0] *= g[4]; v1[1] *= g[5]; v1[2] *= g[6]; v1[3] *= g[7]; }
                    if (MODE == 1) { float t[8]; unpack8(*(const u32x4*)(O + off + bj * HALF), t);
                        v0[0] += t[0]; v0[1] += t[1]; v0[2] += t[2]; v0[3] += t[3]; v1[0] += t[4]; v1[1] += t[5]; v1[2] += t[6]; v1[3] += t[7]; }
                    u32x4 w; w.x = cvt_pk_bf16(v0[0], v0[1]); w.y = cvt_pk_bf16(v0[2], v0[3]); w.z = cvt_pk_bf16(v1[0], v1[1]); w.w = cvt_pk_bf16(v1[2], v1[3]);
                    *(u32x4*)(O + off + bj * HALF) = w; } }
    }
};
struct EpiResF32 {
    static constexpr bool PERM = false, AFTER_DRAIN = false;
    const float* base; float* out; int ldc;
    __device__ __forceinline__ void operator()(const f32x4 (&acc)[2][2][4][2], const Unit& u, int wr, int wc, int fr, int fq) const {
        const int row0 = u.pm * BM + wr * 64 + fr, col0 = u.pn * BM + wc * 32 + 4 * fq;
#pragma unroll
        for (int ai = 0; ai < 2; ++ai)
#pragma unroll
            for (int m = 0; m < 4; ++m) { const size_t off = (size_t)(row0 + ai * HALF + m * 16) * ldc + col0;
#pragma unroll
                for (int bj = 0; bj < 2; ++bj)
#pragma unroll
                    for (int n = 0; n < 2; ++n) { const f32x4 bs = *(const f32x4*)(base + off + bj * HALF + n * 16); *(f32x4*)(out + off + bj * HALF + n * 16) = bs + acc[ai][bj][m][n]; } }
    }
};
struct EpiResHG {
    static constexpr bool PERM = false, AFTER_DRAIN = false;
    const float* base; float* out; bf16_t* HG; const float* gain; float* SSP; int ldc;
    __device__ __forceinline__ void operator()(const f32x4 (&acc)[2][2][4][2], const Unit& u, int wr, int wc, int fr, int fq) const {
        const int row0 = u.pm * BM + wr * 64 + fr, col0 = u.pn * BM + wc * 32 + 4 * fq;
        f32x4 gv[2][2];
#pragma unroll
        for (int bj = 0; bj < 2; ++bj)
#pragma unroll
            for (int n = 0; n < 2; ++n) gv[bj][n] = *(const f32x4*)(gain + col0 + bj * HALF + n * 16);
#pragma unroll
        for (int ai = 0; ai < 2; ++ai)
#pragma unroll
            for (int m = 0; m < 4; ++m) { const int row = row0 + ai * HALF + m * 16; const size_t off = (size_t)row * ldc + col0; float ss = 0.f;
#pragma unroll
                for (int bj = 0; bj < 2; ++bj)
#pragma unroll
                    for (int n = 0; n < 2; ++n) { const f32x4 h = *(const f32x4*)(base + off + bj * HALF + n * 16) + acc[ai][bj][m][n];
                        *(f32x4*)(out + off + bj * HALF + n * 16) = h; ss += (h[0] * h[0] + h[1] * h[1]) + (h[2] * h[2] + h[3] * h[3]);
                        const f32x4 hg = h * gv[bj][n]; typedef unsigned u32x2 __attribute__((ext_vector_type(2)));
                        u32x2 w; w.x = cvt_pk_bf16(hg[0], hg[1]); w.y = cvt_pk_bf16(hg[2], hg[3]); *(u32x2*)(HG + off + bj * HALF + n * 16) = w; }
                ss += __shfl_xor(ss, 16); ss += __shfl_xor(ss, 32);
                if (fq == 0) SSP[(size_t)row * 64 + u.pn * 4 + wc] = ss; }
    }
};
struct EpiRowScale {
    static constexpr bool PERM = true, AFTER_DRAIN = false;
    bf16_t* O; const PG8_LAS float* rs; int ldc;
    __device__ __forceinline__ void operator()(const f32x4 (&acc)[2][2][4][2], const Unit& u, int wr, int wc, int fr, int fq) const {
        const int rl0 = wr * 64 + fr, col0 = u.pn * BM + wc * 32 + 8 * fq; const PG8_LAS float* rp = rs + 256 * u.idx;
#pragma unroll
        for (int ai = 0; ai < 2; ++ai)
#pragma unroll
            for (int m = 0; m < 4; ++m) { const int rl = rl0 + ai * HALF + m * 16; const float r = rp[rl]; const size_t off = (size_t)(u.pm * BM + rl) * ldc + col0;
#pragma unroll
                for (int bj = 0; bj < 2; ++bj) { const f32x4 v0 = acc[ai][bj][m][0] * r, v1 = acc[ai][bj][m][1] * r;
                    u32x4 w; w.x = cvt_pk_bf16(v0[0], v0[1]); w.y = cvt_pk_bf16(v0[2], v0[3]); w.z = cvt_pk_bf16(v1[0], v1[1]); w.w = cvt_pk_bf16(v1[2], v1[3]);
                    *(u32x4*)(O + off + bj * HALF) = w; } }
    }
};
struct EpiNull { static constexpr bool PERM = true, AFTER_DRAIN = false; float* sink;
    __device__ __forceinline__ void operator()(const f32x4 (&acc)[2][2][4][2], const Unit& u, int wr, int wc, int fr, int fq) const {
        if (sink) { float s = 0.f;
#pragma unroll
            for (int ai = 0; ai < 2; ++ai)
#pragma unroll
                for (int bj = 0; bj < 2; ++bj)
#pragma unroll
                    for (int m = 0; m < 4; ++m)
#pragma unroll
                        for (int n = 0; n < 2; ++n) s += acc[ai][bj][m][n][0] + acc[ai][bj][m][n][1] + acc[ai][bj][m][n][2] + acc[ai][bj][m][n][3];
            if (s == 123.456f) *sink = s; } } };
struct SyncOrder : StaticOrder {
    unsigned* cnt; int on;
    __device__ __forceinline__ void a_ready(const Unit& u) const {
        if (!on) return;
        if (threadIdx.x < 64) {
            const int g = c & 7, i = u.idx;
            const long rem = (long)nwg - (long)i * G;
            const int lim = rem < (long)G ? (int)rem : G;
            const unsigned want = (unsigned)((lim - g + 7) / 8);
            unsigned* w = cnt + (size_t)(i * 8 + g) * 64;
            if (threadIdx.x == 0) __hip_atomic_fetch_add(w, 1u, __ATOMIC_RELAXED, __HIP_MEMORY_SCOPE_AGENT);
            const unsigned long long t0 = __builtin_amdgcn_s_memrealtime();
            while ((unsigned)__builtin_amdgcn_readfirstlane(__hip_atomic_load(w, __ATOMIC_RELAXED, __HIP_MEMORY_SCOPE_AGENT)) < want) {
                if (__builtin_amdgcn_s_memrealtime() - t0 > 20000ull) break;
                __builtin_amdgcn_s_sleep(2); }
        }
        asm volatile("" ::: "memory"); __builtin_amdgcn_s_barrier(); asm volatile("" ::: "memory");
    }
};
}
namespace pg8 {
template <class Epi, class Sched, bool ALIGN_EPI = false, bool SP2 = false>
__device__ __forceinline__ void gemm_phase(PG8_LAS unsigned char* lds, const Gemm g, const Sched& S, const Epi& E) {
    int tid_ = threadIdx.x; asm volatile("" : "+v"(tid_));
    const int tid = tid_, wid = __builtin_amdgcn_readfirstlane(tid >> 6), lane = tid & 63, wr = wid >> 2, wc = wid & 3, fr = lane & 15, fq = lane >> 4;
    const int K = g.K, nt = K / BK;
    unsigned voffA[2], voffB[2];
#pragma unroll
    for (int i = 0; i < 2; ++i) { int R, C; stage_rc(tid * 16 + i * 8192, R, C); const int Rb = Epi::PERM ? ((R & ~31) + perm32(R & 31)) : R;
        voffA[i] = (unsigned)(R * K + C) * 2u; voffB[i] = (unsigned)(Rb * K + C) * 2u; }
    const size_t kstep = (size_t)(BK * 2);
    const size_t hstep = (size_t)HALF * K * 2;
    const size_t tstep = 2 * hstep;
    const unsigned ldsw = (unsigned)wid * 1024u;
    const int aoff = lds_byte(wr * 64 + fr, fq * 8), boff = lds_byte(wc * 32 + fr, fq * 8);
#define PG8_SA(b, h) (((b) * 2 + (h)) * HTB)
#define PG8_SB(b, h) ((4 + (b) * 2 + (h)) * HTB)
#define PG8_STAGE(bufoff, gbase, voff) do { _Pragma("unroll") for (int _i = 0; _i < 2; ++_i) \
        __builtin_amdgcn_global_load_lds((const unsigned*)((const char*)(gbase) + (voff)[_i]), (PG8_LAS unsigned*)(lds + (bufoff) + ldsw + _i * 8192), 16, 0, 0); } while (0)
#define PG8_LDA(dst, b, h) do { _Pragma("unroll") for (int m = 0; m < 4; ++m) _Pragma("unroll") for (int k = 0; k < 2; ++k) dst[m][k] = *(const PG8_LAS bf16x8*)(lds + PG8_SA(b, h) + aoff + m * 2048 + k * 1024); } while (0)
#define PG8_LDB(dst, b, h) do { _Pragma("unroll") for (int n = 0; n < 2; ++n) _Pragma("unroll") for (int k = 0; k < 2; ++k) dst[n][k] = *(const PG8_LAS bf16x8*)(lds + PG8_SB(b, h) + boff + n * 2048 + k * 1024); } while (0)
#define PG8_MMA(ai, bj, At, Bt) do { __builtin_amdgcn_s_setprio(1); _Pragma("unroll") for (int m = 0; m < 4; ++m) _Pragma("unroll") for (int n = 0; n < 2; ++n) _Pragma("unroll") for (int k = 0; k < 2; ++k) \
        acc[ai][bj][m][n] = __builtin_amdgcn_mfma_f32_16x16x32_bf16(Bt[n][k], At[m][k], acc[ai][bj][m][n], 0, 0, 0); __builtin_amdgcn_s_setprio(0); } while (0)
#define PG8_WAIT_V(n) asm volatile("s_waitcnt vmcnt(" #n ")" ::: "memory")
#define PG8_WAIT_L(n) asm volatile("s_waitcnt lgkmcnt(" #n ")" ::: "memory")
#define PG8_BAR __builtin_amdgcn_s_barrier()
#define PG8_SCHED __builtin_amdgcn_sched_barrier(0)
    Unit cur, nxt; int ui = 0;
    if (!S.next(0, cur)) return;
    f32x4 acc[2][2][4][2];
#pragma unroll
    for (int a = 0; a < 2; ++a)
#pragma unroll
        for (int b = 0; b < 2; ++b)
#pragma unroll
            for (int m = 0; m < 4; ++m)
#pragma unroll
                for (int n = 0; n < 2; ++n) acc[a][b][m][n] = (f32x4){0.f, 0.f, 0.f, 0.f};
    bf16x8 At[4][2], B0[2][2], B1[2][2];
    const char* cA = (const char*)g.A + (size_t)cur.pm * tstep; const char* cB = (const char*)g.Bt + (size_t)cur.pn * tstep;
    S.a_ready(cur);
    if constexpr (SP2) {
        PG8_STAGE(PG8_SB(0, 0), cB, voffB); PG8_STAGE(PG8_SB(0, 1), cB + hstep, voffB); PG8_STAGE(PG8_SA(0, 0), cA, voffA); PG8_STAGE(PG8_SA(0, 1), cA + hstep, voffA);
        if (wr == 1) PG8_BAR;
        PG8_WAIT_V(2); PG8_BAR;
        PG8_STAGE(PG8_SB(1, 0), cB + kstep, voffB); PG8_STAGE(PG8_SA(1, 0), cA + kstep, voffA); PG8_STAGE(PG8_SB(1, 1), cB + hstep + kstep, voffB);
        PG8_WAIT_V(6); PG8_BAR;
    } else {
        PG8_STAGE(PG8_SB(0, 0), cB, voffB); PG8_STAGE(PG8_SA(0, 0), cA, voffA); PG8_STAGE(PG8_SB(0, 1), cB + hstep, voffB); PG8_STAGE(PG8_SA(0, 1), cA + hstep, voffA);
        if (wr == 1) PG8_BAR;
        PG8_WAIT_V(4); PG8_BAR;
        PG8_STAGE(PG8_SB(1, 0), cB + kstep, voffB); PG8_STAGE(PG8_SA(1, 0), cA + kstep, voffA); PG8_STAGE(PG8_SB(1, 1), cB + hstep + kstep, voffB);
        PG8_WAIT_V(6); PG8_BAR;
    }
    for (;;) {
        const bool has_next = S.next(ui + 1, nxt);
        const char* nA = has_next ? (const char*)g.A + (size_t)nxt.pm * tstep : cA; const char* nB = has_next ? (const char*)g.Bt + (size_t)nxt.pn * tstep : cB;
        for (int t = 0; t < nt; t += 2) {
            const bool last = (t == nt - 2);
            const char* a1 = cA + (size_t)(t + 1) * kstep;
            const char* a2 = last ? nA : cA + (size_t)(t + 2) * kstep; const char* b2 = last ? nB : cB + (size_t)(t + 2) * kstep;
            const char* a3 = a2 + kstep; const char* b3 = b2 + kstep;
            if (last && has_next) S.a_ready(nxt);
            if constexpr (SP2) {
            PG8_LDB(B0, 0, 0); PG8_LDB(B1, 0, 1); PG8_SCHED; PG8_LDA(At, 0, 0); PG8_STAGE(PG8_SA(1, 1), a1 + hstep, voffA);
            PG8_WAIT_V(8); PG8_WAIT_L(0); PG8_BAR; PG8_MMA(0, 0, At, B0); PG8_MMA(0, 1, At, B1); PG8_BAR; PG8_SCHED;
            PG8_LDA(At, 0, 1); PG8_STAGE(PG8_SB(0, 0), b2, voffB); PG8_STAGE(PG8_SB(0, 1), b2 + hstep, voffB); PG8_STAGE(PG8_SA(0, 0), a2, voffA);
            PG8_WAIT_V(8); PG8_WAIT_L(0); PG8_BAR; PG8_MMA(1, 0, At, B0); PG8_MMA(1, 1, At, B1); PG8_BAR; PG8_SCHED;
            PG8_LDB(B0, 1, 0); PG8_LDB(B1, 1, 1); PG8_SCHED; PG8_LDA(At, 1, 0); PG8_STAGE(PG8_SA(0, 1), a2 + hstep, voffA);
            PG8_WAIT_V(8); PG8_WAIT_L(0); PG8_BAR; PG8_MMA(0, 0, At, B0); PG8_MMA(0, 1, At, B1); PG8_BAR; PG8_SCHED;
            PG8_LDA(At, 1, 1); PG8_STAGE(PG8_SB(1, 0), b3, voffB); PG8_STAGE(PG8_SB(1, 1), b3 + hstep, voffB); PG8_STAGE(PG8_SA(1, 0), a3, voffA);
            PG8_WAIT_V(8); PG8_WAIT_L(0); PG8_BAR; PG8_MMA(1, 0, At, B0); PG8_MMA(1, 1, At, B1); PG8_BAR; PG8_SCHED;
            } else {
            PG8_LDB(B0, 0, 0); PG8_SCHED; PG8_LDA(At, 0, 0); PG8_STAGE(PG8_SA(1, 1), a1 + hstep, voffA);
            PG8_WAIT_L(8); PG8_BAR; PG8_WAIT_L(0); PG8_MMA(0, 0, At, B0); PG8_BAR; PG8_SCHED;
            PG8_LDB(B1, 0, 1); PG8_STAGE(PG8_SB(0, 0), b2, voffB);
            PG8_BAR; PG8_WAIT_L(0); PG8_MMA(0, 1, At, B1); PG8_BAR;
            PG8_LDA(At, 0, 1); PG8_STAGE(PG8_SA(0, 0), a2, voffA);
            PG8_BAR; PG8_WAIT_L(0); PG8_MMA(1, 0, At, B0); PG8_BAR; PG8_SCHED;
            PG8_STAGE(PG8_SB(0, 1), b2 + hstep, voffB);
            PG8_WAIT_V(6); PG8_BAR; PG8_MMA(1, 1, At, B1); PG8_BAR;
            PG8_LDB(B0, 1, 0); PG8_SCHED; PG8_LDA(At, 1, 0); PG8_STAGE(PG8_SA(0, 1), a2 + hstep, voffA);
            PG8_WAIT_L(8); PG8_BAR; PG8_WAIT_L(0); PG8_MMA(0, 0, At, B0); PG8_BAR; PG8_SCHED;
            PG8_LDB(B1, 1, 1); PG8_STAGE(PG8_SB(1, 0), b3, voffB);
            PG8_BAR; PG8_WAIT_L(0); PG8_MMA(0, 1, At, B1); PG8_BAR;
            PG8_LDA(At, 1, 1); PG8_STAGE(PG8_SA(1, 0), a3, voffA);
            PG8_BAR; PG8_WAIT_L(0); PG8_MMA(1, 0, At, B0); PG8_BAR; PG8_SCHED;
            PG8_STAGE(PG8_SB(1, 1), b3 + hstep, voffB);
            PG8_WAIT_V(6); PG8_BAR; PG8_MMA(1, 1, At, B1); PG8_BAR;
            }
        }
        if constexpr (ALIGN_EPI) { if (wr == 0) PG8_BAR; }
        if constexpr (!Epi::AFTER_DRAIN) { E(acc, cur, wr, wc, fr, fq); S.done(cur); }
        if (!has_next) break;
#pragma unroll
        for (int a = 0; a < 2; ++a)
#pragma unroll
            for (int b = 0; b < 2; ++b)
#pragma unroll
                for (int m = 0; m < 4; ++m)
#pragma unroll
                    for (int n = 0; n < 2; ++n) acc[a][b][m][n] = (f32x4){0.f, 0.f, 0.f, 0.f};
        cur = nxt; cA = nA; cB = nB; ++ui;
        if constexpr (ALIGN_EPI) { if (wr == 1) PG8_BAR; }
    }
    PG8_WAIT_V(0);
    if constexpr (!ALIGN_EPI) { if (wr == 0) PG8_BAR; }
    PG8_BAR;
    if constexpr (Epi::AFTER_DRAIN) { E.fused(acc, cur, wr, wc, fr, fq, lds, wid, lane); S.done(cur); }
#undef PG8_SA
#undef PG8_SB
#undef PG8_STAGE
#undef PG8_LDA
#undef PG8_LDB
#undef PG8_MMA
#undef PG8_WAIT_V
#undef PG8_WAIT_L
#undef PG8_BAR
#undef PG8_SCHED
}
}
#define XB_TMO      128
#define XB_XCNT(j)  (256  + 64 * (j))
#define XB_XSUB(j)  (1280 + 64 * (j))
#define XB_XGEN(j)  (2304 + 64 * (j))
#define XB_TOP      3328
#define XB_TOPGEN   3392
#define XCD_BAR_WORDS 3456
#define XB_SPIN_CAP (1u << 22)

__device__ __forceinline__ unsigned xb_ld(unsigned* p)              { return __hip_atomic_load(p, __ATOMIC_RELAXED, __HIP_MEMORY_SCOPE_AGENT); }
__device__ __forceinline__ unsigned xb_add(unsigned* p, unsigned v) { return __hip_atomic_fetch_add(p, v, __ATOMIC_RELAXED, __HIP_MEMORY_SCOPE_AGENT); }
__device__ __forceinline__ unsigned xb_xcc_id() { return (unsigned)__builtin_amdgcn_s_getreg((3 << 11) | 20) & 0xFu; }
#define XB_SPIN(cond, bar) do { unsigned _sp = 0; while (cond) { __builtin_amdgcn_s_sleep(1); \
    if ((++_sp & 255u) == 0u) { if (xb_ld(&(bar)[XB_TMO])) break; if (_sp > XB_SPIN_CAP) { atomicAdd(&(bar)[XB_TMO], 1u); break; } } } } while (0)

struct XcdBarrier {
    unsigned* bar; unsigned x; unsigned G;
    volatile LAS unsigned* st;
};

__device__ __forceinline__ XcdBarrier xcd_barrier_post(unsigned* bar, volatile LAS unsigned* st, unsigned G) {
    XcdBarrier b; b.bar = bar; b.x = xb_xcc_id(); b.st = st; b.G = G;
    if (threadIdx.x == 0) (void)xb_add(&bar[XB_XCNT(b.x)], 1u);
    return b;
}
__device__ __forceinline__ void xcd_barrier_complete(unsigned* bar, unsigned x, unsigned G, unsigned& nloc, unsigned& nx) {
    unsigned sum, cnt, mine, sp = 0u;
    for (;;) {
        sum = 0u; cnt = 0u; mine = 0u;
#pragma unroll
        for (unsigned j = 0; j < 16; ++j) { const unsigned c = xb_ld(&bar[XB_XCNT(j)]); sum += c; cnt += (c > 0u) ? 1u : 0u; mine = (j == x) ? c : mine; }
        if (sum == G) break;
        __builtin_amdgcn_s_sleep(1);
        if ((++sp & 255u) == 0u) { if (xb_ld(&bar[XB_TMO])) break; if (sp > XB_SPIN_CAP) { atomicAdd(&bar[XB_TMO], 1u); break; } }
    }
    nloc = mine > 0u ? mine : 1u; nx = cnt > 0u ? cnt : 1u;
}

__device__ __forceinline__ void xcd_barrier(const XcdBarrier& b) {
    asm volatile("s_waitcnt vmcnt(0)" ::: "memory");
    __syncthreads();
    if (threadIdx.x == 0) {
        unsigned* bar = b.bar;
        __builtin_amdgcn_s_waitcnt(0);
        unsigned nloc = b.st[0], nx = b.st[1];
        if (nloc == 0u) { xcd_barrier_complete(bar, b.x, b.G, nloc, nx); b.st[0] = nloc; b.st[1] = nx; }
        const unsigned old = xb_add(&bar[XB_XSUB(b.x)], 1u);
        const unsigned gen = old / nloc;
        if (old + 1u == (gen + 1u) * nloc) {
            __builtin_amdgcn_fence(__ATOMIC_RELEASE, "agent");
            asm volatile("s_waitcnt vmcnt(0)" ::: "memory");
            const unsigned og = xb_add(&bar[XB_TOP], 1u);
            const unsigned tg = og / nx;
            if (og + 1u == (tg + 1u) * nx) xb_add(&bar[XB_TOPGEN], 1u);
            else XB_SPIN(xb_ld(&bar[XB_TOPGEN]) == tg, bar);
            __builtin_amdgcn_fence(__ATOMIC_ACQUIRE, "agent");
            xb_add(&bar[XB_XGEN(b.x)], 1u);
            asm volatile("s_waitcnt vmcnt(0)" ::: "memory");
        } else {
            XB_SPIN(xb_ld(&bar[XB_XGEN(b.x)]) == gen, bar);
            __builtin_amdgcn_fence(__ATOMIC_ACQUIRE, "agent");
            asm volatile("s_waitcnt vmcnt(0)" ::: "memory");
        }
    }
    __syncthreads();
}
struct Frame {
    LAS unsigned char* lds;
    volatile LAS unsigned* MISC;
    gu32* ctl;
    int tid, lane, wave;
    int vcu, G;
    unsigned char* ws;
    const float *x, *meta, *g_mix, *w_in, *b_forget, *g_q, *g_k, *g_ret, *w_fox, *w_ret, *w_out, *g_ffn, *w_q, *keys1, *keys2, *pu, *pv;
    float* out;
};
template <class T> __device__ __forceinline__ T* wsp(const Frame& F, size_t off) { return (T*)(F.ws + off); }

__device__ __forceinline__ int z_src_col(int n) {
    if (n < Z_QR) return n;
    if (n < Z_VR) { const int np = n - Z_QR, j = np & 127, base = np - j; return 6160 + base + ((j & 1) ? 64 + (j >> 1) : (j >> 1)); }
    if (n < Z_F) return n + 16;
    if (n < Z_F + 16) return 6144 + (n - Z_F);
    return -1;
}
template <bool ZMAP>
__device__ __forceinline__ void p0_transpose_item(const float* W, int K, int Nsrc, int Ndst, bf16* WT, LAS float* scr, int item, int lane) {
    const int nblk = Ndst / 32, kb = item / nblk, nb = item % nblk, k0 = 64 * kb, n0 = 32 * nb;
    const int sc = ZMAP ? z_src_col(n0 + (lane & 31)) : (n0 + (lane & 31));
    float tv[32];
#pragma unroll
    for (int i = 0; i < 32; ++i) { const int kk = 2 * i + (lane >> 5); tv[i] = (sc >= 0) ? W[(size_t)(k0 + kk) * Nsrc + sc] : 0.f; }
#pragma unroll
    for (int i = 0; i < 32; ++i) { const int kk = 2 * i + (lane >> 5); scr[kk * 33 + (lane & 31)] = tv[i]; }
    LDS_WAIT(); asm volatile("" ::: "memory");
    const int c = lane & 7;
#pragma unroll
    for (int j = 0; j < 4; ++j) { const int n = (lane >> 3) + 8 * j; const LAS float* s = scr + (8 * c) * 33 + n;
        v4u o; o.x = pk2(s[0 * 33], s[1 * 33]); o.y = pk2(s[2 * 33], s[3 * 33]); o.z = pk2(s[4 * 33], s[5 * 33]); o.w = pk2(s[6 * 33], s[7 * 33]);
        *(GAS v4u*)(WT + (size_t)(n0 + n) * K + k0 + 8 * c) = o; }
    LDS_WAIT(); asm volatile("" ::: "memory");
}
__device__ __forceinline__ void rms_row_to_bf16(const float* xrow, const float* g, bf16* orow, int lane) {
    asm volatile("" : "+v"(lane));
    const GAS f32x4* xr = (const GAS f32x4*)xrow + lane;
    f32x4 v[16]; float s = 0.f;
#pragma unroll
    for (int j = 0; j < 16; ++j) { v[j] = xr[64 * j]; s += (v[j].x * v[j].x + v[j].y * v[j].y) + (v[j].z * v[j].z + v[j].w * v[j].w); }
    const float r = 1.f / sqrtf(wave_sum(s) * (1.f / DM) + EPS);
    const GAS f32x4* gr = (const GAS f32x4*)g + lane;
    GAS v2u* o8 = (GAS v2u*)orow + lane;
#pragma unroll
    for (int j = 0; j < 16; ++j) { const f32x4 gg = gr[64 * j]; v2u w; w.x = pk2(v[j].x * r * gg.x, v[j].y * r * gg.y); w.y = pk2(v[j].z * r * gg.z, v[j].w * r * gg.w); o8[64 * j] = w; }
}
__device__ __forceinline__ void zero_bytes16(unsigned char* p, size_t n16, int gt, int NT) {
    const v4u z = {0u, 0u, 0u, 0u};
    for (size_t i = gt; i < n16; i += NT) ((GAS v4u*)p)[i] = z;
}
__device__ __forceinline__ void p0_prologue(Frame& F) {
    LAS float* scr = (LAS float*)(F.lds + RING_OFF + F.wave * 16384);
    const int gw = F.vcu * 8 + F.wave, NGW = F.G * 8;
    bf16* WZ = wsp<bf16>(F, WS_WZ); bf16* WFOX = wsp<bf16>(F, WS_WFOX); bf16* WRET = wsp<bf16>(F, WS_WRET); bf16* WOUT = wsp<bf16>(F, WS_WOUT); bf16* WQ = wsp<bf16>(F, WS_WQ);
    constexpr int I_Z = (DM / 64) * (NZ / 32), I_FOX = (2048 / 64) * (DM / 32), I_RET = (DM / 64) * (DM / 32), I_OUT = I_RET, I_Q = (DM / 64) * (PQ / 32);
    constexpr int NITEMS = I_Z + I_FOX + I_RET + I_OUT + I_Q;
    for (int it = gw; it < NITEMS; it += NGW) {
        int r = it;
        if (r < I_Z) { p0_transpose_item<true>(F.w_in, DM, 26640, NZ, WZ, scr, r, F.lane); continue; } r -= I_Z;
        if (r < I_FOX) { p0_transpose_item<false>(F.w_fox, 2048, DM, DM, WFOX, scr, r, F.lane); continue; } r -= I_FOX;
        if (r < I_RET) { p0_transpose_item<false>(F.w_ret, DM, DM, DM, WRET, scr, r, F.lane); continue; } r -= I_RET;
        if (r < I_OUT) { p0_transpose_item<false>(F.w_out, DM, DM, DM, WOUT, scr, r, F.lane); continue; } r -= I_OUT;
        p0_transpose_item<false>(F.w_q, DM, PQ, PQ, WQ, scr, r, F.lane);
    }
    bf16* UX = wsp<bf16>(F, WS_UX);
    for (int m = gw; m < MTOK + NMETA; m += NGW) {
        const float* src = (m < MTOK) ? F.x + (size_t)m * DM : F.meta + (size_t)(m - MTOK) * DM;
        rms_row_to_bf16(src, F.g_mix, UX + (size_t)m * DM, F.lane);
    }
    const int gt = F.vcu * 512 + F.tid, NT = F.G * 512;
    zero_bytes16((unsigned char*)(UX + (size_t)(MTOK + NMETA) * DM), (size_t)(256 - NMETA) * DM * 2 / 16, gt, NT);
    { bf16* KB = wsp<bf16>(F, WS_KEYS); constexpr int NKE = PH * PK * PK;
      for (int i = gt; i < 2 * NKE / 4; i += NT) { const float* s = (i < NKE / 4) ? F.keys1 + 4 * (size_t)i : F.keys2 + 4 * (size_t)(i - NKE / 4); const f32x4 v = *(const GAS f32x4*)s;
          v2u w; w.x = pk2(v.x, v.y); w.y = pk2(v.z, v.w); *(GAS v2u*)(KB + 4 * (size_t)i) = w; } }
    for (int bh = 0; bh < NB * NH; ++bh) {
        zero_bytes16((unsigned char*)(wsp<bf16>(F, WS_KA) + (size_t)bh * SKV * HD), 48 * HD * 2 / 16, gt, NT);
        zero_bytes16((unsigned char*)(wsp<bf16>(F, WS_VA) + (size_t)bh * SKV * HD), 48 * HD * 2 / 16, gt, NT);
        zero_bytes16((unsigned char*)(wsp<bf16>(F, WS_KR) + (size_t)bh * LR * HD), 112 * HD * 2 / 16, gt, NT);
        zero_bytes16((unsigned char*)(wsp<bf16>(F, WS_VR) + (size_t)bh * LR * RDV), 112 * RDV * 2 / 16, gt, NT);
    }
}
typedef short v4i16_t __attribute__((ext_vector_type(4)));
__device__ __forceinline__ int v_st(int k, int c) { const int kk = (k & ~0xC) | ((k & 4) << 1) | ((k & 8) >> 1); return ((kk >> 3) * 4 + (c >> 5)) * 512 + ((kk & 7) * 32 + (c & 31)) * 2; }
__device__ __forceinline__ int v_rd_base(int lane) { return ((lane & 3) << 3) | (((lane >> 2) & 3) << 6) | (((lane >> 4) & 1) << 5) | (((lane >> 5) & 1) << 8); }
__device__ __forceinline__ s16x4 vtr(const LAS unsigned char* p) { return __builtin_bit_cast(s16x4, __builtin_amdgcn_ds_read_tr16_b64_v4i16((LAS v4i16_t*)p)); }
__device__ __forceinline__ bf16x8 tr_frag(const LAS unsigned char* p) {
    const s16x4 l = vtr(p), h = vtr(p + 2048);
    return (bf16x8){l[0], l[1], l[2], l[3], h[0], h[1], h[2], h[3]};
}
__device__ __forceinline__ int crow(int r, int hi) { return (r & 3) + 8 * (r >> 2) + 4 * hi; }
__device__ const float LG2GAM[16] = { -4.580368961e-02f, -2.272007650e-02f, -1.131531323e-02f, -5.646563141e-03f, -2.820519062e-03f, -1.409570255e-03f, -7.046129766e-04f, -3.522634716e-04f,
    -1.761209843e-04f, -8.805780458e-05f, -4.402823044e-05f, -2.201394726e-05f, -1.100693164e-05f, -5.503455325e-06f, -2.751725038e-06f, -1.375861863e-06f };

__device__ __forceinline__ void p2_cumsum(float* CUMp, int lane) {
    float carry = 0.f;
    constexpr int NIT = (SKV - 48 + 255) / 256;
    const GAS f32x4* src = (const GAS f32x4*)(CUMp + 48) + lane;
    f32x4 v = *src, vn;
    for (int it = 0; it < NIT; ++it) {
        const int j0n = 48 + (it + 1) * 256 + lane * 4;
        vn = (f32x4){0.f, 0.f, 0.f, 0.f};
        if (it + 1 < NIT && j0n < SKV) vn = src[(it + 1) * 64];
        const float p0 = v.x, p1 = p0 + v.y, p2 = p1 + v.z, p3 = p2 + v.w;
        float x = p3;
#pragma unroll
        for (int o = 1; o < 64; o <<= 1) { const float t = __shfl_up(x, o); if (lane >= o) x += t; }
        const float excl = carry + (x - p3);
        const int j0 = 48 + it * 256 + lane * 4;
        if (j0 < SKV) *((GAS f32x4*)(CUMp + j0)) = (f32x4){-(excl + p0), -(excl + p1), -(excl + p2), -(excl + p3)};
        carry += __shfl(x, 63);
        v = vn;
    }
    if (lane < 12) *((GAS f32x4*)CUMp + lane) = (f32x4){-__builtin_inff(), -__builtin_inff(), -__builtin_inff(), -__builtin_inff()};
}
__device__ __forceinline__ void p2_qknorm(Frame& F, int gw, int NGW) {
    constexpr int R_Q = NB * NH * SEQ, RK_PER = SKV - 48, R_K = NB * NH * RK_PER, NSTEP = (R_Q + R_K) / 4;
    bf16* QA = wsp<bf16>(F, WS_QA); bf16* KA = wsp<bf16>(F, WS_KA);
    const int sub = F.lane >> 4, c8 = (F.lane & 15) * 8;
    float gq[8], gk[8];
#pragma unroll
    for (int k = 0; k < 8; ++k) { gq[k] = F.g_q[c8 + k] * 0.08838834764831845f; gk[k] = F.g_k[c8 + k]; }
    for (int s0 = gw; s0 < NSTEP; s0 += 8 * NGW) {
        v4u w[8]; bf16* ptr[8]; bool isq[8], ok[8];
#pragma unroll
        for (int u = 0; u < 8; ++u) { const int s = s0 + u * NGW; ok[u] = s < NSTEP; const int r = 4 * s + sub;
            if (r < R_Q) { isq[u] = true; ptr[u] = QA + (size_t)r * HD + c8; }
            else { const int rp = r - R_Q, bh = rp / RK_PER, j = 48 + rp % RK_PER; isq[u] = false; ptr[u] = KA + ((size_t)bh * SKV + j) * HD + c8; }
            if (ok[u]) w[u] = *(const GAS v4u*)ptr[u]; else w[u] = (v4u){0u, 0u, 0u, 0u}; }
#pragma unroll
        for (int u = 0; u < 8; ++u) {
            float f[8] = {bflo(w[u].x), bfhi(w[u].x), bflo(w[u].y), bfhi(w[u].y), bflo(w[u].z), bfhi(w[u].z), bflo(w[u].w), bfhi(w[u].w)};
            float ss = 0.f;
#pragma unroll
            for (int k = 0; k < 8; ++k) ss += f[k] * f[k];
            ss += __shfl_xor(ss, 1); ss += __shfl_xor(ss, 2); ss += __shfl_xor(ss, 4); ss += __shfl_xor(ss, 8);
            const float rs = 1.f / sqrtf(ss * (1.f / HD) + EPS);
#pragma unroll
            for (int k = 0; k < 8; ++k) f[k] = f[k] * rs * (isq[u] ? gq[k] : gk[k]);
            v4u o; o.x = pk2(f[0], f[1]); o.y = pk2(f[2], f[3]); o.z = pk2(f[4], f[5]); o.w = pk2(f[6], f[7]);
            if (ok[u]) *(GAS v4u*)ptr[u] = o;
        }
    }
}
struct KvRegs { v4u kw[4], vw[2][4]; };
__device__ __forceinline__ void p2_kv_load(Frame& F, int item, KvRegs& R) {
    const int bh = item >> 6, n = item & 63;
    const bf16* Kg = wsp<bf16>(F, WS_KR) + ((size_t)bh * LR + 128 * n) * HD;
    const bf16* Vg = wsp<bf16>(F, WS_VR) + ((size_t)bh * LR + 128 * n) * RDV;
    int tid_ = F.tid; asm volatile("" : "+v"(tid_));
    const int sr = tid_ >> 4, sc = (tid_ & 15) * 8;
#pragma unroll
    for (int q = 0; q < 4; ++q) { const int j = sr + 32 * q; R.kw[q] = *(const GAS v4u*)(Kg + (size_t)j * HD + sc);
        R.vw[0][q] = *(const GAS v4u*)(Vg + (size_t)j * RDV + sc); R.vw[1][q] = *(const GAS v4u*)(Vg + (size_t)j * RDV + 128 + sc); }
}
__device__ __forceinline__ void p2_kv_item(Frame& F, int item, int next, KvRegs& R) {
    const int bh = item >> 6, h = bh & (NH - 1);
    const float lg2 = LG2GAM[h];
    LAS unsigned char* ldsV = F.lds; LAS unsigned char* ldsK = F.lds + 65536;
    const int sr = F.tid >> 4, sc = (F.tid & 15) * 8;
#pragma unroll
    for (int q = 0; q < 4; ++q) { const int j = sr + 32 * q; const float z = fast_exp2(lg2 * (float)(127 - j));
        const v4u kq = R.kw[q];
        v4u o; o.x = pk2(bflo(kq.x) * z, bfhi(kq.x) * z); o.y = pk2(bflo(kq.y) * z, bfhi(kq.y) * z); o.z = pk2(bflo(kq.z) * z, bfhi(kq.z) * z); o.w = pk2(bflo(kq.w) * z, bfhi(kq.w) * z);
        const int so = v_st(j & 63, sc);
        *(LAS v4u*)(ldsK + (j >> 6) * 16384 + so) = o;
        *(LAS v4u*)(ldsV + ((j >> 6) * 2 + 0) * 16384 + so) = R.vw[0][q];
        *(LAS v4u*)(ldsV + ((j >> 6) * 2 + 1) * 16384 + so) = R.vw[1][q]; }
    __syncthreads();
    if (next < NB * NH * NCHUNK) p2_kv_load(F, next, R);
    const int w = F.wave, r32 = F.lane & 31, hi = F.lane >> 5;
    const LAS unsigned char* pa = ldsV + v_rd_base(F.lane) + (w >> 2) * 16384 + (w & 3) * 512;
    const LAS unsigned char* pb = ldsK + v_rd_base(F.lane);
    f32x16 acc[4] = {};
#pragma unroll
    for (int jh = 0; jh < 2; ++jh)
#pragma unroll
        for (int ks = 0; ks < 4; ++ks) {
            const bf16x8 a = tr_frag(pa + jh * 32768 + ks * 4096);
#pragma unroll
            for (int dt = 0; dt < 4; ++dt) { const bf16x8 b = tr_frag(pb + jh * 16384 + dt * 512 + ks * 4096); acc[dt] = __builtin_amdgcn_mfma_f32_32x32x16_bf16(a, b, acc[dt], 0, 0, 0); }
        }
    bf16* outp = wsp<bf16>(F, WS_KVT) + (size_t)item * (RDV * HD);
#pragma unroll
    for (int dt = 0; dt < 4; ++dt)
#pragma unroll
        for (int r = 0; r < 16; ++r) { const float v = acc[dt][r], vn = __shfl_xor(v, 1);
            if ((r32 & 1) == 0) *(unsigned*)(outp + (size_t)(32 * w + crow(r, hi)) * HD + 32 * dt + r32) = pk2(v, vn); }
    __syncthreads();
}
__device__ __forceinline__ void p2_phase(Frame& F) {
    KvRegs R; int item = F.vcu;
    if (item < NB * NH * NCHUNK) p2_kv_load(F, item, R);
    if (F.wave == 0 && F.vcu < NB * NH) p2_cumsum(wsp<float>(F, WS_CUM) + (size_t)F.vcu * SKV, F.lane);
#ifdef P2_QKNORM
    p2_qknorm(F, F.vcu * 8 + F.wave, F.G * 8);
#endif
    for (; item < NB * NH * NCHUNK; item += F.G) p2_kv_item(F, item, item + F.G, R);
}
__device__ __forceinline__ void p3_scan(Frame& F) {
    const int gt = F.vcu * 512 + F.tid, NT = F.G * 512;
    const bf16* KVT = wsp<bf16>(F, WS_KVT); bf16* ST = wsp<bf16>(F, WS_ST);
    for (int g = gt; g < NB * NH * 4096; g += NT) {
        const int bh = g >> 12, off = (g & 4095) * 8, h = bh & (NH - 1);
        const float cd = fast_exp2(LG2GAM[h] * 128.f);
        const bf16* src = KVT + (size_t)bh * NCHUNK * 32768 + off;
        const int e_ = off >> 7, d0_ = off & 127;
        bf16* dst = ST + (size_t)bh * NCHUNK * 32768 + ((((e_ >> 7) * 4 + ((e_ >> 5) & 3)) * 8 + (d0_ >> 4)) * 64 + ((d0_ >> 3) & 1) * 32 + (e_ & 31)) * 8;
        float s[8] = {0.f, 0.f, 0.f, 0.f, 0.f, 0.f, 0.f, 0.f};
        for (int n0 = 0; n0 < NCHUNK; n0 += 8) {
            f32x4 a[8], b[8]; v4u raw[8];
#pragma unroll
            for (int u = 0; u < 8; ++u) raw[u] = *(const GAS v4u*)(src + (size_t)(n0 + u) * 32768);
#pragma unroll
            for (int u = 0; u < 8; ++u) { a[u] = (f32x4){bflo(raw[u].x), bfhi(raw[u].x), bflo(raw[u].y), bfhi(raw[u].y)}; b[u] = (f32x4){bflo(raw[u].z), bfhi(raw[u].z), bflo(raw[u].w), bfhi(raw[u].w)}; }
#pragma unroll
            for (int u = 0; u < 8; ++u) {
#pragma unroll
                for (int k = 0; k < 4; ++k) { s[k] = s[k] * cd + a[u][k]; s[4 + k] = s[4 + k] * cd + b[u][k]; }
                v4u o; o.x = pk2(s[0], s[1]); o.y = pk2(s[2], s[3]); o.z = pk2(s[4], s[5]); o.w = pk2(s[6], s[7]);
                *(GAS v4u*)(dst + (size_t)(n0 + u) * 32768) = o; }
        }
    }
}

namespace fox {
constexpr int D = 128, NW = 8, QBLK = 32, KVBLK = 64, QB = NW * QBLK;
constexpr int SHM_V = KVBLK * D * 2, SHM_K = KVBLK * D * 2;
constexpr int LDS_ATT = 2 * SHM_V + 2 * SHM_K + NW * 64 * 4;
constexpr float THR = 8.f;
constexpr int OSTRIDE = NH * HD;
#define KSWZ(row, colB) ((row) * 256 + ((colB) ^ (((row) & 7) << 4)))
constexpr int v_rd_off(int d0, int ks, int half) { return d0 * 512 + ks * 4096 + half * 2048; }
__device__ __forceinline__ bf16x8 load8(const bf16* p) { return *reinterpret_cast<const bf16x8*>(p); }
__device__ __forceinline__ void mask_tile(f32x16& p0, f32x16& p1, int dq) {
    const float NEG = -__builtin_inff();
#pragma unroll
    for (int r = 0; r < 16; ++r) {
        const int c = (r & 3) + 8 * (r >> 2);
        if (dq - c < 0) p0[r] = NEG;
        if (dq - c - 32 < 0) p1[r] = NEG;
    }
}
__device__ __forceinline__ void partialSM(f32x16& p0, f32x16& p1, float& m_reg, float& mn, float& alpha) {
    float pmax = p0[0];
#pragma unroll
    for (int r = 1; r < 16; ++r) pmax = fmaxf(pmax, p0[r]);
#pragma unroll
    for (int r = 0; r < 16; ++r) pmax = fmaxf(pmax, p1[r]);
    { auto rr = __builtin_amdgcn_permlane32_swap(__float_as_uint(pmax), __float_as_uint(pmax), false, false);
      pmax = fmaxf(__uint_as_float(rr[0]), __uint_as_float(rr[1])); }
    constexpr float C2 = 1.4426950408889634f;
    if (__builtin_expect(__all((pmax - m_reg) <= THR), 1)) { mn = m_reg; alpha = 1.f; }
    else { mn = fmaxf(m_reg, pmax); alpha = __builtin_amdgcn_exp2f((m_reg - mn) * C2); m_reg = mn; }
    const float mnL = -mn * C2;
#pragma unroll
    for (int r = 0; r < 16; ++r) p0[r] = fmaf(p0[r], C2, mnL);
#pragma unroll
    for (int r = 0; r < 16; ++r) p1[r] = fmaf(p1[r], C2, mnL);
#pragma unroll
    for (int r = 0; r < 16; ++r) p0[r] = __builtin_amdgcn_exp2f(p0[r]);
}
__device__ __forceinline__ void finishSM(f32x16& p0, f32x16& p1, float alpha, float& l_reg, bf16x8& pa0, bf16x8& pa1, bf16x8& pa2, bf16x8& pa3) {
#pragma unroll
    for (int r = 0; r < 16; ++r) p1[r] = __builtin_amdgcn_exp2f(p1[r]);
    float ps = 0;
#pragma unroll
    for (int r = 0; r < 16; ++r) ps += p0[r];
#pragma unroll
    for (int r = 0; r < 16; ++r) ps += p1[r];
    { auto rr = __builtin_amdgcn_permlane32_swap(__float_as_uint(ps), __float_as_uint(ps), false, false);
      ps = __uint_as_float(rr[0]) + __uint_as_float(rr[1]); }
    l_reg = l_reg * alpha + ps;
#define PK4(P, B_, OUT) do { unsigned a0 = cvtpk(P[B_+0], P[B_+1]), a1 = cvtpk(P[B_+2], P[B_+3]);                          \
        unsigned b0 = cvtpk(P[B_+4], P[B_+5]), b1 = cvtpk(P[B_+6], P[B_+7]);                                             \
        auto r0 = __builtin_amdgcn_permlane32_swap(a0, b0, false, false); auto r1 = __builtin_amdgcn_permlane32_swap(a1, b1, false, false); \
        v4u w = {r0[0], r1[0], r0[1], r1[1]}; OUT = *reinterpret_cast<bf16x8*>(&w); } while (0)
    PK4(p0, 0, pa0); PK4(p0, 8, pa1); PK4(p1, 0, pa2); PK4(p1, 8, pa3);
}
__device__ __forceinline__ void load_bias(f32x16& p0, f32x16& p1, __amdgpu_buffer_rsrc_t rs, int kb, int hi) {
    const int vo = hi * 16, so = kb * 4;
#pragma unroll
    for (int g = 0; g < 4; ++g) { const v4u x = __builtin_amdgcn_raw_buffer_load_b128(rs, vo, so + 32 * g, 0), y = __builtin_amdgcn_raw_buffer_load_b128(rs, vo, so + 32 * g + 128, 0);
        p0[4 * g] = __uint_as_float(x[0]); p0[4 * g + 1] = __uint_as_float(x[1]); p0[4 * g + 2] = __uint_as_float(x[2]); p0[4 * g + 3] = __uint_as_float(x[3]);
        p1[4 * g] = __uint_as_float(y[0]); p1[4 * g + 1] = __uint_as_float(y[1]); p1[4 * g + 2] = __uint_as_float(y[2]); p1[4 * g + 3] = __uint_as_float(y[3]); }
}
template <int KB>
__device__ __forceinline__ void qkt(f32x16& p0, f32x16& p1, const char* K_lds, int r32, int hi, const bf16x8* qr) {
    const char* kb[4];
#pragma unroll
    for (int dd = 0; dd < 4; ++dd) kb[dd] = K_lds + KB * SHM_K + KSWZ(r32, (dd * 16 + hi * 8) * 2);
#pragma unroll
    for (int d0 = 0; d0 < 8; ++d0) { const char* a = kb[d0 & 3] + (d0 >> 2) * 128;
        bf16x8 b0 = *reinterpret_cast<const bf16x8*>(a);
        bf16x8 b1 = *reinterpret_cast<const bf16x8*>(a + 32 * 256);
        p0 = __builtin_amdgcn_mfma_f32_32x32x16_bf16(b0, qr[d0], p0, 0, 0, 0);
        p1 = __builtin_amdgcn_mfma_f32_32x32x16_bf16(b1, qr[d0], p1, 0, 0, 0); }
}
template <int VB>
__device__ __forceinline__ void pv_tile(f32x16* o, int vb0, bf16x8 pa0, bf16x8 pa1, bf16x8 pa2, bf16x8 pa3) {
#define TRRD(dst, off) asm volatile("ds_read_b64_tr_b16 %0, %1 offset:%2" : "=&v"(dst) : "v"(vb0), "i"(off) : "memory")
#define PV_D0(d0) do { s16x4 l0, l1, l2, l3, h0, h1, h2, h3; constexpr int b_ = VB * SHM_V + v_rd_off(d0, 0, 0); \
        TRRD(l0, b_); TRRD(h0, b_ + 2048); TRRD(l1, b_ + 4096); TRRD(h1, b_ + 6144); TRRD(l2, b_ + 8192); TRRD(h2, b_ + 10240); TRRD(l3, b_ + 12288); TRRD(h3, b_ + 14336); \
        asm volatile("s_waitcnt lgkmcnt(0)" ::: "memory"); SBAR();   \
        o[d0] = __builtin_amdgcn_mfma_f32_32x32x16_bf16(pa0, (bf16x8){l0[0], l0[1], l0[2], l0[3], h0[0], h0[1], h0[2], h0[3]}, o[d0], 0, 0, 0);   \
        o[d0] = __builtin_amdgcn_mfma_f32_32x32x16_bf16(pa1, (bf16x8){l1[0], l1[1], l1[2], l1[3], h1[0], h1[1], h1[2], h1[3]}, o[d0], 0, 0, 0);   \
        o[d0] = __builtin_amdgcn_mfma_f32_32x32x16_bf16(pa2, (bf16x8){l2[0], l2[1], l2[2], l2[3], h2[0], h2[1], h2[2], h2[3]}, o[d0], 0, 0, 0);   \
        o[d0] = __builtin_amdgcn_mfma_f32_32x32x16_bf16(pa3, (bf16x8){l3[0], l3[1], l3[2], l3[3], h3[0], h3[1], h3[2], h3[3]}, o[d0], 0, 0, 0); } while (0)
    PV_D0(0); PV_D0(1); PV_D0(2); PV_D0(3);
#undef PV_D0
#undef TRRD
}
struct BlockRef { const bf16* Q; const bf16* K; const bf16* V; bf16* O; const float* Bz; int P0; };
struct Seam { bf16x8 qr[8]; bf16x8 st_v0, st_v1, st_k0, st_k1; };
#define VMW() asm volatile("s_waitcnt vmcnt(0)" ::: "memory")
#define VMWN(n) asm volatile("s_waitcnt vmcnt(%0)" :: "i"(n) : "memory")
#define BL16(rs, so) __builtin_bit_cast(bf16x8, __builtin_amdgcn_raw_buffer_load_b128(rs, lkvB, (so), 0))
#define SLOAD_H(rK, rV, k0) do { S.st_v0 = BL16(rV, (k0) * (D * 2)); S.st_v1 = BL16(rV, ((k0) + 32) * (D * 2));              \
                         S.st_k0 = BL16(rK, (k0) * (D * 2)); S.st_k1 = BL16(rK, ((k0) + 32) * (D * 2)); } while (0)
#define SWRITE_HK(bf) do { *(bf16x8*)(K_lds + (bf) * SHM_K + kws) = S.st_k0; *(bf16x8*)(K_lds + (bf) * SHM_K + kws + 32 * 256) = S.st_k1; } while (0)
#define SWRITE_HV(bf) do { *(bf16x8*)(V_lds + (bf) * SHM_V + vst0) = S.st_v0; *(bf16x8*)(V_lds + (bf) * SHM_V + vst1) = S.st_v1; } while (0)
#define SWRITE_H(bf) do { SWRITE_HV(bf); SWRITE_HK(bf); } while (0)
__device__ __forceinline__ void attn_prime(const BlockRef& cur, char* lds, Seam& S) {
    const int tid = threadIdx.x, wid = __builtin_amdgcn_readfirstlane(tid >> 6), lane = tid & 63, r32 = lane & 31, hi = lane >> 5;
    const int sr = tid >> 4, sc = (tid & 15) * 8, kws = KSWZ(sr, sc * 2); char* K_lds = lds + 2 * SHM_V; const int lkvB = (sr * D + sc) * 2;
    const __amdgpu_buffer_rsrc_t rsK = __builtin_amdgcn_make_buffer_rsrc((void*)cur.K, 0, SKV * D * 2, 0x00020000), rsV = __builtin_amdgcn_make_buffer_rsrc((void*)cur.V, 0, SKV * D * 2, 0x00020000);
    { const bf16* qp = (cur.Q + (size_t)(wid * QBLK) * D) + (unsigned)(r32 * D + hi * 8);
#pragma unroll
      for (int d0 = 0; d0 < 8; ++d0) S.qr[d0] = load8(qp + d0 * 16); }
    SLOAD_H(rsK, rsV, 0); VMW(); SWRITE_HK(0);
    __syncthreads();
}
__device__ __forceinline__ void attn_block(const BlockRef& cur, int skv, char* lds, Seam& S) {
    const int tid = threadIdx.x, wid = __builtin_amdgcn_readfirstlane(tid >> 6), lane = tid & 63, r32 = lane & 31, hi = lane >> 5;
    int j_hi = (cur.P0 + QB - 1) / KVBLK + 1; if (j_hi > skv / KVBLK) j_hi = skv / KVBLK;
    const int NT = j_hi;
    const int qlo = cur.P0 + wid * QBLK, qm = qlo + r32 - 4 * hi;
    char* V_lds = lds; char* K_lds = lds + 2 * SHM_V;
    float* ws = (float*)(lds + 2 * SHM_V + 2 * SHM_K) + wid * 64; float* li_l = ws, * al_l = ws + 32;
    float m_reg = -1e30f, l_reg = 0; f32x16 o[4] = {};
    const int sr = tid >> 4, sc = (tid & 15) * 8, vst0 = v_st(sr, sc), vst1 = v_st(32 + sr, sc), kws = KSWZ(sr, sc * 2); const int lkvB = (sr * D + sc) * 2;
    const int vb0 = (int)(uintptr_t)V_lds + v_rd_base(lane);
    const __amdgpu_buffer_rsrc_t Kh = __builtin_amdgcn_make_buffer_rsrc((void*)cur.K, 0, SKV * D * 2, 0x00020000), Vh = __builtin_amdgcn_make_buffer_rsrc((void*)cur.V, 0, SKV * D * 2, 0x00020000);
    const __amdgpu_buffer_rsrc_t Bz = __builtin_amdgcn_make_buffer_rsrc((void*)cur.Bz, 0, SKV * 4, 0x00020000);
#define RESC(a) do { if (__any((a) < 1.f)) { if (hi == 0) al_l[r32] = (a); asm volatile("s_waitcnt lgkmcnt(0)" ::: "memory");              \
                     for (int d_ = 0; d_ < 4; ++d_) for (int r = 0; r < 16; ++r) o[d_][r] *= al_l[crow(r, hi)]; } } while (0)
#define KBASE(t) ((t) * KVBLK)
#define MASKT(P0_, P1_, t) do { const int kb_ = KBASE(t); if (kb_ + KVBLK - 1 > qlo) mask_tile(P0_, P1_, qm - kb_); } while (0)
    f32x16 pA0, pA1, pB0, pB1; float mnA, mnB, alA, alB; bf16x8 pa0, pa1, pa2, pa3;
    SWRITE_HV(0); SBAR();
    load_bias(pA0, pA1, Bz, KBASE(0), hi);
    if (NT > 1) { load_bias(pB0, pB1, Bz, KBASE(1), hi); SLOAD_H(Kh, Vh, KBASE(1)); }
    SBAR(); qkt<0>(pA0, pA1, K_lds, r32, hi, S.qr);
    MASKT(pA0, pA1, 0); partialSM(pA0, pA1, m_reg, mnA, alA);
    if (NT > 1) { VMW(); SWRITE_H(1); }
    __syncthreads();
#define HALF_STEP(PX0, PX1, mnX, alX, PY0, PY1, alY, t, KB, VB, SB) do {                                                      \
        SBAR(); qkt<KB>(PX0, PX1, K_lds, r32, hi, S.qr);                                                                      \
        finishSM(PY0, PY1, alY, l_reg, pa0, pa1, pa2, pa3); SBAR();                                                           \
        if ((t) + 1 < NT) { load_bias(PY0, PY1, Bz, KBASE((t) + 1), hi); SLOAD_H(Kh, Vh, KBASE((t) + 1)); SBAR(); }            \
        pv_tile<VB>(o, vb0, pa0, pa1, pa2, pa3); MASKT(PX0, PX1, (t)); partialSM(PX0, PX1, m_reg, mnX, alX);                  \
        __syncthreads();                                                                                                      \
        if ((t) + 1 < NT) { VMW(); SWRITE_H(SB); }                                                                            \
        RESC(alX); __syncthreads(); } while (0)
    for (int t = 1; t + 1 < NT; t += 2) {
        HALF_STEP(pB0, pB1, mnB, alB, pA0, pA1, alA, t, 1, 0, 0);
        HALF_STEP(pA0, pA1, mnA, alA, pB0, pB1, alB, t + 1, 0, 1, 1);
    }
    const bool even = (NT & 1) == 0;
    if (even) { SBAR(); qkt<1>(pB0, pB1, K_lds, r32, hi, S.qr); SBAR(); }
    finishSM(pA0, pA1, alA, l_reg, pa0, pa1, pa2, pa3); SBAR();
    pv_tile<0>(o, vb0, pa0, pa1, pa2, pa3);
    if (even) { MASKT(pB0, pB1, NT - 1); partialSM(pB0, pB1, m_reg, mnB, alB); __syncthreads(); RESC(alB);
        finishSM(pB0, pB1, alB, l_reg, pa0, pa1, pa2, pa3); SBAR(); pv_tile<1>(o, vb0, pa0, pa1, pa2, pa3); }
    SBAR();
    if (hi == 0) li_l[r32] = l_reg; asm volatile("s_waitcnt lgkmcnt(0)" ::: "memory");
    float rli[16];
#pragma unroll
    for (int r = 0; r < 16; ++r) rli[r] = __builtin_amdgcn_rcpf(li_l[crow(r, hi)]);
    unsigned char* const Ow = (unsigned char*)(cur.O + (size_t)(wid * QBLK) * OSTRIDE); const unsigned lo_ = (unsigned)((4 * hi * OSTRIDE + r32) * 2);
#pragma unroll
    for (int r = 0; r < 16; ++r) { const int orow = crow(r, hi);
#pragma unroll
        for (int d0 = 0; d0 < 4; ++d0) { const float v = o[d0][r] * rli[r];
            const float vn = __shfl_xor(v, 1);
            if ((r32 & 1) == 0) *(unsigned*)((Ow + (size_t)((((r & 3) + 8 * (r >> 2)) * OSTRIDE + d0 * 32) * 2)) + lo_) = cvtpk(v, vn); } }
    __syncthreads();
#undef RESC
#undef KBASE
#undef MASKT
#undef HALF_STEP
}
#undef BL16
#undef VMW
#undef VMWN
#undef SLOAD_H
#undef SWRITE_HK
#undef SWRITE_HV
#undef SWRITE_H
#undef PK4
#undef KSWZ
}

__device__ __forceinline__ fox::BlockRef attn_ref(const Frame& F, int L, int pass) {
    const int bh = L >> 4, x = L & 15, qb = pass ? 31 - x : x, b = bh >> 4, h = bh & 15;
    fox::BlockRef r;
    r.Q = wsp<bf16>(F, WS_QA) + ((size_t)bh * SEQ + (size_t)qb * 256) * HD;
    r.K = wsp<bf16>(F, WS_KA) + (size_t)bh * SKV * HD; r.V = wsp<bf16>(F, WS_VA) + (size_t)bh * SKV * HD;
    r.O = wsp<bf16>(F, WS_YA) + ((size_t)b * SEQ + (size_t)qb * 256) * (NH * HD) + h * HD;
    r.Bz = wsp<float>(F, WS_CUM) + (size_t)bh * SKV; r.P0 = 64 + qb * 256;
    return r;
}
__device__ __forceinline__ void p3_attention(Frame& F, char* ldsg) {
    constexpr int TOTAL = NB * NH * 16;
    char* lds = ldsg + RING_OFF;
    for (int L = F.vcu; L < TOTAL; L += F.G)
#pragma unroll 1
        for (int pass = 0; pass < 2; ++pass) {
            const fox::BlockRef cur = attn_ref(F, L, pass);
            fox::Seam S;
            fox::attn_prime(cur, lds, S);
            fox::attn_block(cur, SKV, lds, S);
        }
}
template <int B_> __device__ __forceinline__ bf16x8 pk4(const f32x16& P) {
    unsigned a0 = cvtpk(P[B_ + 0], P[B_ + 1]), a1 = cvtpk(P[B_ + 2], P[B_ + 3]), b0 = cvtpk(P[B_ + 4], P[B_ + 5]), b1 = cvtpk(P[B_ + 6], P[B_ + 7]);
    auto r0 = __builtin_amdgcn_permlane32_swap(a0, b0, false, false); auto r1 = __builtin_amdgcn_permlane32_swap(a1, b1, false, false);
    v4u w = {r0[0], r1[0], r0[1], r1[1]}; return *reinterpret_cast<bf16x8*>(&w);
}
#define RKSWZ(row, colB) ((row) * 256 + ((colB) ^ (((row) & 7) << 4)))
struct RetRegs { v4u vw[2][4], kw[4]; };
__device__ __forceinline__ void p4_ret_load(Frame& F, int item, RetRegs& R) {
    const int bh = item >> 6, c = (item & 63) + 1;
    const bf16* Kg = wsp<bf16>(F, WS_KR) + ((size_t)bh * LR + 128 * c) * HD;
    const bf16* Vg = wsp<bf16>(F, WS_VR) + ((size_t)bh * LR + 128 * c) * RDV;
    int tid_ = F.tid; asm volatile("" : "+v"(tid_));
    const int sr = tid_ >> 4, sc = (tid_ & 15) * 8;
#pragma unroll
    for (int q = 0; q < 4; ++q) { const int j = sr + 32 * q; R.vw[0][q] = *(const GAS v4u*)(Vg + (size_t)j * RDV + sc); R.vw[1][q] = *(const GAS v4u*)(Vg + (size_t)j * RDV + 128 + sc); R.kw[q] = *(const GAS v4u*)(Kg + (size_t)j * HD + sc); }
}
__device__ __forceinline__ void p4_ret_item(Frame& F, int item, int next, RetRegs& R) {
    const int bh = item >> 6, c = (item & 63) + 1, b = bh >> 4, h = bh & (NH - 1);
    const float lg2 = LG2GAM[h];
    const bf16* Qg = wsp<bf16>(F, WS_QR) + ((size_t)bh * LR + 128 * c) * HD;
    const bf16* STg = wsp<bf16>(F, WS_ST) + ((size_t)bh * NCHUNK + (c - 1)) * 32768;
    LAS unsigned char* ldsV = F.lds; LAS unsigned char* ldsK = F.lds + 65536; LAS f32x2* stats = (LAS f32x2*)(F.lds + 98304);
    const int sr = F.tid >> 4, sc = (F.tid & 15) * 8;
    const int w = F.wave, ib = w & 3, eh = w >> 2, r32 = F.lane & 31, hi = F.lane >> 5;
    bf16x8 qr[8], sa[4][4];
#pragma unroll
    for (int ks = 0; ks < 8; ++ks) qr[ks] = *(const GAS bf16x8*)(Qg + (size_t)(32 * ib + r32) * HD + 16 * ks + 8 * hi);
    const bf16* STl = STg + (size_t)eh * 16384 + F.lane * 8;
#pragma unroll
    for (int ks = 0; ks < 4; ++ks)
#pragma unroll
        for (int et = 0; et < 4; ++et) sa[ks][et] = *(const GAS bf16x8*)(STl + (et * 8 + ks) * 512);
#pragma unroll
    for (int q = 0; q < 4; ++q) { const int j = sr + 32 * q, so = v_st(j & 63, sc);
        *(LAS v4u*)(ldsV + ((j >> 6) * 2 + 0) * 16384 + so) = R.vw[0][q]; *(LAS v4u*)(ldsV + ((j >> 6) * 2 + 1) * 16384 + so) = R.vw[1][q];
        *(LAS v4u*)(ldsK + (j >> 6) * 16384 + RKSWZ(j & 63, sc * 2)) = R.kw[q]; }
    __syncthreads();
    if (next < NB * NH * NCHUNK) p4_ret_load(F, next, R);
    f32x16 acc[4] = {};
#pragma unroll
    for (int ks = 0; ks < 4; ++ks)
#pragma unroll
        for (int et = 0; et < 4; ++et) acc[et] = __builtin_amdgcn_mfma_f32_32x32x16_bf16(sa[ks][et], qr[ks], acc[et], 0, 0, 0);
#pragma unroll
    for (int ks = 0; ks < 4; ++ks)
#pragma unroll
        for (int et = 0; et < 4; ++et) sa[ks][et] = *(const GAS bf16x8*)(STl + (et * 8 + ks + 4) * 512);
#pragma unroll
    for (int ks = 0; ks < 4; ++ks)
#pragma unroll
        for (int et = 0; et < 4; ++et) acc[et] = __builtin_amdgcn_mfma_f32_32x32x16_bf16(sa[ks][et], qr[ks + 4], acc[et], 0, 0, 0);
    { const float xi = fast_exp2(lg2 * (float)(32 * ib + r32 + 1));
#pragma unroll
      for (int et = 0; et < 4; ++et)
#pragma unroll
          for (int r = 0; r < 16; ++r) acc[et][r] *= xi; }
    const LAS unsigned char* pv = ldsV + v_rd_base(F.lane) + eh * 16384;
    for (int jt = 0; jt <= ib; ++jt) {
        f32x16 p = {};
        const LAS unsigned char* kp = ldsK + (jt >> 1) * 16384;
        const int krow = (jt & 1) * 32 + r32;
#pragma unroll
        for (int ks = 0; ks < 8; ++ks) { const bf16x8 a = *(const LAS bf16x8*)(kp + RKSWZ(krow, (16 * ks + 8 * hi) * 2));
            p = __builtin_amdgcn_mfma_f32_32x32x16_bf16(a, qr[ks], p, 0, 0, 0); }
        const int ibase = 32 * ib + r32 - 32 * jt - 4 * hi;
#pragma unroll
        for (int r = 0; r < 16; ++r) { const int dl = ibase - ((r & 3) + 8 * (r >> 2)); p[r] = dl >= 0 ? p[r] * fast_exp2(lg2 * (float)dl) : 0.f; }
        const bf16x8 pa0 = pk4<0>(p), pa1 = pk4<8>(p);
        const LAS unsigned char* pvj = pv + (jt >> 1) * 32768 + (jt & 1) * 8192;
#pragma unroll
        for (int et = 0; et < 4; ++et) { const bf16x8 a0 = tr_frag(pvj + et * 512), a1 = tr_frag(pvj + et * 512 + 4096);
            acc[et] = __builtin_amdgcn_mfma_f32_32x32x16_bf16(a0, pa0, acc[et], 0, 0, 0);
            acc[et] = __builtin_amdgcn_mfma_f32_32x32x16_bf16(a1, pa1, acc[et], 0, 0, 0); }
    }
    const size_t tok = (size_t)b * SEQ + 128 * (c - 1) + 32 * ib + r32;
    const bf16* GRp = wsp<bf16>(F, WS_GR) + tok * DM + h * RDV + 128 * eh + 4 * hi;
    v2u gt[4][4];
#pragma unroll
    for (int et = 0; et < 4; ++et)
#pragma unroll
        for (int g4 = 0; g4 < 4; ++g4) gt[et][g4] = *(const GAS v2u*)(GRp + 32 * et + 8 * g4);
    float s1 = 0.f, s2 = 0.f;
#pragma unroll
    for (int et = 0; et < 4; ++et)
#pragma unroll
        for (int r = 0; r < 16; ++r) { s1 += acc[et][r]; s2 += acc[et][r] * acc[et][r]; }
    s1 += __shfl_xor(s1, 32); s2 += __shfl_xor(s2, 32);
    if (hi == 0) stats[eh * 128 + 32 * ib + r32] = (f32x2){s1, s2};
    __syncthreads();
    const f32x2 sa_ = stats[32 * ib + r32], sb_ = stats[128 + 32 * ib + r32];
    const float mean = (sa_.x + sb_.x) * (1.f / RDV), var = fmaxf((sa_.y + sb_.y) * (1.f / RDV) - mean * mean, 0.f), rstd = 1.f / sqrtf(var + EPS);
    bf16* YRp = wsp<bf16>(F, WS_YR) + tok * DM + h * RDV + 128 * eh + 4 * hi;
    const float* gp = F.g_ret + h * RDV + 128 * eh + 4 * hi;
#pragma unroll
    for (int et = 0; et < 4; ++et)
#pragma unroll
        for (int g4 = 0; g4 < 4; ++g4) { const int eo = 32 * et + 8 * g4;
            const f32x4 gn = *(const GAS f32x4*)(gp + eo); const v2u g2 = gt[et][g4];
            const float o0 = (acc[et][4 * g4 + 0] - mean) * rstd * gn[0] * bflo(g2.x), o1 = (acc[et][4 * g4 + 1] - mean) * rstd * gn[1] * bfhi(g2.x);
            const float o2 = (acc[et][4 * g4 + 2] - mean) * rstd * gn[2] * bflo(g2.y), o3 = (acc[et][4 * g4 + 3] - mean) * rstd * gn[3] * bfhi(g2.y);
            v2u ov; ov.x = pk2(o0, o1); ov.y = pk2(o2, o3); *(GAS v2u*)(YRp + eo) = ov; }
    __syncthreads();
}
__device__ __forceinline__ void p4_phase(Frame& F) {
    RetRegs R; int item = F.vcu;
    if (item < NB * NH * NCHUNK) p4_ret_load(F, item, R);
    for (; item < NB * NH * NCHUNK; item += F.G) p4_ret_item(F, item, item + F.G, R);
}
__device__ __forceinline__ int f2key(float x) { const int i = __float_as_int(x); return i ^ ((i >> 31) & 0x7fffffff); }
__device__ __forceinline__ float key2f(int k) { return __int_as_float(k ^ ((k >> 31) & 0x7fffffff)); }
__device__ __forceinline__ int imax(int a, int b) { return a > b ? a : b; }
__device__ __forceinline__ int imin(int a, int b) { return a < b ? a : b; }
__device__ __forceinline__ void ins16(int (&a)[16], int x) {
#pragma unroll
    for (int i = 0; i < 16; ++i) { const int t = imax(a[i], x); x = imin(a[i], x); a[i] = t; }
}
__device__ __forceinline__ void merge_partner16(int (&a)[16]) {
    int c[16];
#pragma unroll
    for (int i = 0; i < 16; ++i) c[i] = __shfl_xor(a[15 - i], 32);
#pragma unroll
    for (int i = 0; i < 16; ++i) c[i] = imax(a[i], c[i]);
#pragma unroll
    for (int st = 8; st >= 1; st >>= 1)
#pragma unroll
        for (int i = 0; i < 16; ++i) if (!(i & st)) { const int hi_ = imax(c[i], c[i + st]), lo_ = imin(c[i], c[i + st]); c[i] = hi_; c[i + st] = lo_; }
#pragma unroll
    for (int i = 0; i < 16; ++i) a[i] = c[i];
}
struct CandTab { int a[50], b[50]; };
constexpr CandTab make_cands() { CandTab t{}; int n = 0; for (int a = 0; a < 16; ++a) for (int b = 0; b < 16; ++b) if ((a + 1) * (b + 1) <= 16) { t.a[n] = a; t.b[n] = b; ++n; } return t; }
constexpr CandTab CANDS = make_cands();

__device__ __forceinline__ void p9_unit(Frame& F, int unit) {
    const int tt = unit >> 3, h = unit & 7;
    int lane_ = F.lane; asm volatile("" : "+v"(lane_));
    const int w = F.wave, r32 = lane_ & 31, hi = lane_ >> 5;
    const int t = tt * 256 + 32 * w + r32;
    const bf16* QPp = wsp<bf16>(F, WS_QP) + (size_t)t * PQ + h * 256 + 8 * hi;
    const bf16* KB = wsp<bf16>(F, WS_KEYS);
    LAS int* mylds = (LAS int*)(F.lds + RING_OFF) + (size_t)F.tid * 32;
#pragma unroll 1
    for (int half = 0; half < 2; ++half) {
        bf16x8 qf[8];
#pragma unroll
        for (int ks = 0; ks < 8; ++ks) qf[ks] = *(const GAS bf16x8*)(QPp + half * 128 + 16 * ks);
        int top[16];
#pragma unroll
        for (int i = 0; i < 16; ++i) top[i] = (int)0x80000000;
        const bf16* Kh = KB + ((size_t)half * PH + h) * PK * 128 + (size_t)r32 * 128 + 8 * hi;
#pragma unroll 1
        for (int nt = 0; nt < 4; ++nt) {
            f32x16 p = {};
#pragma unroll
            for (int ks = 0; ks < 8; ++ks) { const bf16x8 a = *(const GAS bf16x8*)(Kh + (size_t)nt * 32 * 128 + 16 * ks); p = __builtin_amdgcn_mfma_f32_32x32x16_bf16(a, qf[ks], p, 0, 0, 0); }
            const int nb = 32 * nt + 4 * hi;
#pragma unroll
            for (int r = 0; r < 16; ++r) { const int n = nb + (r & 3) + 8 * (r >> 2); ins16(top, (f2key(p[r]) & ~127) | n); }
        }
        merge_partner16(top);
#pragma unroll
        for (int i = 0; i < 4; ++i) *(LAS v4u*)(mylds + half * 16 + 4 * i) = (v4u){(unsigned)top[4 * i], (unsigned)top[4 * i + 1], (unsigned)top[4 * i + 2], (unsigned)top[4 * i + 3]};
    }
    float f1[16], f2[16];
#pragma unroll
    for (int i = 0; i < 4; ++i) { const v4u a = *(LAS v4u*)(mylds + 4 * i), b = *(LAS v4u*)(mylds + 16 + 4 * i);
#pragma unroll
        for (int k = 0; k < 4; ++k) { f1[4 * i + k] = key2f((int)a[k] & ~127); f2[4 * i + k] = key2f((int)b[k] & ~127); } }
    int fin[16];
#pragma unroll
    for (int i = 0; i < 16; ++i) fin[i] = (int)0x80000000;
#pragma unroll
    for (int s = 0; s < 25; ++s) {
        const float ve = f1[CANDS.a[2 * s]] + f2[CANDS.b[2 * s]], vo = f1[CANDS.a[2 * s + 1]] + f2[CANDS.b[2 * s + 1]];
        const int ie = (CANDS.a[2 * s] << 4) | CANDS.b[2 * s], io = (CANDS.a[2 * s + 1] << 4) | CANDS.b[2 * s + 1];
        const float v = hi ? vo : ve; const int id = hi ? io : ie;
        ins16(fin, (f2key(v) & ~255) | id);
    }
    merge_partner16(fin);
    float sv[16], e[16]; float den = 0.f;
#pragma unroll
    for (int i = 0; i < 16; ++i) sv[i] = key2f(fin[i] & ~255);
#pragma unroll
    for (int i = 0; i < 16; ++i) { e[i] = fast_exp2((sv[i] - sv[0]) * 1.4426950408889634f); den += e[i]; }
    const float rden = 1.f / den;
    int eid[8]; float gw[8];
#pragma unroll
    for (int k = 0; k < 8; ++k) { const int key = hi ? fin[8 + k] : fin[k]; const int a = (key >> 4) & 15, b = key & 15;
        const int n1 = mylds[a] & 127, n2 = mylds[16 + b] & 127; eid[k] = n1 * PK + n2; gw[k] = (hi ? e[8 + k] : e[k]) * rden; }
    int* EIDp = wsp<int>(F, WS_EID) + (size_t)t * 128 + h * 16 + 8 * hi; float* GWp = wsp<float>(F, WS_GW) + (size_t)t * 128 + h * 16 + 8 * hi;
    *(GAS v4u*)EIDp = (v4u){(unsigned)eid[0], (unsigned)eid[1], (unsigned)eid[2], (unsigned)eid[3]}; *(GAS v4u*)(EIDp + 4) = (v4u){(unsigned)eid[4], (unsigned)eid[5], (unsigned)eid[6], (unsigned)eid[7]};
    *(GAS f32x4*)GWp = (f32x4){gw[0], gw[1], gw[2], gw[3]}; *(GAS f32x4*)(GWp + 4) = (f32x4){gw[4], gw[5], gw[6], gw[7]};
}
__device__ __forceinline__ void p9_phase(Frame& F) {
    for (int unit = F.vcu; unit < (MTOK / 256) * PH; unit += F.G) p9_unit(F, unit);
}
#ifndef P10_SORT
#define P10_SORT 1
#endif
#ifndef P10_AUX
#define P10_AUX 0
#endif
typedef __amdgpu_buffer_rsrc_t rsrc_t;
typedef unsigned v6u __attribute__((ext_vector_type(6)));
typedef float f32x32 __attribute__((ext_vector_type(32)));
#ifndef FPB
#define FPB 4
#endif
constexpr int ROWB = DM * FPB / 8, ROWCH = ROWB / 1024;
constexpr float FPMAX = FPB == 6 ? 7.5f : 6.0f;
__device__ __forceinline__ rsrc_t mk_rsrc(const void* p, unsigned bytes) { return __builtin_amdgcn_make_buffer_rsrc((void*)p, 0, bytes, 0x00020000); }
__device__ __forceinline__ void load_row8(v4u (&r)[ROWCH], rsrc_t rs, int lane16, int e) {
    const int so = e * ROWB;
#pragma unroll
    for (int j = 0; j < ROWCH; ++j) r[j] = __builtin_amdgcn_raw_buffer_load_b128(rs, lane16, so + j * 1024, P10_AUX);
}
#define D2(d, i) ((f32x2){d[2 * (i)], d[2 * (i) + 1]})
#if FPB == 6
#define DEC6A(r) __builtin_amdgcn_cvt_scalef32_pk32_f32_fp6((v6u){r[0][0], r[0][1], r[0][2], r[0][3], r[1][0], r[1][1]}, 1.0f)
#define DEC6B(r) __builtin_amdgcn_cvt_scalef32_pk32_f32_fp6((v6u){r[1][2], r[1][3], r[2][0], r[2][1], r[2][2], r[2][3]}, 1.0f)
__device__ __forceinline__ float dot_row8(const v4u (&r)[ROWCH], const f32x2 (&x)[32]) {
    f32x2 a0 = {0.f, 0.f}, a1 = {0.f, 0.f};
    { const f32x32 d = DEC6A(r);
#pragma unroll
      for (int i = 0; i < 16; i += 2) { a0 = __builtin_elementwise_fma(D2(d, i), x[i], a0); a1 = __builtin_elementwise_fma(D2(d, i + 1), x[i + 1], a1); asm volatile("" : "+v"(a0), "+v"(a1)); } }
    { const f32x32 d = DEC6B(r);
#pragma unroll
      for (int i = 0; i < 16; i += 2) { a0 = __builtin_elementwise_fma(D2(d, i), x[16 + i], a0); a1 = __builtin_elementwise_fma(D2(d, i + 1), x[16 + i + 1], a1); asm volatile("" : "+v"(a0), "+v"(a1)); } }
    return (a0.x + a0.y) + (a1.x + a1.y);
}
__device__ __forceinline__ void axpy_row8(f32x2 (&acc)[32], const v4u (&r)[ROWCH], float w) {
    const f32x2 ww = {w, w};
    { const f32x32 d = DEC6A(r);
#pragma unroll
      for (int i = 0; i < 16; ++i) { acc[i] = __builtin_elementwise_fma(ww, D2(d, i), acc[i]); asm volatile("" : "+v"(acc[i])); } }
    { const f32x32 d = DEC6B(r);
#pragma unroll
      for (int i = 0; i < 16; ++i) { acc[16 + i] = __builtin_elementwise_fma(ww, D2(d, i), acc[16 + i]); asm volatile("" : "+v"(acc[16 + i])); } }
}
#else
#define DEC4(w, b) __builtin_amdgcn_cvt_scalef32_pk_f32_fp4((w), 1.0f, (b))
__device__ __forceinline__ float dot_row8(const v4u (&r)[ROWCH], const f32x2 (&x)[32]) {
    f32x2 a0 = {0.f, 0.f}, a1 = {0.f, 0.f};
#pragma unroll
    for (int j = 0; j < 2; ++j)
#pragma unroll
        for (int d = 0; d < 4; ++d) { const unsigned w = r[j][d];
            a0 = __builtin_elementwise_fma(DEC4(w, 0), x[16 * j + 4 * d], a0); a1 = __builtin_elementwise_fma(DEC4(w, 1), x[16 * j + 4 * d + 1], a1);
            a0 = __builtin_elementwise_fma(DEC4(w, 2), x[16 * j + 4 * d + 2], a0); a1 = __builtin_elementwise_fma(DEC4(w, 3), x[16 * j + 4 * d + 3], a1);
            asm volatile("" : "+v"(a0), "+v"(a1)); }
    return (a0.x + a0.y) + (a1.x + a1.y);
}
__device__ __forceinline__ void axpy_row8(f32x2 (&acc)[32], const v4u (&r)[ROWCH], float w_) {
    const f32x2 ww = {w_, w_};
#pragma unroll
    for (int j = 0; j < 2; ++j)
#pragma unroll
        for (int d = 0; d < 4; ++d) { const unsigned w = r[j][d]; const int i = 16 * j + 4 * d;
            acc[i] = __builtin_elementwise_fma(ww, DEC4(w, 0), acc[i]); acc[i + 1] = __builtin_elementwise_fma(ww, DEC4(w, 1), acc[i + 1]);
            acc[i + 2] = __builtin_elementwise_fma(ww, DEC4(w, 2), acc[i + 2]); acc[i + 3] = __builtin_elementwise_fma(ww, DEC4(w, 3), acc[i + 3]);
            asm volatile("" : "+v"(acc[i]), "+v"(acc[i + 1]), "+v"(acc[i + 2]), "+v"(acc[i + 3])); }
}
#endif
__device__ __forceinline__ int imin_(int a, int b) { return a < b ? a : b; }
__device__ __forceinline__ float gelu1(float v) {
    const float av = __builtin_fabsf(v), t = fast_rcp(av * 0.2316418882f + 1.0f);
    float q = t * 0.5307027145f + (-0.7265760135f); q = q * t + 0.7107068705f; q = q * t + (-0.142248368f); q = q * t + 0.127414796f; q = q * t;
    const float e = fast_exp2((v * v) * (-0.72134752044f)), m = v * (q * e);
    return v < 0.f ? m : v - m;
}
__device__ __forceinline__ float red8(float p0, float p1, float p2, float p3, float p4, float p5, float p6, float p7, int lane) {
    const bool b0 = lane & 1, b1 = lane & 2, b2 = lane & 4;
    const float q0 = (b0 ? p1 : p0) + __shfl_xor(b0 ? p0 : p1, 1), q1 = (b0 ? p3 : p2) + __shfl_xor(b0 ? p2 : p3, 1);
    const float q2 = (b0 ? p5 : p4) + __shfl_xor(b0 ? p4 : p5, 1), q3 = (b0 ? p7 : p6) + __shfl_xor(b0 ? p6 : p7, 1);
    const float r0 = (b1 ? q1 : q0) + __shfl_xor(b1 ? q0 : q1, 2), r1 = (b1 ? q3 : q2) + __shfl_xor(b1 ? q2 : q3, 2);
    float s = (b2 ? r1 : r0) + __shfl_xor(b2 ? r0 : r1, 4);
    s += __shfl_xor(s, 8); s += __shfl_xor(s, 16); s += __shfl_xor(s, 32);
    return s;
}
#define RLI(v, k) __builtin_amdgcn_readlane((v), (k))
__device__ __forceinline__ float rlf(float v, int k) { return __int_as_float(__builtin_amdgcn_readlane(__float_as_int(v), k)); }
#if FPB == 6
__device__ __forceinline__ float u_half(const f32x2 (&x)[32], rsrc_t rs, int lane16, int ev, int lane) {
    float a = 0.f;
    v4u R0[ROWCH], R1[ROWCH], R2[ROWCH], R3[ROWCH], R4[ROWCH], R5[ROWCH], R6[ROWCH], R7[ROWCH];
    load_row8(R0, rs, lane16, RLI(ev, 0)); load_row8(R1, rs, lane16, RLI(ev, 1)); load_row8(R2, rs, lane16, RLI(ev, 2)); load_row8(R3, rs, lane16, RLI(ev, 3)); load_row8(R4, rs, lane16, RLI(ev, 4)); load_row8(R5, rs, lane16, RLI(ev, 5)); load_row8(R6, rs, lane16, RLI(ev, 6));
#pragma unroll 1
    for (int k = 0; k < 64; k += 8) {
        load_row8(R7, rs, lane16, RLI(ev, k + 7)); SBAR(); const float d0 = dot_row8(R0, x); SBAR();
        load_row8(R0, rs, lane16, RLI(ev, imin_(k + 8, 63))); SBAR(); const float d1 = dot_row8(R1, x); SBAR();
        load_row8(R1, rs, lane16, RLI(ev, imin_(k + 9, 63))); SBAR(); const float d2 = dot_row8(R2, x); SBAR();
        load_row8(R2, rs, lane16, RLI(ev, imin_(k + 10, 63))); SBAR(); const float d3 = dot_row8(R3, x); SBAR();
        load_row8(R3, rs, lane16, RLI(ev, imin_(k + 11, 63))); SBAR(); const float d4 = dot_row8(R4, x); SBAR();
        load_row8(R4, rs, lane16, RLI(ev, imin_(k + 12, 63))); SBAR(); const float d5 = dot_row8(R5, x); SBAR();
        load_row8(R5, rs, lane16, RLI(ev, imin_(k + 13, 63))); SBAR(); const float d6 = dot_row8(R6, x); SBAR();
        load_row8(R6, rs, lane16, RLI(ev, imin_(k + 14, 63))); SBAR(); const float d7 = dot_row8(R7, x); SBAR();
        const float sred = red8(d0, d1, d2, d3, d4, d5, d6, d7, lane);
        a = ((lane >> 3) == (k >> 3)) ? sred : a; SBAR();
    }
    return a;
}
__device__ __forceinline__ void v_half(f32x2 (&acc)[32], rsrc_t rs, int lane16, int ev, float wv) {
    v4u R0[ROWCH], R1[ROWCH], R2[ROWCH], R3[ROWCH], R4[ROWCH], R5[ROWCH], R6[ROWCH], R7[ROWCH];
    load_row8(R0, rs, lane16, RLI(ev, 0)); load_row8(R1, rs, lane16, RLI(ev, 1)); load_row8(R2, rs, lane16, RLI(ev, 2)); load_row8(R3, rs, lane16, RLI(ev, 3)); load_row8(R4, rs, lane16, RLI(ev, 4)); load_row8(R5, rs, lane16, RLI(ev, 5)); load_row8(R6, rs, lane16, RLI(ev, 6));
#pragma unroll 1
    for (int k = 0; k < 64; k += 8) {
        load_row8(R7, rs, lane16, RLI(ev, k + 7)); SBAR(); axpy_row8(acc, R0, rlf(wv, k + 0)); SBAR();
        load_row8(R0, rs, lane16, RLI(ev, imin_(k + 8, 63))); SBAR(); axpy_row8(acc, R1, rlf(wv, k + 1)); SBAR();
        load_row8(R1, rs, lane16, RLI(ev, imin_(k + 9, 63))); SBAR(); axpy_row8(acc, R2, rlf(wv, k + 2)); SBAR();
        load_row8(R2, rs, lane16, RLI(ev, imin_(k + 10, 63))); SBAR(); axpy_row8(acc, R3, rlf(wv, k + 3)); SBAR();
        load_row8(R3, rs, lane16, RLI(ev, imin_(k + 11, 63))); SBAR(); axpy_row8(acc, R4, rlf(wv, k + 4)); SBAR();
        load_row8(R4, rs, lane16, RLI(ev, imin_(k + 12, 63))); SBAR(); axpy_row8(acc, R5, rlf(wv, k + 5)); SBAR();
        load_row8(R5, rs, lane16, RLI(ev, imin_(k + 13, 63))); SBAR(); axpy_row8(acc, R6, rlf(wv, k + 6)); SBAR();
        load_row8(R6, rs, lane16, RLI(ev, imin_(k + 14, 63))); SBAR(); axpy_row8(acc, R7, rlf(wv, k + 7)); SBAR();
    }
}
#else
#define ROWS16(X) X(0) X(1) X(2) X(3) X(4) X(5) X(6) X(7) X(8) X(9) X(10) X(11) X(12) X(13) X(14) X(15)
__device__ __forceinline__ float u_half(const f32x2 (&x)[32], rsrc_t rs, int lane16, int ev, int lane) {
    float a = 0.f;
    v4u R[16][ROWCH];
#pragma unroll
    for (int i = 0; i < 15; ++i) load_row8(R[i], rs, lane16, RLI(ev, i));
#pragma unroll 1
    for (int k = 0; k < 64; k += 16) {
        float d[16];
#pragma unroll
        for (int i = 0; i < 16; ++i) { load_row8(R[(i + 15) & 15], rs, lane16, RLI(ev, imin_(k + i + 15, 63))); SBAR(); d[i] = dot_row8(R[i], x); SBAR(); }
        const float s0 = red8(d[0], d[1], d[2], d[3], d[4], d[5], d[6], d[7], lane), s1 = red8(d[8], d[9], d[10], d[11], d[12], d[13], d[14], d[15], lane);
        a = ((lane >> 3) == (k >> 3)) ? s0 : a; a = ((lane >> 3) == (k >> 3) + 1) ? s1 : a; SBAR();
    }
    return a;
}
__device__ __forceinline__ void v_half(f32x2 (&acc)[32], rsrc_t rs, int lane16, int ev, float wv) {
    v4u R[16][ROWCH];
#pragma unroll
    for (int i = 0; i < 15; ++i) load_row8(R[i], rs, lane16, RLI(ev, i));
#pragma unroll 1
    for (int k = 0; k < 64; k += 16) {
#pragma unroll
        for (int i = 0; i < 16; ++i) { load_row8(R[(i + 15) & 15], rs, lane16, RLI(ev, imin_(k + i + 15, 63))); SBAR(); axpy_row8(acc, R[i], rlf(wv, k + i)); SBAR(); }
    }
}
#endif
#ifndef P10_MFMA
#define P10_MFMA 0
#endif
#if P10_MFMA
typedef int v8i __attribute__((ext_vector_type(8)));
constexpr int P10_WREG = 8704, P10_ZERO_OFF = 8 * P10_WREG;
__device__ __forceinline__ void u_mfma(LAS unsigned char* wl, LAS unsigned char* zl, rsrc_t rs, int e0, int e1, int lane) {
    const int r = lane & 15, kq = lane >> 4;
    const LAS unsigned char* bp = (r < 2 ? wl + r * 4096 : zl) + kq * 16;
    LAS float* dots = (LAS float*)(wl + 8192);
    int voff[8];
#pragma unroll
    for (int g = 0; g < 8; ++g) voff[g] = __shfl(g < 4 ? e0 : e1, ((g & 3) << 4) + r) * ROWB + kq * 32;
    v4u R[2][8][2], B[2][2][2];
#pragma unroll
    for (int q = 0; q < 2; ++q)
#pragma unroll
        for (int g = 0; g < 8; ++g) { R[q][g][0] = __builtin_amdgcn_raw_buffer_load_b128(rs, voff[g], 128 * q, P10_AUX); R[q][g][1] = __builtin_amdgcn_raw_buffer_load_b128(rs, voff[g] + 16, 128 * q, P10_AUX); }
#pragma unroll
    for (int q = 0; q < 2; ++q)
#pragma unroll
        for (int h = 0; h < 2; ++h) { B[q][h][0] = *(const LAS v4u*)(bp + 256 * q + 128 * h); B[q][h][1] = *(const LAS v4u*)(bp + 256 * q + 128 * h + 64); }
    f32x4 c[8];
#pragma unroll
    for (int g = 0; g < 8; ++g) c[g] = (f32x4){0.f, 0.f, 0.f, 0.f};
#define MF(ra, bb, cc) { const v8i a8_ = {(int)ra[0], (int)ra[1], (int)ra[2], (int)ra[3], 0, 0, 0, 0}, b8_ = {(int)bb[0][0], (int)bb[0][1], (int)bb[0][2], (int)bb[0][3], (int)bb[1][0], (int)bb[1][1], (int)bb[1][2], (int)bb[1][3]}; \
                         cc = __builtin_amdgcn_mfma_scale_f32_16x16x128_f8f6f4(a8_, b8_, cc, 4, 0, 0, 0, 0, 0); }
#pragma unroll 1
    for (int pp = 0; pp < 16; pp += 2) {
#pragma unroll
        for (int q = 0; q < 2; ++q) {
            const int pn = pp + q + 2 < 16 ? pp + q + 2 : 15, so = 128 * pn;
            SBAR();
#pragma unroll
            for (int g = 0; g < 8; ++g) { MF(R[q][g][0], B[q][0], c[g]); SBAR(); R[q][g][0] = __builtin_amdgcn_raw_buffer_load_b128(rs, voff[g], so, P10_AUX); SBAR(); }
#pragma unroll
            for (int g = 0; g < 8; ++g) { MF(R[q][g][1], B[q][1], c[g]); SBAR(); R[q][g][1] = __builtin_amdgcn_raw_buffer_load_b128(rs, voff[g] + 16, so, P10_AUX); SBAR(); }
            { const LAS unsigned char* bq = bp + 256 * pn;
#pragma unroll
              for (int h = 0; h < 2; ++h) { B[q][h][0] = *(const LAS v4u*)(bq + 128 * h); B[q][h][1] = *(const LAS v4u*)(bq + 128 * h + 64); } }
            SBAR();
        }
    }
#undef MF
#pragma unroll
    for (int g = 0; g < 8; ++g) { f32x4 cg = c[g];
#pragma unroll
        for (int i = 0; i < 4; ++i) cg[i] += __shfl_xor(cg[i], 1);
        if (r == 0) *(LAS f32x4*)(dots + 16 * g + 4 * kq) = cg; }
}
#endif
#ifndef P10_SYNC
#define P10_SYNC 1
#endif
__device__ __forceinline__ void xcd_sweep_sync(unsigned* cnt, unsigned x, unsigned nloc, unsigned k) {
    __syncthreads();
    if (threadIdx.x == 0) {
        unsigned* w = cnt + 64 * x;
        (void)xb_add(w, 1u);
        const unsigned want = (k + 1u) * nloc; unsigned sp = 0u;
        while (xb_ld(w) < want) { __builtin_amdgcn_s_sleep(1); if (++sp > 4096u) break; }
    }
    __syncthreads();
}
struct SweepSync { unsigned* cnt; unsigned x, nloc, k; };
__device__ __forceinline__ void p10_token(Frame& F, int t, rsrc_t rsU, rsrc_t rsV, SweepSync& Y) {
    int lane_ = F.lane; asm volatile("" : "+v"(lane_));
    const int lane = lane_, lane16 = lane * 16;
    const int* EIDp = wsp<int>(F, WS_EID) + (size_t)t * 128; const float* GWp = wsp<float>(F, WS_GW) + (size_t)t * 128;
#if P10_SORT
    const int e0_ = EIDp[lane], e1_ = EIDp[64 + lane]; const float g0_ = GWp[lane], g1_ = GWp[64 + lane];
#else
    const int e0 = EIDp[lane], e1 = EIDp[64 + lane]; const float g0 = GWp[lane], g1 = GWp[64 + lane];
#endif
#if P10_SORT
    int e0 = e0_, e1 = e1_; float g0 = g0_, g1 = g1_;
#pragma unroll
    for (int size = 2; size <= 128; size <<= 1)
#pragma unroll
        for (int j = size >> 1; j > 0; j >>= 1) {
            if (j == 64) { const bool sw = e0 > e1; const int te = sw ? e1 : e0, tE = sw ? e0 : e1; const float tg = sw ? g1 : g0, tG = sw ? g0 : g1; e0 = te; e1 = tE; g0 = tg; g1 = tG; }
            else {
                { const int pe = __shfl_xor(e0, j); const float pg = __shfl_xor(g0, j); const bool up = (lane & size) == 0, lower = (lane & j) == 0;
                  const bool take = (lower == up) ? (pe < e0) : (pe > e0); e0 = take ? pe : e0; g0 = take ? pg : g0; }
                { const int i1 = lane + 64; const int pe = __shfl_xor(e1, j); const float pg = __shfl_xor(g1, j); const bool up = (i1 & size) == 0, lower = (lane & j) == 0;
                  const bool take = (lower == up) ? (pe < e1) : (pe > e1); e1 = take ? pe : e1; g1 = take ? pg : g1; }
            }
        }
#endif
    const float* SCU = wsp<float>(F, WS_SCU); const float* SCV = wsp<float>(F, WS_SCV);
    const float su0 = SCU[e0], su1 = SCU[e1], sv0 = SCV[e0], sv1 = SCV[e1];
    float w0, w1;
#if P10_MFMA
    {   const float rrow = 1.f / sqrtf(wave_sum(wsp<float>(F, WS_SSP)[(size_t)t * 64 + lane]) * (1.f / DM) + EPS);
        LAS unsigned char* wl = F.lds + F.wave * P10_WREG; LAS unsigned char* zl = F.lds + P10_ZERO_OFF;
        { const GAS v2u* xp = (const GAS v2u*)(wsp<bf16>(F, WS_XN) + (size_t)t * DM) + lane;
#pragma unroll
          for (int j = 0; j < 16; ++j) { const v2u a = xp[64 * j]; const float x0 = bflo(a.x), x1 = bfhi(a.x), x2 = bflo(a.y), x3 = bfhi(a.y);
              int h = __builtin_amdgcn_cvt_pk_fp8_f32(x0, x1, 0, false); h = __builtin_amdgcn_cvt_pk_fp8_f32(x2, x3, h, true);
              const f32x2 d01 = __builtin_amdgcn_cvt_pk_f32_fp8(h, false), d23 = __builtin_amdgcn_cvt_pk_f32_fp8(h, true);
              int l = __builtin_amdgcn_cvt_pk_fp8_f32(x0 - d01.x, x1 - d01.y, 0, false); l = __builtin_amdgcn_cvt_pk_fp8_f32(x2 - d23.x, x3 - d23.y, l, true);
              *(LAS int*)(wl + 4 * (64 * j + lane)) = h; *(LAS int*)(wl + 4096 + 4 * (64 * j + lane)) = l; } }
        u_mfma(wl, zl, rsU, e0, e1, lane); SBAR();
        const LAS float* dots = (const LAS float*)(wl + 8192);
        const float a0 = dots[lane], a1 = dots[64 + lane];
        w0 = g0 * gelu1(a0 * (su0 * rrow)) * sv0; w1 = g1 * gelu1(a1 * (su1 * rrow)) * sv1;
    }
#else
    {   f32x2 x[32];
        const float rrow = 1.f / sqrtf(wave_sum(wsp<float>(F, WS_SSP)[(size_t)t * 64 + lane]) * (1.f / DM) + EPS);
        { const GAS v2u* xp = (const GAS v2u*)(wsp<bf16>(F, WS_XN) + (size_t)t * DM) + lane;
#pragma unroll
          for (int j = 0; j < 16; ++j) { const v2u a = xp[64 * j]; x[2 * j] = (f32x2){bflo(a.x), bfhi(a.x)}; x[2 * j + 1] = (f32x2){bflo(a.y), bfhi(a.y)}; } }
        if (P10_SYNC && Y.cnt) { xcd_sweep_sync(Y.cnt, Y.x, Y.nloc, Y.k); ++Y.k; }
        const float a0 = u_half(x, rsU, lane16, e0, lane); SBAR();
#if P10_SYNC >= 2
        if (Y.cnt) { xcd_sweep_sync(Y.cnt, Y.x, Y.nloc, Y.k); ++Y.k; }
#endif
        const float a1 = u_half(x, rsU, lane16, e1, lane); SBAR();
        w0 = g0 * gelu1(a0 * (su0 * rrow)) * sv0; w1 = g1 * gelu1(a1 * (su1 * rrow)) * sv1;
    }
#endif
    SBAR();
    f32x2 acc[32];
#pragma unroll
    for (int i = 0; i < 32; ++i) acc[i] = (f32x2){0.f, 0.f};
    if (P10_SYNC && Y.cnt) { xcd_sweep_sync(Y.cnt, Y.x, Y.nloc, Y.k); ++Y.k; }
    v_half(acc, rsV, lane16, e0, w0); SBAR();
#if P10_SYNC >= 2
    if (Y.cnt) { xcd_sweep_sync(Y.cnt, Y.x, Y.nloc, Y.k); ++Y.k; }
#endif
    v_half(acc, rsV, lane16, e1, w1); SBAR();
    GAS f32x4* op = (GAS f32x4*)(F.out + (size_t)t * DM) + lane;
#pragma unroll
    for (int j = 0; j < 16; ++j) { f32x4 h = op[64 * j]; h[0] += acc[2 * j].x; h[1] += acc[2 * j].y; h[2] += acc[2 * j + 1].x; h[3] += acc[2 * j + 1].y; op[64 * j] = h; }
}
__device__ __forceinline__ void p10_range(Frame& F, int t0, int t1, int gw, int NGW, SweepSync Y) {
    const rsrc_t rsU = mk_rsrc(wsp<unsigned char>(F, WS_U8), (unsigned)MTOK * ROWB), rsV = mk_rsrc(wsp<unsigned char>(F, WS_V8), (unsigned)MTOK * ROWB);
#if P10_MFMA
    { int tid_ = F.tid; asm volatile("" : "+v"(tid_)); unsigned z_; asm volatile("v_mov_b32 %0, 0" : "=v"(z_)); ((LAS v2u*)(F.lds + P10_ZERO_OFF))[tid_] = (v2u){z_, z_}; }
    __syncthreads();
#endif
    for (int t = t0 + gw; t < t1; t += NGW) p10_token(F, t, rsU, rsV, Y);
}
constexpr int NPHASE = 11;
#ifndef MK_SYNC
#define MK_SYNC 0
#endif
constexpr int CW_SYNC = 32768, SYNC_STRIDE = 32 * 8 * 64;
static_assert((CW_SYNC + 5 * SYNC_STRIDE) * 4 <= (int)CTL_ZERO_BYTES, "sync counters inside the per-call memset");
constexpr int N_LAUNCHES = MK_N_LAUNCHES;
#ifndef MK_CUT
#define MK_CUT 1
#endif
struct Args { const float* in[17]; float* out; unsigned char* ws; int ph_lo, ph_hi, li, pad; };
__device__ __forceinline__ void cvt_table(const float* src, bf16* dst, size_t n8, int gt, int NT) {
    for (size_t i = gt; i < n8; i += NT) { const f32x4 a = ((const GAS f32x4*)src)[2 * i], b = ((const GAS f32x4*)src)[2 * i + 1];
        v4u o; o.x = pk2(a[0], a[1]); o.y = pk2(a[2], a[3]); o.z = pk2(b[0], b[1]); o.w = pk2(b[2], b[3]); ((GAS v4u*)dst)[i] = o; }
}
#ifndef MK_PIPE
#define MK_PIPE 0
#endif
#ifndef P1_WGM
#define P1_WGM 4
#endif
#ifndef CHAIN_WGM
#define CHAIN_WGM 4
#endif
#ifndef PIPE_CH
#define PIPE_CH 8192
#endif
#ifndef BAR_REP
#define BAR_REP 1
#endif
__device__ __forceinline__ void xbar(const XcdBarrier& b) {
#pragma unroll 1
    for (int q = 0; q < BAR_REP; ++q) xcd_barrier(b);
}
__device__ __forceinline__ void chain_front(Frame& F, int chunk, int CH, int G_, int c_, const XcdBarrier& gb) {
    const size_t r0 = (size_t)chunk * CH;
    { pg8::Gemm g{wsp<bf16>(F, WS_YA) + r0 * 2048, wsp<bf16>(F, WS_WFOX), CH, DM, 2048}; pg8::SyncOrder S; S.init(CH, DM, G_, c_, CHAIN_WGM); S.cnt = nullptr; S.on = 0;
      pg8::EpiGate<0> E{wsp<bf16>(F, WS_MRG) + r0 * DM, wsp<bf16>(F, WS_GA) + r0 * DM, DM};
      pg8::gemm_phase<pg8::EpiGate<0>, pg8::SyncOrder, true, true>(F.lds + RING_OFF, g, S, E); }
    { pg8::Gemm g{wsp<bf16>(F, WS_YR) + r0 * DM, wsp<bf16>(F, WS_WRET), CH, DM, DM}; pg8::SyncOrder S; S.init(CH, DM, G_, c_, CHAIN_WGM); S.cnt = nullptr; S.on = 0;
      pg8::EpiGate<1> E{wsp<bf16>(F, WS_MRG) + r0 * DM, wsp<bf16>(F, WS_GT) + r0 * DM, DM};
      pg8::gemm_phase<pg8::EpiGate<1>, pg8::SyncOrder, true, true>(F.lds + RING_OFF, g, S, E); }
    xbar(gb);
    { pg8::Gemm g{wsp<bf16>(F, WS_MRG) + r0 * DM, wsp<bf16>(F, WS_WOUT), CH, DM, DM}; pg8::SyncOrder S; S.init(CH, DM, G_, c_, CHAIN_WGM); S.cnt = nullptr; S.on = 0;
      pg8::EpiResHG E{F.x + r0 * DM, F.out + r0 * DM, wsp<bf16>(F, WS_XN) + r0 * DM, F.g_ffn, wsp<float>(F, WS_SSP) + r0 * 64, DM};
      pg8::gemm_phase<pg8::EpiResHG, pg8::SyncOrder, true, true>(F.lds + RING_OFF, g, S, E); }
}
__device__ __forceinline__ void chain_query(Frame& F, int chunk, int CH, int G_, int c_) {
    const size_t r0 = (size_t)chunk * CH;
    { pg8::Gemm g{wsp<bf16>(F, WS_XN) + r0 * DM, wsp<bf16>(F, WS_WQ), CH, PQ, DM}; pg8::SyncOrder S; S.init(CH, PQ, G_, c_, CHAIN_WGM); S.cnt = nullptr; S.on = 0;
      LAS float* rs = (LAS float*)(F.lds + LDSX_OFF); pg8::Unit u;
      int tid_ = F.tid; asm volatile("" : "+v"(tid_));
      for (int i = 0; i < 8 && S.next(i, u); ++i)
          if (tid_ < 256) { const GAS f32x4* sp = (const GAS f32x4*)(wsp<float>(F, WS_SSP) + (r0 + (size_t)u.pm * 256 + tid_) * 64); float ss = 0.f;
#pragma unroll
              for (int k = 0; k < 16; ++k) { const f32x4 v = sp[k]; ss += (v[0] + v[1]) + (v[2] + v[3]); }
              rs[256 * i + tid_] = 1.f / sqrtf(ss * (1.f / DM) + EPS); }
      __syncthreads();
      pg8::EpiRowScale E{wsp<bf16>(F, WS_QP) + r0 * PQ, rs, PQ};
      pg8::gemm_phase<pg8::EpiRowScale, pg8::SyncOrder, true, true>(F.lds + RING_OFF, g, S, E);
      const int t0 = chunk * (CH / 256);
      for (int i = 0; S.next(i, u); ++i) p9_unit(F, ((t0 + u.pm) << 3) | u.pn); }
}
#ifndef DBG_DUMP
#define DBG_DUMP -1
#endif
__device__ __forceinline__ void dbg_dump(Frame& F, size_t o0, size_t n0, size_t o1, size_t n1, size_t o2, size_t n2, bool f32_2) {
    const size_t gt = (size_t)F.vcu * 512 + F.tid, NT = (size_t)F.G * 512;
    for (size_t i = gt; i < (size_t)MTOK * DM; i += NT) {
        float v = 0.f;
        if (n0) v += __uint_as_float((unsigned)wsp<bf16>(F, o0)[i % n0] << 16);
        if (n1) v += __uint_as_float((unsigned)wsp<bf16>(F, o1)[i % n1] << 16);
        if (n2) v += f32_2 ? wsp<float>(F, o2)[i % n2] : __uint_as_float((unsigned)wsp<bf16>(F, o2)[i % n2] << 16);
        F.out[i] = v;
    }
}
#ifndef FP6_SEQ
#define FP6_SEQ 0
#endif
__device__ __forceinline__ void cvt_row_fp8(const float* src, unsigned char* dst, float* scale_out, int lane, bool nat) {
    const GAS f32x4* p = (const GAS f32x4*)src + lane;
    f32x4 v[16]; float am = 0.f;
#pragma unroll
    for (int j = 0; j < 16; ++j) { v[j] = p[64 * j]; am = fmaxf(fmaxf(am, fmaxf(__builtin_fabsf(v[j].x), __builtin_fabsf(v[j].y))), fmaxf(__builtin_fabsf(v[j].z), __builtin_fabsf(v[j].w))); }
#pragma unroll
    for (int o = 1; o < 64; o <<= 1) am = fmaxf(am, __shfl_xor(am, o));
    const float s = am > 0.f ? FPMAX / am : 1.f;
#if FPB == 6
    unsigned w[12];
#pragma unroll
    for (int g = 0; g < 2; ++g) { f32x16 a, b;
#pragma unroll
        for (int q = 0; q < 16; ++q) {
#if FP6_SEQ
            const int ka = 32 * g + q, kb = 32 * g + 16 + q;
#else
            const int ka = 32 * g + 2 * q, kb = ka + 1;
#endif
            a[q] = v[ka >> 2][ka & 3] * s; b[q] = v[kb >> 2][kb & 3] * s; }
        const v6u r = __builtin_amdgcn_cvt_scalef32_2xpk16_fp6_f32(a, b, 1.0f);
#pragma unroll
        for (int q = 0; q < 6; ++q) w[6 * g + q] = r[q]; }
#else
    if (nat) {
#pragma unroll
        for (int j = 0; j < 16; ++j) { unsigned t = __builtin_amdgcn_cvt_scalef32_pk_fp4_f32(0u, v[j].x * s, v[j].y * s, 1.0f, 0); t = __builtin_amdgcn_cvt_scalef32_pk_fp4_f32(t, v[j].z * s, v[j].w * s, 1.0f, 1);
            const int c = 4 * (64 * j + lane), ks = c >> 7, kq = (c >> 5) & 3, e = c & 31;
            *(GAS unsigned short*)(dst + 128 * (ks >> 1) + 32 * kq + 16 * (ks & 1) + (e >> 1)) = (unsigned short)t; }
        if (lane == 0) *scale_out = am > 0.f ? am * (1.f / FPMAX) : 1.f;
        return;
    }
    unsigned w[8];
#pragma unroll
    for (int d = 0; d < 8; ++d) { unsigned t = 0u;
#define PK4B(b) { const int k = 8 * d + 2 * (b); t = __builtin_amdgcn_cvt_scalef32_pk_fp4_f32(t, v[k >> 2][k & 3] * s, v[(k + 1) >> 2][(k + 1) & 3] * s, 1.0f, (b)); }
        PK4B(0) PK4B(1) PK4B(2) PK4B(3)
#undef PK4B
        w[d] = t; }
#endif
    GAS v4u* d = (GAS v4u*)dst + lane;
#pragma unroll
    for (int c = 0; c < ROWCH; ++c) d[64 * c] = (v4u){w[4 * c], w[4 * c + 1], w[4 * c + 2], w[4 * c + 3]};
    if (lane == 0) *scale_out = am > 0.f ? am * (1.f / FPMAX) : 1.f;
}
__global__ void __launch_bounds__(512, 2) fwd(Args args) {
    extern __shared__ __attribute__((aligned(16))) unsigned char lds[];
    Frame F;
    F.lds = (LAS unsigned char*)lds;
    F.MISC = (volatile LAS unsigned*)(F.lds + MISC_OFF);
    F.tid = threadIdx.x; F.lane = F.tid & 63; F.wave = __builtin_amdgcn_readfirstlane(F.tid >> 6);
    F.G = gridDim.x; { const int bx = blockIdx.x; F.vcu = (F.G % 8 == 0) ? (bx % 8) * (F.G / 8) + bx / 8 : bx; }
    F.ws = args.ws; F.ctl = (gu32*)(args.ws + WS_CTL);
    F.x = args.in[0]; F.meta = args.in[1]; F.g_mix = args.in[2]; F.w_in = args.in[3]; F.b_forget = args.in[4]; F.g_q = args.in[5]; F.g_k = args.in[6]; F.g_ret = args.in[7];
    F.w_fox = args.in[8]; F.w_ret = args.in[9]; F.w_out = args.in[10]; F.g_ffn = args.in[11]; F.w_q = args.in[12]; F.keys1 = args.in[13]; F.keys2 = args.in[14]; F.pu = args.in[15]; F.pv = args.in[16];
    F.out = args.out;
    for (int u = F.tid; u < (LDS_BYTES - LDSCTL_OFF) / 4; u += 512) ((LAS unsigned*)(F.lds + LDSCTL_OFF))[u] = 0u;
    __syncthreads();
    XcdBarrier bar; bar.bar = (unsigned*)(F.ctl + CW_BAR); bar.x = 0; bar.st = nullptr; bar.G = gridDim.x;
    if (args.ph_hi - args.ph_lo > 1) bar = xcd_barrier_post((unsigned*)(F.ctl + CW_BAR), F.MISC + 8, gridDim.x);
    const int lo = args.ph_lo, hi = args.ph_hi;
#ifndef PH_MASK
#define PH_MASK 0x7ff
#endif
#define IN(k) ((((PH_MASK) >> (k)) & 1) && lo <= (k) && (k) < hi)
#define SEAM(k) do { if (IN(k) && IN((k) + 1)) xbar(bar); } while (0)

    if (IN(0)) { p0_prologue(F);
#ifdef TWICE_P0
        __syncthreads(); p0_prologue(F);
#endif
    } SEAM(0);

    if (IN(1)) {
        pg8::Gemm g{wsp<bf16>(F, WS_UX), wsp<bf16>(F, WS_WZ), MROWS, NZ, DM}; pg8::SyncOrder S; S.init(MROWS, NZ, F.G, (int)blockIdx.x, P1_WGM); S.cnt = (unsigned*)(F.ctl + CW_SYNC) + 0 * SYNC_STRIDE; S.on = MK_SYNC;
#if DBG_DUMP == 100
        pg8::EpiGate<2> E{wsp<bf16>(F, WS_QA), nullptr, NZ};
        pg8::gemm_phase<pg8::EpiGate<2>, pg8::SyncOrder, true, true>(F.lds + RING_OFF, g, S, E);
#else
        pg8::EpiZ E{F.ws, F.b_forget, F.g_q, F.g_k, (LAS float*)(F.lds + LDSX_OFF)};
        pg8::gemm_phase<pg8::EpiZ, pg8::SyncOrder, true, true>(F.lds + RING_OFF, g, S, E);
#ifdef TWICE_P1
        __syncthreads(); pg8::gemm_phase<pg8::EpiZ, pg8::SyncOrder, true, true>(F.lds + RING_OFF, g, S, E);
#endif
#ifdef NULL_P1
        __syncthreads(); { pg8::EpiNull EN{wsp<float>(F, WS_CTL) + 1000}; pg8::gemm_phase<pg8::EpiNull, pg8::SyncOrder, true, true>(F.lds + RING_OFF, g, S, EN); }
#endif
#endif
    } SEAM(1);

    if (DBG_DUMP == 0) { dbg_dump(F, WS_UX, (size_t)MROWS * DM, WS_WZ, (size_t)NZ * DM, WS_WFOX, (size_t)48 * MiB, false); return; }
    if (DBG_DUMP == 100) { const size_t gt = (size_t)F.vcu * 512 + F.tid, NT = (size_t)F.G * 512, TOT = (size_t)MROWS * NZ;
        for (size_t i = gt; i < (size_t)MTOK * DM; i += NT) { float v = 0.f;
            for (int j = 0; j < 7; ++j) { const size_t k = i + (size_t)j * MTOK * DM; if (k < TOT) v += __uint_as_float((unsigned)wsp<bf16>(F, WS_QA)[k] << 16); }
            F.out[i] = v; } return; }
    if (DBG_DUMP == 1) { dbg_dump(F, WS_GR, (size_t)3 * MTOK * DM, 0, 0, 0, 0, false); return; }
    if (IN(2)) { p2_phase(F); } SEAM(2);
    if (DBG_DUMP == 2) { dbg_dump(F, WS_QA, (size_t)NB * NH * SEQ * HD, WS_GR, (size_t)3 * MTOK * DM, WS_KVT, (size_t)NB * NH * NCHUNK * 32768, true); return; }

    if (IN(3)) {
#ifndef NO_SCAN
        p3_scan(F);
#endif
#ifndef NO_ATT
        p3_attention(F, (char*)lds);
#endif
#ifdef TWICE_P3
        __syncthreads(); p3_scan(F); p3_attention(F, (char*)lds);
#endif
    } SEAM(3);

    if (IN(4)) { p4_phase(F);
#ifdef TWICE_P4
        p4_phase(F);
#endif
    } SEAM(4);
    if (DBG_DUMP == 4) { dbg_dump(F, WS_YA, (size_t)MTOK * 2048, WS_YR, (size_t)MTOK * DM, WS_ST, (size_t)NB * NH * NCHUNK * 32768, false); return; }

#if !MK_PIPE
    if (IN(5)) {
        { const int gw = F.vcu * 8 + F.wave, NGW = F.G * 8;
          for (int r = gw; r < 2 * MTOK; r += NGW) { const bool isv = r >= MTOK; const int e = isv ? r - MTOK : r;
              cvt_row_fp8((isv ? F.pv : F.pu) + (size_t)e * DM, wsp<unsigned char>(F, isv ? WS_V8 : WS_U8) + (size_t)e * ROWB, wsp<float>(F, isv ? WS_SCV : WS_SCU) + e, F.lane, P10_MFMA && !isv); } }
        chain_front(F, 0, MTOK, F.G, (int)blockIdx.x, bar); xbar(bar); chain_query(F, 0, MTOK, F.G, (int)blockIdx.x);
    } SEAM(5);
    if (IN(10)) { SweepSync Y{(MTOK % (F.G * 8) == 0) ? (unsigned*)(F.ctl + CW_SYNC) : nullptr, bar.x, bar.st[0], 0u};
        p10_range(F, 0, MTOK, F.vcu * 8 + F.wave, F.G * 8, Y); }
#else
    if (IN(5)) {
        constexpr int CH = PIPE_CH, NCH = MTOK / CH;
#ifndef CVT_REP
#define CVT_REP 1
#endif
#pragma unroll 1
        for (int rep = 0; rep < CVT_REP; ++rep)
        { const int gw = F.vcu * 8 + F.wave, NGW = F.G * 8;
          for (int r = gw; r < 2 * MTOK; r += NGW) { const bool isv = r >= MTOK; const int e = isv ? r - MTOK : r;
              cvt_row_fp8((isv ? F.pv : F.pu) + (size_t)e * DM, wsp<unsigned char>(F, isv ? WS_V8 : WS_U8) + (size_t)e * ROWB, wsp<float>(F, isv ? WS_SCV : WS_SCU) + e, F.lane, P10_MFMA && !isv); } }
        const int roleB = F.vcu & 1, gi2 = F.vcu >> 1, Gh = F.G >> 1;
        const int cB = (gi2 % (Gh / 8)) * 8 + gi2 / (Gh / 8);
        XcdBarrier gbar; gbar.bar = (unsigned*)(F.ctl + CW_BAR) + XCD_BAR_WORDS * (roleB ? 1 : 2); gbar.x = 0; gbar.st = nullptr; gbar.G = (unsigned)Gh;
        gbar = xcd_barrier_post((unsigned*)(F.ctl + CW_BAR) + XCD_BAR_WORDS * (roleB ? 1 : 2), F.MISC + 12, (unsigned)Gh);
#pragma unroll 1
        for (int s = 0; s <= NCH; ++s) {
            if (s < NCH && (s == 0 || roleB)) {
                const bool allc = (s == 0);
                const XcdBarrier gb = allc ? bar : gbar;
                chain_front(F, s, CH, allc ? F.G : Gh, allc ? (int)blockIdx.x : cB, gb);
            }
            if (s >= 1 && (s == NCH || !roleB)) {
                const bool allc = (s == NCH);
                const XcdBarrier gb = allc ? bar : gbar;
                chain_query(F, s - 1, CH, allc ? F.G : Gh, allc ? (int)blockIdx.x : cB);
                xbar(gb);
                p10_range(F, (s - 1) * CH, s * CH, (allc ? F.vcu : gi2) * 8 + F.wave, (allc ? F.G : Gh) * 8, SweepSync{nullptr, 0u, 1u, 0u});
            }
            if (s < NCH) xbar(bar);
        }
    }
#endif
#undef IN
#undef SEAM
}

extern "C" void kernel_launch(void* const* d_in, const int* in_sizes, int n_in, void* d_out, int out_size, void* d_ws, size_t ws_size, hipStream_t stream) {
    static int grid = 0;
    if (grid == 0) {
        if (n_in != 17 || in_sizes[0] != MTOK * DM || out_size != MTOK * DM || ws_size < WS_END) {
            fprintf(stderr, "kernel_launch: unexpected shapes (n_in %d, in0 %d, out %d, ws %zu; need ws >= %zu); nothing launched\n", n_in, n_in > 0 ? in_sizes[0] : -1, out_size, ws_size, (size_t)WS_END); grid = -1; return; }
        int dev = 0, cus = 0, per_cu = 0;
        if (hipGetDevice(&dev) != hipSuccess || hipDeviceGetAttribute(&cus, hipDeviceAttributeMultiprocessorCount, dev) != hipSuccess) { grid = -1; return; }
        if (hipFuncSetAttribute((const void*)fwd, hipFuncAttributeMaxDynamicSharedMemorySize, LDS_BYTES) != hipSuccess) { fprintf(stderr, "kernel_launch: hipFuncSetAttribute failed\n"); grid = -1; return; }
        if (hipOccupancyMaxActiveBlocksPerMultiprocessor(&per_cu, (const void*)fwd, 512, LDS_BYTES) != hipSuccess || per_cu < 1) { fprintf(stderr, "kernel_launch: occupancy query says %d blocks per CU\n", per_cu); }
        (void)hipGetLastError();
        grid = cus;
    }
    if (grid < 0) return;
    (void)hipMemsetAsync((char*)d_ws + WS_CTL, 0, CTL_ZERO_BYTES, stream);
    Args a{};
    for (int i = 0; i < 17; ++i) a.in[i] = (const float*)d_in[i];
    a.out = (float*)d_out; a.ws = (unsigned char*)d_ws; a.pad = 0;
    if (N_LAUNCHES == 1) { a.ph_lo = 0; a.ph_hi = NPHASE; a.li = 0; hipLaunchKernelGGL(fwd, dim3(grid), dim3(512), LDS_BYTES, stream, a); }
    else if (N_LAUNCHES == 2) { a.ph_lo = 0; a.ph_hi = MK_CUT; a.li = 0; hipLaunchKernelGGL(fwd, dim3(grid), dim3(512), LDS_BYTES, stream, a);
        a.ph_lo = MK_CUT; a.ph_hi = NPHASE; a.li = 1; hipLaunchKernelGGL(fwd, dim3(grid), dim3(512), LDS_BYTES, stream, a); }
    else { for (int p = 0; p < NPHASE; ++p) { a.ph_lo = p; a.ph_hi = p + 1; a.li = p; hipLaunchKernelGGL(fwd, dim3(grid), dim3(512), LDS_BYTES, stream, a); } }
}
```

```cpp
#include <hip/hip_runtime.h>
#include <cstdio>
#include <cstdint>

#ifndef MK_N_LAUNCHES
#define MK_N_LAUNCHES 1
#endif
#ifndef DBG_CHECK
#define DBG_CHECK 0
#endif

constexpr int DM = 4096, NB = 2, SEQ = 8192, MTOK = NB * SEQ;
constexpr int NMETA = 16, MROWS = MTOK + 256;
constexpr int NH = 16, HD = 128, RDV = 256;
constexpr int SKV = 64 + SEQ;
constexpr int LR = 128 + SEQ;
constexpr int NZ = 26880;
constexpr int NCHUNK = 64;
constexpr int PH = 8, PK = 128, PTOP = 16, PQ = 2048;
constexpr float EPS = 1e-6f;
constexpr int Z_QA = 0, Z_KA = 2048, Z_VA = 4096, Z_QR = 6144, Z_KR = 8192, Z_VR = 10240, Z_GR = 14336, Z_GA = 18432, Z_GT = 22528, Z_F = 26624;

constexpr size_t MiB = 1u << 20;
constexpr size_t WS_CTL = 0, CTL_ZERO_BYTES = 1 * MiB;
constexpr size_t WS_WFOX = 2 * MiB;
constexpr size_t WS_WRET = WS_WFOX + 16 * MiB;
constexpr size_t WS_WOUT = WS_WRET + 32 * MiB;
constexpr size_t WS_WQ   = WS_WOUT + 32 * MiB;
constexpr size_t WS_KEYS = WS_WQ + 16 * MiB;
constexpr size_t WS_T1   = WS_KEYS + 1 * MiB;
constexpr size_t WS_WZ   = WS_T1;
constexpr size_t WS_UX   = WS_T1 + 210 * MiB;
constexpr size_t WS_KVT  = WS_T1;
constexpr size_t WS_MRG  = WS_T1;
constexpr size_t WS_XN   = WS_T1 + 128 * MiB;
constexpr size_t WS_QP   = WS_T1 + 256 * MiB;
constexpr size_t WS_SSP  = WS_T1 + 320 * MiB;
constexpr size_t WS_P1   = WS_T1 + 340 * MiB;
constexpr size_t WS_QA   = WS_P1;
constexpr size_t WS_KA   = WS_QA + 64 * MiB;
constexpr size_t WS_VA   = WS_KA + 65 * MiB;
constexpr size_t WS_QR   = WS_VA + 65 * MiB;
constexpr size_t WS_KR   = WS_QR + 65 * MiB;
constexpr size_t WS_VR   = WS_KR + 65 * MiB;
constexpr size_t WS_CUM  = WS_VR + 130 * MiB;
constexpr size_t WS_GR   = WS_CUM + 2 * MiB;
constexpr size_t WS_GA   = WS_GR + 128 * MiB;
constexpr size_t WS_GT   = WS_GA + 128 * MiB;
constexpr size_t WS_ST   = WS_GT + 128 * MiB;
constexpr size_t WS_YA   = WS_ST + 128 * MiB;
constexpr size_t WS_YR   = WS_YA + 64 * MiB;
constexpr size_t WS_END  = WS_YR + 128 * MiB;
constexpr size_t WS_U8   = WS_QA;
constexpr size_t WS_V8   = WS_QA + 64 * MiB;
constexpr size_t WS_SCU  = WS_QA + 128 * MiB;
constexpr size_t WS_SCV  = WS_QA + 129 * MiB;
constexpr size_t WS_EID  = WS_QA + 256 * MiB;
constexpr size_t WS_GW   = WS_QA + 264 * MiB;
static_assert(WS_GW + 8 * MiB <= WS_CUM, "overlay fits in the dead QA..VR region");
static_assert(WS_END <= 1745879040ull, "workspace map fits 4 x sizeof(w_in)");
static_assert(WS_QP + 64 * MiB <= WS_P1 && WS_UX + 130 * MiB <= WS_P1, "T1 map");

constexpr int CW_TMO = 0, CW_CODE = 1;
constexpr int CW_BAR = 4096;
constexpr int CW_DBG = 65536;

constexpr int RING_OFF = 0, RING_BYTES = 131072;
constexpr int LDSX_OFF = RING_BYTES;
constexpr int LDSCTL_OFF = RING_BYTES + 24576, MISC_OFF = LDSCTL_OFF + 320;
constexpr int LDS_BYTES = LDSCTL_OFF + 1024;
static_assert(LDS_BYTES <= 163840, "LDS");

#define GAS __attribute__((address_space(1)))
#define LAS __attribute__((address_space(3)))
typedef unsigned short bf16;
typedef unsigned v4u __attribute__((ext_vector_type(4)));
typedef unsigned v2u __attribute__((ext_vector_type(2)));
typedef float f32x4 __attribute__((ext_vector_type(4)));
typedef float f32x2 __attribute__((ext_vector_type(2)));
typedef float f32x16 __attribute__((ext_vector_type(16)));
typedef short bf16x8 __attribute__((ext_vector_type(8)));
typedef short s16x4 __attribute__((ext_vector_type(4)));
typedef __bf16 bf16x2_t __attribute__((ext_vector_type(2)));
typedef GAS unsigned gu32;
#define RLX_AGENT __ATOMIC_RELAXED, __HIP_MEMORY_SCOPE_AGENT
#define LDS_WAIT() asm volatile("s_waitcnt lgkmcnt(0)" ::: "memory")
#define VM_WAIT() asm volatile("s_waitcnt vmcnt(0)" ::: "memory")
#define SBAR() __builtin_amdgcn_sched_barrier(0)
__device__ __forceinline__ unsigned f2bf(float f) { unsigned u = __builtin_bit_cast(unsigned, f); return (u + 0x7fffu + ((u >> 16) & 1u)) >> 16; }
__device__ __forceinline__ unsigned pk2(float lo, float hi) { return f2bf(lo) | (f2bf(hi) << 16); }
__device__ __forceinline__ unsigned cvtpk(float lo, float hi) { unsigned r; asm volatile("v_cvt_pk_bf16_f32 %0, %1, %2" : "=v"(r) : "v"(lo), "v"(hi)); return r; }
__device__ __forceinline__ float bflo(unsigned w) { return __uint_as_float(w << 16); }
__device__ __forceinline__ float bfhi(unsigned w) { return __uint_as_float(w & 0xffff0000u); }
__device__ __forceinline__ float fast_exp2(float x) { return __builtin_amdgcn_exp2f(x); }
__device__ __forceinline__ float fast_rcp(float x) { return __builtin_amdgcn_rcpf(x); }
__device__ __forceinline__ float sigmoidf_(float x) { return fast_rcp(1.f + fast_exp2(-1.4426950408889634f * x)); }
__device__ __forceinline__ float wave_sum(float v) {
#pragma unroll
    for (int o = 1; o < 64; o <<= 1) v += __shfl_xor(v, o);
    return v;
}
#ifndef PG8_WGM
#define PG8_WGM 8
#endif
namespace pg8 {
#define PG8_LAS __attribute__((address_space(3)))
typedef unsigned short bf16_t;
typedef short bf16x8 __attribute__((ext_vector_type(8)));
typedef float f32x4 __attribute__((ext_vector_type(4)));
typedef unsigned u32x4 __attribute__((ext_vector_type(4)));
constexpr int BM = 256, BK = 64, HALF = 128, HTB = HALF * BK * 2  , STAGE_BYTES = 8 * HTB, NXCD = 8, WGM = PG8_WGM;

__host__ __device__ __forceinline__ int lds_byte(int r, int c) { const int st = (r >> 4) * 2 + (c >> 5), rr = r & 15, cc = c & 31, ob = rr * 64 + cc * 2; return st * 1024 + (ob ^ (((ob >> 9) & 1) << 5)); }
__host__ __device__ __forceinline__ void stage_rc(int b, int& R, int& C) { const int st = b / 1024, sb = b % 1024, swz = sb ^ (((sb >> 9) & 1) << 5); R = (st >> 1) * 16 + swz / 64; C = (st & 1) * 32 + (swz % 64) / 2; }
__host__ __device__ __forceinline__ int perm32(int rho) { const int n = rho >> 4, i = rho & 15; return 8 * (i >> 2) + 4 * n + (i & 3); }

struct Unit { int pm, pn, idx; };
struct Gemm { const bf16_t* A; const bf16_t* Bt; int M, N, K; };

struct StaticOrder {
    int nM, nN, nwg, G, c, wgm;
    __host__ __device__ void init(int M, int N, int G_, int c_, int wgm_ = WGM) { nM = M / BM; nN = N / BM; nwg = nM * nN; G = G_; c = c_; wgm = wgm_; }
    __host__ __device__ bool next(int i, Unit& u) const {
        const long L = (long)i * G + c; if (L >= nwg) return false;
        int wgid = (int)L; { const int q = nwg / NXCD, r = nwg % NXCD, xcd = wgid % NXCD, off = wgid / NXCD; wgid = (xcd < r ? xcd * (q + 1) : r * (q + 1) + (xcd - r) * q) + off; }
        const int nig = wgm * nN, gid = wgid / nig, fm = gid * wgm, gsz = (nM - fm) < wgm ? (nM - fm) : wgm;
        u.pm = fm + ((wgid % nig) % gsz); u.pn = (wgid % nig) / gsz; u.idx = i; return true;
    }
    __device__ __forceinline__ void a_ready(const Unit&) const {}
    __device__ __forceinline__ void done(const Unit&) const {}
};

__device__ __forceinline__ unsigned cvt_pk_bf16(float lo, float hi) { unsigned r; asm volatile("v_cvt_pk_bf16_f32 %0, %1, %2" : "=v"(r) : "v"(lo), "v"(hi)); return r; }
typedef float f32x2 __attribute__((ext_vector_type(2)));
}
__device__ const double ROT_REV[64] = {
    1.59154943091895346e-01, 1.37822502603982849e-01, 1.19349370211248862e-01, 1.03352296618434064e-01,
    8.94994016088910133e-02, 7.75032887553740585e-02, 6.71150830052272551e-02, 5.81192674418762462e-02,
    5.03292121044870353e-02, 4.35833021053073297e-02, 3.77415847174197711e-02, 3.26828658723569976e-02,
    2.83021958306233987e-02, 2.45086918620698521e-02, 2.12236527647776604e-02, 1.83789261056796667e-02,
    1.59154943091895339e-02, 1.37822502603982839e-02, 1.19349370211248862e-02, 1.03352296618434061e-02,
    8.94994016088910237e-03, 7.75032887553740550e-03, 6.71150830052272534e-03, 5.81192674418762410e-03,
    5.03292121044870370e-03, 4.35833021053073314e-03, 3.77415847174197719e-03, 3.26828658723569932e-03,
    2.83021958306233987e-03, 2.45086918620698521e-03, 2.12236527647776622e-03, 1.83789261056796667e-03,
    1.59154943091895356e-03, 1.37822502603982878e-03, 1.19349370211248849e-03, 1.03352296618434048e-03,
    8.94994016088910237e-04, 7.75032887553740507e-04, 6.71150830052272599e-04, 5.81192674418762388e-04,
    5.03292121044870326e-04, 4.35833021053073292e-04, 3.77415847174197741e-04, 3.26828658723569922e-04,
    2.83021958306233954e-04, 2.45086918620698543e-04, 2.12236527647776605e-04, 1.83789261056796662e-04,
    1.59154943091895351e-04, 1.37822502603982856e-04, 1.19349370211248862e-04, 1.03352296618434061e-04,
    8.94994016088910182e-05, 7.75032887553740561e-05, 6.71150830052272545e-05, 5.81192674418762388e-05,
    5.03292121044870354e-05, 4.35833021053073225e-05, 3.77415847174197768e-05, 3.26828658723569989e-05,
    2.83021958306233961e-05, 2.45086918620698523e-05, 2.12236527647776592e-05, 1.83789261056796682e-05,
};
namespace pg8 {
#if 1
typedef unsigned char* rsrc_t;
__device__ __forceinline__ rsrc_t mk_rsrc(const void* p, unsigned) { return (unsigned char*)p; }
#else
typedef __amdgpu_buffer_rsrc_t rsrc_t;
__device__ __forceinline__ rsrc_t mk_rsrc(const void* p, unsigned bytes) { return __builtin_amdgcn_make_buffer_rsrc((void*)p, 0, bytes, 0x00020000); }
#endif
__device__ __forceinline__ void st8b(rsrc_t rs, int voff, int soff, const f32x4& a, const f32x4& b) {
    u32x4 w; w.x = cvt_pk_bf16(a[0], a[1]); w.y = cvt_pk_bf16(a[2], a[3]); w.z = cvt_pk_bf16(b[0], b[1]); w.w = cvt_pk_bf16(b[2], b[3]);
#if 1
    *(u32x4*)((rs + (size_t)(unsigned)soff) + (unsigned)voff) = w;
#else
    __builtin_amdgcn_raw_buffer_store_b128(w, rs, voff, soff, 0);
#endif
}
__device__ __forceinline__ float silu1(float x) { return x * __builtin_amdgcn_rcpf(1.f + __builtin_amdgcn_exp2f(-1.4426950408889634f * x)); }
__device__ __forceinline__ float sigm1(float x) { return __builtin_amdgcn_rcpf(1.f + __builtin_amdgcn_exp2f(-1.4426950408889634f * x)); }
__device__ __forceinline__ float logsig1(float x) {
    const float e = __builtin_amdgcn_exp2f(-1.4426950408889634f * __builtin_fabsf(x));
    return fminf(x, 0.f) - 0.6931471805599453f * __builtin_amdgcn_logf(1.f + e);
}
#if 1
#define ST1(so) (*(float*)((rs + (size_t)(unsigned)(so)) + (unsigned)voff) = lf)
#else
#define ST1(so) __builtin_amdgcn_raw_buffer_store_b32(__float_as_uint(lf), rs, voff, (so), 0)
#endif
#ifndef EPIZ_SECS
#define EPIZ_SECS 31
#endif
struct EpiZ {
    static constexpr bool PERM = true, AFTER_DRAIN = false;
    unsigned char* ws; const float* b_forget; const float* g_q; const float* g_k; LAS float* nrm;
    __device__ __forceinline__ void operator()(const f32x4 (&acc)[2][2][4][2], const Unit& u, int wr, int wc, int fr, int fq) const {
        int fr_ = fr, fq_ = fq; asm volatile("" : "+v"(fr_), "+v"(fq_));
        body(acc, u, wr, wc, fr_, fq_);
    }
    __device__ __forceinline__ void body(const f32x4 (&acc)[2][2][4][2], const Unit& u, int wr, int wc, int fr, int fq) const {
        const int pn = u.pn, pm = u.pm;
        const bool meta_tile = (pm == MTOK / 256);
        const int b = pm >> 5;
        const int tu0 = (pm & 31) * 256 + wr * 64;
        if (pn < 24) {
            const int sec = pn >> 3, hb = (pn & 7) * 2;
            if (!(EPIZ_SECS & 1)) return;
            if (meta_tile && sec == 0) return;
            const bool st_ok = !(meta_tile && wr != 0);
            const int rows_per = sec == 0 ? SEQ : SKV, roff = sec == 0 ? 0 : 64;
            const rsrc_t rs = mk_rsrc(ws + (sec == 0 ? WS_QA : (sec == 1 ? WS_KA : WS_VA)), (unsigned)(NB * NH) * rows_per * HD * 2);
            const int voff = (fr * HD + 8 * fq) * 2;
            if (sec < 2) {
                LAS float* part = nrm;
#pragma unroll
                for (int ai = 0; ai < 2; ++ai)
#pragma unroll
                    for (int m = 0; m < 4; ++m)
#pragma unroll
                        for (int bj = 0; bj < 2; ++bj) { const f32x4 a = acc[ai][bj][m][0], c = acc[ai][bj][m][1];
                            float q = ((a[0] * a[0] + a[1] * a[1]) + (a[2] * a[2] + a[3] * a[3])) + ((c[0] * c[0] + c[1] * c[1]) + (c[2] * c[2] + c[3] * c[3]));
                            q += __shfl_xor(q, 16); q += __shfl_xor(q, 32);
                            if (fq == 0) part[((((wr * 2 + ai) * 4 + m) * 2 + bj) * 16 + fr) * 4 + wc] = q; }
                asm volatile("s_waitcnt lgkmcnt(0)" ::: "memory"); __builtin_amdgcn_s_barrier();
                const float* gp = (sec == 0 ? g_q : g_k) + wc * 32 + 8 * fq; const float gs = sec == 0 ? 0.08838834764831845f : 1.f;
                const f32x4 g0 = *(const f32x4*)gp * gs, g1 = *(const f32x4*)(gp + 4) * gs;
#pragma unroll
                for (int ai = 0; ai < 2; ++ai)
#pragma unroll
                    for (int m = 0; m < 4; ++m)
#pragma unroll
                        for (int bj = 0; bj < 2; ++bj) {
                            if (meta_tile && (ai != 0 || m != 0)) continue;
                            const f32x4 p4 = *(const LAS f32x4*)(part + ((((wr * 2 + ai) * 4 + m) * 2 + bj) * 16 + fr) * 4);
                            const float rn = 1.f / sqrtf(((p4[0] + p4[1]) + (p4[2] + p4[3])) * (1.f / HD) + EPS);
                            const f32x4 oa = acc[ai][bj][m][0] * rn * g0, oc = acc[ai][bj][m][1] * rn * g1;
                            if (!meta_tile) st8b(rs, voff, (((b * NH + hb + bj) * rows_per + roff + tu0 + ai * 128 + m * 16) * HD + wc * 32) * 2, oa, oc);
                            else if (st_ok) {
#pragma unroll
                                for (int bb = 0; bb < NB; ++bb) st8b(rs, voff, (((bb * NH + hb + bj) * rows_per + 48) * HD + wc * 32) * 2, oa, oc);
                            }
                        }
            } else if (st_ok) {
                if (!meta_tile) {
#pragma unroll
                    for (int ai = 0; ai < 2; ++ai)
#pragma unroll
                        for (int m = 0; m < 4; ++m)
#pragma unroll
                            for (int bj = 0; bj < 2; ++bj)
                                st8b(rs, voff, (((b * NH + hb + bj) * rows_per + roff + tu0 + ai * 128 + m * 16) * HD + wc * 32) * 2, acc[ai][bj][m][0], acc[ai][bj][m][1]);
                } else {
#pragma unroll
                    for (int bj = 0; bj < 2; ++bj)
#pragma unroll
                        for (int bb = 0; bb < NB; ++bb) st8b(rs, voff, (((bb * NH + hb + bj) * rows_per + 48) * HD + wc * 32) * 2, acc[0][bj][0][0], acc[0][bj][0][1]);
                }
            }
        } else if (pn < 40) {
            const bool isk = pn >= 32; const int hb = ((pn - 24) & 7) * 2;
            if (!(EPIZ_SECS & 2)) return;
            if (meta_tile && (!isk || wr != 0)) return;
            const rsrc_t rs = mk_rsrc(ws + (isk ? WS_KR : WS_QR), (unsigned)(NB * NH) * LR * HD * 2);
            const float sc = isk ? 0.08838834764831845f : 1.f;
            const int voff = (fr * HD + 8 * fq) * 2;
            double rr[4];
#pragma unroll
            for (int p = 0; p < 4; ++p) rr[p] = ROT_REV[wc * 16 + 4 * fq + p];
#pragma unroll
            for (int ai = 0; ai < 2; ++ai)
#pragma unroll
                for (int m = 0; m < 4; ++m) {
                    if (meta_tile && (ai != 0 || m != 0)) continue;
                    const int pos = meta_tile ? fr : (NMETA + tu0 + ai * 128 + m * 16 + fr);
                    float cs[4], sn[4];
#pragma unroll
                    for (int p = 0; p < 4; ++p) { double rv = (double)pos * rr[p]; rv -= __builtin_floor(rv); const float rf = (float)rv; sn[p] = __builtin_amdgcn_sinf(rf) * sc; cs[p] = __builtin_amdgcn_cosf(rf) * sc; }
#pragma unroll
                    for (int bj = 0; bj < 2; ++bj) {
                        const f32x4 a = acc[ai][bj][m][0], c = acc[ai][bj][m][1];
                        f32x4 oa, oc;
                        oa[0] = a[0] * cs[0] - a[1] * sn[0]; oa[1] = a[0] * sn[0] + a[1] * cs[0];
                        oa[2] = a[2] * cs[1] - a[3] * sn[1]; oa[3] = a[2] * sn[1] + a[3] * cs[1];
                        oc[0] = c[0] * cs[2] - c[1] * sn[2]; oc[1] = c[0] * sn[2] + c[1] * cs[2];
                        oc[2] = c[2] * cs[3] - c[3] * sn[3]; oc[3] = c[2] * sn[3] + c[3] * cs[3];
                        if (!meta_tile) st8b(rs, voff, (((b * NH + hb + bj) * LR + 128 + tu0 + ai * 128 + m * 16) * HD + wc * 32) * 2, oa, oc);
                        else {
#pragma unroll
                            for (int bb = 0; bb < NB; ++bb) st8b(rs, voff, (((bb * NH + hb + bj) * LR + 112) * HD + wc * 32) * 2, oa, oc);
                        }
                    }
                    __builtin_amdgcn_sched_barrier(0);
                }
        } else if (pn < 56) {
            const int h = pn - 40;
            if (!(EPIZ_SECS & 4)) return;
            if (meta_tile && wr != 0) return;
            const rsrc_t rs = mk_rsrc(ws + WS_VR, (unsigned)(NB * NH) * LR * RDV * 2);
            const int voff = (fr * RDV + 8 * fq) * 2;
            if (!meta_tile) {
#pragma unroll
                for (int ai = 0; ai < 2; ++ai)
#pragma unroll
                    for (int m = 0; m < 4; ++m)
#pragma unroll
                        for (int bj = 0; bj < 2; ++bj)
                            st8b(rs, voff, (((b * NH + h) * LR + 128 + tu0 + ai * 128 + m * 16) * RDV + bj * 128 + wc * 32) * 2, acc[ai][bj][m][0], acc[ai][bj][m][1]);
            } else {
#pragma unroll
                for (int bj = 0; bj < 2; ++bj)
#pragma unroll
                    for (int bb = 0; bb < NB; ++bb) st8b(rs, voff, (((bb * NH + h) * LR + 112) * RDV + bj * 128 + wc * 32) * 2, acc[0][bj][0][0], acc[0][bj][0][1]);
            }
        } else if (pn < 104) {
            if (meta_tile || !(EPIZ_SECS & 8)) return;
            const int sec = (pn - 56) >> 4;
            const rsrc_t rs = mk_rsrc(ws + (sec == 0 ? WS_GR : (sec == 1 ? WS_GA : WS_GT)), (unsigned)MTOK * DM * 2);
            const int voff = (fr * DM + 8 * fq) * 2, c0 = ((pn - 56) & 15) * 256 + wc * 32;
#pragma unroll
            for (int ai = 0; ai < 2; ++ai)
#pragma unroll
                for (int m = 0; m < 4; ++m) {
#pragma unroll
                    for (int bj = 0; bj < 2; ++bj) { f32x4 a = acc[ai][bj][m][0], c = acc[ai][bj][m][1];
                        if (sec == 0) {
#pragma unroll
                            for (int k = 0; k < 4; ++k) { a[k] = silu1(a[k]); c[k] = silu1(c[k]); }
                        } else {
#pragma unroll
                            for (int k = 0; k < 4; ++k) { a[k] = sigm1(a[k]); c[k] = sigm1(c[k]); }
                        }
                        st8b(rs, voff, ((pm * 256 + wr * 64 + ai * 128 + m * 16) * DM + c0 + bj * 128) * 2, a, c); }
                    __builtin_amdgcn_sched_barrier(0);
                }
        } else {
            if (!(EPIZ_SECS & 16)) return;
            if (wc != 0 || fq >= 2 || (meta_tile && wr != 0)) return;
            const rsrc_t rs = mk_rsrc(ws + WS_CUM, (unsigned)(NB * NH) * SKV * 4);
            const f32x4 b0 = *(const f32x4*)(b_forget + 8 * fq), b1 = *(const f32x4*)(b_forget + 8 * fq + 4);
            const int voff = (8 * fq * SKV + fr) * 4;
#pragma unroll
            for (int ai = 0; ai < 2; ++ai)
#pragma unroll
                for (int m = 0; m < 4; ++m) {
                    if (meta_tile && (ai != 0 || m != 0)) continue;
                    const f32x4 a = acc[ai][0][m][0] + b0, c = acc[ai][0][m][1] + b1;
#pragma unroll
                    for (int k = 0; k < 8; ++k) { const float lf = logsig1(k < 4 ? a[k] : c[k - 4]);
                        if (!meta_tile) ST1(((b * NH + k) * SKV + 64 + tu0 + ai * 128 + m * 16) * 4);
                        else { ST1(((0 * NH + k) * SKV + 48) * 4); ST1(((1 * NH + k) * SKV + 48) * 4); } }
                }
        }
    }
};
}
namespace pg8 {
__device__ __forceinline__ void unpack8(const u32x4 w, float (&f)[8]) {
    f[0] = __uint_as_float(w.x << 16); f[1] = __uint_as_float(w.x & 0xffff0000u); f[2] = __uint_as_float(w.y << 16); f[3] = __uint_as_float(w.y & 0xffff0000u);
    f[4] = __uint_as_float(w.z << 16); f[5] = __uint_as_float(w.z & 0xffff0000u); f[6] = __uint_as_float(w.w << 16); f[7] = __uint_as_float(w.w & 0xffff0000u);
}
template <int MODE> struct EpiGate {
    static constexpr bool PERM = true, AFTER_DRAIN = false;
    bf16_t* O; const bf16_t* G; int ldc;
    __device__ __forceinline__ void operator()(const f32x4 (&acc)[2][2][4][2], const Unit& u, int wr, int wc, int fr, int fq) const {
        const int row0 = u.pm * BM + wr * 64 + fr, col0 = u.pn * BM + wc * 32 + 8 * fq;
#pragma unroll
        for (int ai = 0; ai < 2; ++ai)
#pragma unroll
            for (int m = 0; m < 4; ++m) { const size_t off = (size_t)(row0 + ai * HALF + m * 16) * ldc + col0;
#pragma unroll
                for (int bj = 0; bj < 2; ++bj) { f32x4 v0 = acc[ai][bj][m][0], v1 = acc[ai][bj][m][1];
                    if (MODE != 2) { float g[8]; unpack8(*(const u32x4*)(G + off + bj * HALF), g);
                        v0[0] *= g[0]; v0[1] *= g[1]; v0[2] *= g[2]; v0[3] *= g[3]; v1[0] *= g[4]; v1[1] *= g[5]; v1[2] *= g[6]; v1[3] *= g[7]; }
                    if (MODE == 1) { float t[8]; unpack8(*(const u32x4*)(O + off + bj * HALF), t);
                        v0[0] += t[0]; v0[1] += t[1]; v0[2] += t[2]; v0[3] += t[3]; v1[0] += t[4]; v1[1] += t[5]; v1[2] += t[6]; v1[3] += t[7]; }
                    u32x4 w; w.x = cvt_pk_bf16(v0[0], v0[1]); w.y = cvt_pk_bf16(v0[2], v0[3]); w.z = cvt_pk_bf16(v1[0], v1[1]); w.w = cvt_pk_bf16(v1[2], v1[3]);
                    *(u32x4*)(O + off + bj * HALF) = w; } }
    }
};
struct EpiResF32 {
    static constexpr bool PERM = false, AFTER_DRAIN = false;
    const float* base; float* out; int ldc;
    __device__ __forceinline__ void operator()(const f32x4 (&acc)[2][2][4][2], const Unit& u, int wr, int wc, int fr, int fq) const {
        const int row0 = u.pm * BM + wr * 64 + fr, col0 = u.pn * BM + wc * 32 + 4 * fq;
#pragma unroll
        for (int ai = 0; ai < 2; ++ai)
#pragma unroll
            for (int m = 0; m < 4; ++m) { const size_t off = (size_t)(row0 + ai * HALF + m * 16) * ldc + col0;
#pragma unroll
                for (int bj = 0; bj < 2; ++bj)
#pragma unroll
                    for (int n = 0; n < 2; ++n) { const f32x4 bs = *(const f32x4*)(base + off + bj * HALF + n * 16); *(f32x4*)(out + off + bj * HALF + n * 16) = bs + acc[ai][bj][m][n]; } }
    }
};
struct EpiResHG {
    static constexpr bool PERM = false, AFTER_DRAIN = false;
    const float* base; float* out; bf16_t* HG; const float* gain; float* SSP; int ldc;
    __device__ __forceinline__ void operator()(const f32x4 (&acc)[2][2][4][2], const Unit& u, int wr, int wc, int fr, int fq) const {
        const int row0 = u.pm * BM + wr * 64 + fr, col0 = u.pn * BM + wc * 32 + 4 * fq;
        f32x4 gv[2][2];
#pragma unroll
        for (int bj = 0; bj < 2; ++bj)
#pragma unroll
            for (int n = 0; n < 2; ++n) gv[bj][n] = *(const f32x4*)(gain + col0 + bj * HALF + n * 16);
#pragma unroll
        for (int ai = 0; ai < 2; ++ai)
#pragma unroll
            for (int m = 0; m < 4; ++m) { const int row = row0 + ai * HALF + m * 16; const size_t off = (size_t)row * ldc + col0; float ss = 0.f;
#pragma unroll
                for (int bj = 0; bj < 2; ++bj)
#pragma unroll
                    for (int n = 0; n < 2; ++n) { const f32x4 h = *(const f32x4*)(base + off + bj * HALF + n * 16) + acc[ai][bj][m][n];
                        *(f32x4*)(out + off + bj * HALF + n * 16) = h; ss += (h[0] * h[0] + h[1] * h[1]) + (h[2] * h[2] + h[3] * h[3]);
                        const f32x4 hg = h * gv[bj][n]; typedef unsigned u32x2 __attribute__((ext_vector_type(2)));
                        u32x2 w; w.x = cvt_pk_bf16(hg[0], hg[1]); w.y = cvt_pk_bf16(hg[2], hg[3]); *(u32x2*)(HG + off + bj * HALF + n * 16) = w; }
                ss += __shfl_xor(ss, 16); ss += __shfl_xor(ss, 32);
                if (fq == 0) SSP[(size_t)row * 64 + u.pn * 4 + wc] = ss; }
    }
};
struct EpiRowScale {
    static constexpr bool PERM = true, AFTER_DRAIN = false;
    bf16_t* O; const PG8_LAS float* rs; int ldc;
    __device__ __forceinline__ void operator()(const f32x4 (&acc)[2][2][4][2], const Unit& u, int wr, int wc, int fr, int fq) const {
        const int rl0 = wr * 64 + fr, col0 = u.pn * BM + wc * 32 + 8 * fq; const PG8_LAS float* rp = rs + 256 * u.idx;
#pragma unroll
        for (int ai = 0; ai < 2; ++ai)
#pragma unroll
            for (int m = 0; m < 4; ++m) { const int rl = rl0 + ai * HALF + m * 16; const float r = rp[rl]; const size_t off = (size_t)(u.pm * BM + rl) * ldc + col0;
#pragma unroll
                for (int bj = 0; bj < 2; ++bj) { const f32x4 v0 = acc[ai][bj][m][0] * r, v1 = acc[ai][bj][m][1] * r;
                    u32x4 w; w.x = cvt_pk_bf16(v0[0], v0[1]); w.y = cvt_pk_bf16(v0[2], v0[3]); w.z = cvt_pk_bf16(v1[0], v1[1]); w.w = cvt_pk_bf16(v1[2], v1[3]);
                    *(u32x4*)(O + off + bj * HALF) = w; } }
    }
};
struct EpiNull { static constexpr bool PERM = true, AFTER_DRAIN = false; float* sink;
    __device__ __forceinline__ void operator()(const f32x4 (&acc)[2][2][4][2], const Unit& u, int wr, int wc, int fr, int fq) const {
        if (sink) { float s = 0.f;
#pragma unroll
            for (int ai = 0; ai < 2; ++ai)
#pragma unroll
                for (int bj = 0; bj < 2; ++bj)
#pragma unroll
                    for (int m = 0; m < 4; ++m)
#pragma unroll
                        for (int n = 0; n < 2; ++n) s += acc[ai][bj][m][n][0] + acc[ai][bj][m][n][1] + acc[ai][bj][m][n][2] + acc[ai][bj][m][n][3];
            if (s == 123.456f) *sink = s; } } };
struct SyncOrder : StaticOrder {
    unsigned* cnt; int on;
    __device__ __forceinline__ void a_ready(const Unit& u) const {
        if (!on) return;
        if (threadIdx.x < 64) {
            const int g = c & 7, i = u.idx;
            const long rem = (long)nwg - (long)i * G;
            const int lim = rem < (long)G ? (int)rem : G;
            const unsigned want = (unsigned)((lim - g + 7) / 8);
            unsigned* w = cnt + (size_t)(i * 8 + g) * 64;
            if (threadIdx.x == 0) __hip_atomic_fetch_add(w, 1u, __ATOMIC_RELAXED, __HIP_MEMORY_SCOPE_AGENT);
            const unsigned long long t0 = __builtin_amdgcn_s_memrealtime();
            while ((unsigned)__builtin_amdgcn_readfirstlane(__hip_atomic_load(w, __ATOMIC_RELAXED, __HIP_MEMORY_SCOPE_AGENT)) < want) {
                if (__builtin_amdgcn_s_memrealtime() - t0 > 20000ull) break;
                __builtin_amdgcn_s_sleep(2); }
        }
        asm volatile("" ::: "memory"); __builtin_amdgcn_s_barrier(); asm volatile("" ::: "memory");
    }
};
}
namespace pg8 {
template <class Epi, class Sched, bool ALIGN_EPI = false, bool SP2 = false>
__device__ __forceinline__ void gemm_phase(PG8_LAS unsigned char* lds, const Gemm g, const Sched& S, const Epi& E) {
    int tid_ = threadIdx.x; asm volatile("" : "+v"(tid_));
    const int tid = tid_, wid = __builtin_amdgcn_readfirstlane(tid >> 6), lane = tid & 63, wr = wid >> 2, wc = wid & 3, fr = lane & 15, fq = lane >> 4;
    const int K = g.K, nt = K / BK;
    unsigned voffA[2], voffB[2];
#pragma unroll
    for (int i = 0; i < 2; ++i) { int R, C; stage_rc(tid * 16 + i * 8192, R, C); const int Rb = Epi::PERM ? ((R & ~31) + perm32(R & 31)) : R;
        voffA[i] = (unsigned)(R * K + C) * 2u; voffB[i] = (unsigned)(Rb * K + C) * 2u; }
    const size_t kstep = (size_t)(BK * 2);
    const size_t hstep = (size_t)HALF * K * 2;
    const size_t tstep = 2 * hstep;
    const unsigned ldsw = (unsigned)wid * 1024u;
    const int aoff = lds_byte(wr * 64 + fr, fq * 8), boff = lds_byte(wc * 32 + fr, fq * 8);
#define PG8_SA(b, h) (((b) * 2 + (h)) * HTB)
#define PG8_SB(b, h) ((4 + (b) * 2 + (h)) * HTB)
#define PG8_STAGE(bufoff, gbase, voff) do { _Pragma("unroll") for (int _i = 0; _i < 2; ++_i) \
        __builtin_amdgcn_global_load_lds((const unsigned*)((const char*)(gbase) + (voff)[_i]), (PG8_LAS unsigned*)(lds + (bufoff) + ldsw + _i * 8192), 16, 0, 0); } while (0)
#define PG8_LDA(dst, b, h) do { _Pragma("unroll") for (int m = 0; m < 4; ++m) _Pragma("unroll") for (int k = 0; k < 2; ++k) dst[m][k] = *(const PG8_LAS bf16x8*)(lds + PG8_SA(b, h) + aoff + m * 2048 + k * 1024); } while (0)
#define PG8_LDB(dst, b, h) do { _Pragma("unroll") for (int n = 0; n < 2; ++n) _Pragma("unroll") for (int k = 0; k < 2; ++k) dst[n][k] = *(const PG8_LAS bf16x8*)(lds + PG8_SB(b, h) + boff + n * 2048 + k * 1024); } while (0)
#define PG8_MMA(ai, bj, At, Bt) do { __builtin_amdgcn_s_setprio(1); _Pragma("unroll") for (int m = 0; m < 4; ++m) _Pragma("unroll") for (int n = 0; n < 2; ++n) _Pragma("unroll") for (int k = 0; k < 2; ++k) \
        acc[ai][bj][m][n] = __builtin_amdgcn_mfma_f32_16x16x32_bf16(Bt[n][k], At[m][k], acc[ai][bj][m][n], 0, 0, 0); __builtin_amdgcn_s_setprio(0); } while (0)
#define PG8_WAIT_V(n) asm volatile("s_waitcnt vmcnt(" #n ")" ::: "memory")
#define PG8_WAIT_L(n) asm volatile("s_waitcnt lgkmcnt(" #n ")" ::: "memory")
#define PG8_BAR __builtin_amdgcn_s_barrier()
#define PG8_SCHED __builtin_amdgcn_sched_barrier(0)
    Unit cur, nxt; int ui = 0;
    if (!S.next(0, cur)) return;
    f32x4 acc[2][2][4][2];
#pragma unroll
    for (int a = 0; a < 2; ++a)
#pragma unroll
        for (int b = 0; b < 2; ++b)
#pragma unroll
            for (int m = 0; m < 4; ++m)
#pragma unroll
                for (int n = 0; n < 2; ++n) acc[a][b][m][n] = (f32x4){0.f, 0.f, 0.f, 0.f};
    bf16x8 At[4][2], B0[2][2], B1[2][2];
    const char* cA = (const char*)g.A + (size_t)cur.pm * tstep; const char* cB = (const char*)g.Bt + (size_t)cur.pn * tstep;
    S.a_ready(cur);
    if constexpr (SP2) {
        PG8_STAGE(PG8_SB(0, 0), cB, voffB); PG8_STAGE(PG8_SB(0, 1), cB + hstep, voffB); PG8_STAGE(PG8_SA(0, 0), cA, voffA); PG8_STAGE(PG8_SA(0, 1), cA + hstep, voffA);
        if (wr == 1) PG8_BAR;
        PG8_WAIT_V(2); PG8_BAR;
        PG8_STAGE(PG8_SB(1, 0), cB + kstep, voffB); PG8_STAGE(PG8_SA(1, 0), cA + kstep, voffA); PG8_STAGE(PG8_SB(1, 1), cB + hstep + kstep, voffB);
        PG8_WAIT_V(6); PG8_BAR;
    } else {
        PG8_STAGE(PG8_SB(0, 0), cB, voffB); PG8_STAGE(PG8_SA(0, 0), cA, voffA); PG8_STAGE(PG8_SB(0, 1), cB + hstep, voffB); PG8_STAGE(PG8_SA(0, 1), cA + hstep, voffA);
        if (wr == 1) PG8_BAR;
        PG8_WAIT_V(4); PG8_BAR;
        PG8_STAGE(PG8_SB(1, 0), cB + kstep, voffB); PG8_STAGE(PG8_SA(1, 0), cA + kstep, voffA); PG8_STAGE(PG8_SB(1, 1), cB + hstep + kstep, voffB);
        PG8_WAIT_V(6); PG8_BAR;
    }
    for (;;) {
        const bool has_next = S.next(ui + 1, nxt);
        const char* nA = has_next ? (const char*)g.A + (size_t)nxt.pm * tstep : cA; const char* nB = has_next ? (const char*)g.Bt + (size_t)nxt.pn * tstep : cB;
        for (int t = 0; t < nt; t += 2) {
            const bool last = (t == nt - 2);
            const char* a1 = cA + (size_t)(t + 1) * kstep;
            const char* a2 = last ? nA : cA + (size_t)(t + 2) * kstep; const char* b2 = last ? nB : cB + (size_t)(t + 2) * kstep;
            const char* a3 = a2 + kstep; const char* b3 = b2 + kstep;
            if (last && has_next) S.a_ready(nxt);
            if constexpr (SP2) {
            PG8_LDB(B0, 0, 0); PG8_LDB(B1, 0, 1); PG8_SCHED; PG8_LDA(At, 0, 0); PG8_STAGE(PG8_SA(1, 1), a1 + hstep, voffA);
            PG8_WAIT_V(8); PG8_WAIT_L(0); PG8_BAR; PG8_MMA(0, 0, At, B0); PG8_MMA(0, 1, At, B1); PG8_BAR; PG8_SCHED;
            PG8_LDA(At, 0, 1); PG8_STAGE(PG8_SB(0, 0), b2, voffB); PG8_STAGE(PG8_SB(0, 1), b2 + hstep, voffB); PG8_STAGE(PG8_SA(0, 0), a2, voffA);
            PG8_WAIT_V(8); PG8_WAIT_L(0); PG8_BAR; PG8_MMA(1, 0, At, B0); PG8_MMA(1, 1, At, B1); PG8_BAR; PG8_SCHED;
            PG8_LDB(B0, 1, 0); PG8_LDB(B1, 1, 1); PG8_SCHED; PG8_LDA(At, 1, 0); PG8_STAGE(PG8_SA(0, 1), a2 + hstep, voffA);
            PG8_WAIT_V(8); PG8_WAIT_L(0); PG8_BAR; PG8_MMA(0, 0, At, B0); PG8_MMA(0, 1, At, B1); PG8_BAR; PG8_SCHED;
            PG8_LDA(At, 1, 1); PG8_STAGE(PG8_SB(1, 0), b3, voffB); PG8_STAGE(PG8_SB(1, 1), b3 + hstep, voffB); PG8_STAGE(PG8_SA(1, 0), a3, voffA);
            PG8_WAIT_V(8); PG8_WAIT_L(0); PG8_BAR; PG8_MMA(1, 0, At, B0); PG8_MMA(1, 1, At, B1); PG8_BAR; PG8_SCHED;
            } else {
            PG8_LDB(B0, 0, 0); PG8_SCHED; PG8_LDA(At, 0, 0); PG8_STAGE(PG8_SA(1, 1), a1 + hstep, voffA);
            PG8_WAIT_L(8); PG8_BAR; PG8_WAIT_L(0); PG8_MMA(0, 0, At, B0); PG8_BAR; PG8_SCHED;
            PG8_LDB(B1, 0, 1); PG8_STAGE(PG8_SB(0, 0), b2, voffB);
            PG8_BAR; PG8_WAIT_L(0); PG8_MMA(0, 1, At, B1); PG8_BAR;
            PG8_LDA(At, 0, 1); PG8_STAGE(PG8_SA(0, 0), a2, voffA);
            PG8_BAR; PG8_WAIT_L(0); PG8_MMA(1, 0, At, B0); PG8_BAR; PG8_SCHED;
            PG8_STAGE(PG8_SB(0, 1), b2 + hstep, voffB);
            PG8_WAIT_V(6); PG8_BAR; PG8_MMA(1, 1, At, B1); PG8_BAR;
            PG8_LDB(B0, 1, 0); PG8_SCHED; PG8_LDA(At, 1, 0); PG8_STAGE(PG8_SA(0, 1), a2 + hstep, voffA);
            PG8_WAIT_L(8); PG8_BAR; PG8_WAIT_L(0); PG8_MMA(0, 0, At, B0); PG8_BAR; PG8_SCHED;
            PG8_LDB(B1, 1, 1); PG8_STAGE(PG8_SB(1, 0), b3, voffB);
            PG8_BAR; PG8_WAIT_L(0); PG8_MMA(0, 1, At, B1); PG8_BAR;
            PG8_LDA(At, 1, 1); PG8_STAGE(PG8_SA(1, 0), a3, voffA);
            PG8_BAR; PG8_WAIT_L(0); PG8_MMA(1, 0, At, B0); PG8_BAR; PG8_SCHED;
            PG8_STAGE(PG8_SB(1, 1), b3 + hstep, voffB);
            PG8_WAIT_V(6); PG8_BAR; PG8_MMA(1, 1, At, B1); PG8_BAR;
            }
        }
        if constexpr (ALIGN_EPI) { if (wr == 0) PG8_BAR; }
        if constexpr (!Epi::AFTER_DRAIN) { E(acc, cur, wr, wc, fr, fq); S.done(cur); }
        if (!has_next) break;
#pragma unroll
        for (int a = 0; a < 2; ++a)
#pragma unroll
            for (int b = 0; b < 2; ++b)
#pragma unroll
                for (int m = 0; m < 4; ++m)
#pragma unroll
                    for (int n = 0; n < 2; ++n) acc[a][b][m][n] = (f32x4){0.f, 0.f, 0.f, 0.f};
        cur = nxt; cA = nA; cB = nB; ++ui;
        if constexpr (ALIGN_EPI) { if (wr == 1) PG8_BAR; }
    }
    PG8_WAIT_V(0);
    if constexpr (!ALIGN_EPI) { if (wr == 0) PG8_BAR; }
    PG8_BAR;
    if constexpr (Epi::AFTER_DRAIN) { E.fused(acc, cur, wr, wc, fr, fq, lds, wid, lane); S.done(cur); }
#undef PG8_SA
#undef PG8_SB
#undef PG8_STAGE
#undef PG8_LDA
#undef PG8_LDB
#undef PG8_MMA
#undef PG8_WAIT_V
#undef PG8_WAIT_L
#undef PG8_BAR
#undef PG8_SCHED
}
}
#define XB_TMO      128
#define XB_XCNT(j)  (256  + 64 * (j))
#define XB_XSUB(j)  (1280 + 64 * (j))
#define XB_XGEN(j)  (2304 + 64 * (j))
#define XB_TOP      3328
#define XB_TOPGEN   3392
#define XCD_BAR_WORDS 3456
#define XB_SPIN_CAP (1u << 22)

__device__ __forceinline__ unsigned xb_ld(unsigned* p)              { return __hip_atomic_load(p, __ATOMIC_RELAXED, __HIP_MEMORY_SCOPE_AGENT); }
__device__ __forceinline__ unsigned xb_add(unsigned* p, unsigned v) { return __hip_atomic_fetch_add(p, v, __ATOMIC_RELAXED, __HIP_MEMORY_SCOPE_AGENT); }
__device__ __forceinline__ unsigned xb_xcc_id() { return (unsigned)__builtin_amdgcn_s_getreg((3 << 11) | 20) & 0xFu; }
#define XB_SPIN(cond, bar) do { unsigned _sp = 0; while (cond) { __builtin_amdgcn_s_sleep(1); \
    if ((++_sp & 255u) == 0u) { if (xb_ld(&(bar)[XB_TMO])) break; if (_sp > XB_SPIN_CAP) { atomicAdd(&(bar)[XB_TMO], 1u); break; } } } } while (0)

struct XcdBarrier {
    unsigned* bar; unsigned x; unsigned G;
    volatile LAS unsigned* st;
};

__device__ __forceinline__ XcdBarrier xcd_barrier_post(unsigned* bar, volatile LAS unsigned* st, unsigned G) {
    XcdBarrier b; b.bar = bar; b.x = xb_xcc_id(); b.st = st; b.G = G;
    if (threadIdx.x == 0) (void)xb_add(&bar[XB_XCNT(b.x)], 1u);
    return b;
}
__device__ __forceinline__ void xcd_barrier_complete(unsigned* bar, unsigned x, unsigned G, unsigned& nloc, unsigned& nx) {
    unsigned sum, cnt, mine, sp = 0u;
    for (;;) {
        sum = 0u; cnt = 0u; mine = 0u;
#pragma unroll
        for (unsigned j = 0; j < 16; ++j) { const unsigned c = xb_ld(&bar[XB_XCNT(j)]); sum += c; cnt += (c > 0u) ? 1u : 0u; mine = (j == x) ? c : mine; }
        if (sum == G) break;
        __builtin_amdgcn_s_sleep(1);
        if ((++sp & 255u) == 0u) { if (xb_ld(&bar[XB_TMO])) break; if (sp > XB_SPIN_CAP) { atomicAdd(&bar[XB_TMO], 1u); break; } }
    }
    nloc = mine > 0u ? mine : 1u; nx = cnt > 0u ? cnt : 1u;
}

__device__ __forceinline__ void xcd_barrier(const XcdBarrier& b) {
    asm volatile("s_waitcnt vmcnt(0)" ::: "memory");
    __syncthreads();
    if (threadIdx.x == 0) {
        unsigned* bar = b.bar;
        __builtin_amdgcn_s_waitcnt(0);
        unsigned nloc = b.st[0], nx = b.st[1];
        if (nloc == 0u) { xcd_barrier_complete(bar, b.x, b.G, nloc, nx); b.st[0] = nloc; b.st[1] = nx; }
        const unsigned old = xb_add(&bar[XB_XSUB(b.x)], 1u);
        const unsigned gen = old / nloc;
        if (old + 1u == (gen + 1u) * nloc) {
            __builtin_amdgcn_fence(__ATOMIC_RELEASE, "agent");
            asm volatile("s_waitcnt vmcnt(0)" ::: "memory");
            const unsigned og = xb_add(&bar[XB_TOP], 1u);
            const unsigned tg = og / nx;
            if (og + 1u == (tg + 1u) * nx) xb_add(&bar[XB_TOPGEN], 1u);
            else XB_SPIN(xb_ld(&bar[XB_TOPGEN]) == tg, bar);
            __builtin_amdgcn_fence(__ATOMIC_ACQUIRE, "agent");
            xb_add(&bar[XB_XGEN(b.x)], 1u);
            asm volatile("s_waitcnt vmcnt(0)" ::: "memory");
        } else {
            XB_SPIN(xb_ld(&bar[XB_XGEN(b.x)]) == gen, bar);
            __builtin_amdgcn_fence(__ATOMIC_ACQUIRE, "agent");
            asm volatile("s_waitcnt vmcnt(0)" ::: "memory");
        }
    }
    __syncthreads();
}
struct Frame {
    LAS unsigned char* lds;
    volatile LAS unsigned* MISC;
    gu32* ctl;
    int tid, lane, wave;
    int vcu, G;
    unsigned char* ws;
    const float *x, *meta, *g_mix, *w_in, *b_forget, *g_q, *g_k, *g_ret, *w_fox, *w_ret, *w_out, *g_ffn, *w_q, *keys1, *keys2, *pu, *pv;
    float* out;
};
template <class T> __device__ __forceinline__ T* wsp(const Frame& F, size_t off) { return (T*)(F.ws + off); }

__device__ __forceinline__ int z_src_col(int n) {
    if (n < Z_QR) return n;
    if (n < Z_VR) { const int np = n - Z_QR, j = np & 127, base = np - j; return 6160 + base + ((j & 1) ? 64 + (j >> 1) : (j >> 1)); }
    if (n < Z_F) return n + 16;
    if (n < Z_F + 16) return 6144 + (n - Z_F);
    return -1;
}
template <bool ZMAP>
__device__ __forceinline__ void p0_transpose_item(const float* W, int K, int Nsrc, int Ndst, bf16* WT, LAS float* scr, int item, int lane) {
    const int nblk = Ndst / 32, kb = item / nblk, nb = item % nblk, k0 = 64 * kb, n0 = 32 * nb;
    const int sc = ZMAP ? z_src_col(n0 + (lane & 31)) : (n0 + (lane & 31));
    float tv[32];
#pragma unroll
    for (int i = 0; i < 32; ++i) { const int kk = 2 * i + (lane >> 5); tv[i] = (sc >= 0) ? W[(size_t)(k0 + kk) * Nsrc + sc] : 0.f; }
#pragma unroll
    for (int i = 0; i < 32; ++i) { const int kk = 2 * i + (lane >> 5); scr[kk * 33 + (lane & 31)] = tv[i]; }
    LDS_WAIT(); asm volatile("" ::: "memory");
    const int c = lane & 7;
#pragma unroll
    for (int j = 0; j < 4; ++j) { const int n = (lane >> 3) + 8 * j; const LAS float* s = scr + (8 * c) * 33 + n;
        v4u o; o.x = pk2(s[0 * 33], s[1 * 33]); o.y = pk2(s[2 * 33], s[3 * 33]); o.z = pk2(s[4 * 33], s[5 * 33]); o.w = pk2(s[6 * 33], s[7 * 33]);
        *(GAS v4u*)(WT + (size_t)(n0 + n) * K + k0 + 8 * c) = o; }
    LDS_WAIT(); asm volatile("" ::: "memory");
}
__device__ __forceinline__ void rms_row_to_bf16(const float* xrow, const float* g, bf16* orow, int lane) {
    asm volatile("" : "+v"(lane));
    const GAS f32x4* xr = (const GAS f32x4*)xrow + lane;
    f32x4 v[16]; float s = 0.f;
#pragma unroll
    for (int j = 0; j < 16; ++j) { v[j] = xr[64 * j]; s += (v[j].x * v[j].x + v[j].y * v[j].y) + (v[j].z * v[j].z + v[j].w * v[j].w); }
    const float r = 1.f / sqrtf(wave_sum(s) * (1.f / DM) + EPS);
    const GAS f32x4* gr = (const GAS f32x4*)g + lane;
    GAS v2u* o8 = (GAS v2u*)orow + lane;
#pragma unroll
    for (int j = 0; j < 16; ++j) { const f32x4 gg = gr[64 * j]; v2u w; w.x = pk2(v[j].x * r * gg.x, v[j].y * r * gg.y); w.y = pk2(v[j].z * r * gg.z, v[j].w * r * gg.w); o8[64 * j] = w; }
}
__device__ __forceinline__ void zero_bytes16(unsigned char* p, size_t n16, int gt, int NT) {
    const v4u z = {0u, 0u, 0u, 0u};
    for (size_t i = gt; i < n16; i += NT) ((GAS v4u*)p)[i] = z;
}
__device__ __forceinline__ void p0_prologue(Frame& F) {
    LAS float* scr = (LAS float*)(F.lds + RING_OFF + F.wave * 16384);
    const int gw = F.vcu * 8 + F.wave, NGW = F.G * 8;
    bf16* WZ = wsp<bf16>(F, WS_WZ); bf16* WFOX = wsp<bf16>(F, WS_WFOX); bf16* WRET = wsp<bf16>(F, WS_WRET); bf16* WOUT = wsp<bf16>(F, WS_WOUT); bf16* WQ = wsp<bf16>(F, WS_WQ);
    constexpr int I_Z = (DM / 64) * (NZ / 32), I_FOX = (2048 / 64) * (DM / 32), I_RET = (DM / 64) * (DM / 32), I_OUT = I_RET, I_Q = (DM / 64) * (PQ / 32);
    constexpr int NITEMS = I_Z + I_FOX + I_RET + I_OUT + I_Q;
    for (int it = gw; it < NITEMS; it += NGW) {
        int r = it;
        if (r < I_Z) { p0_transpose_item<true>(F.w_in, DM, 26640, NZ, WZ, scr, r, F.lane); continue; } r -= I_Z;
        if (r < I_FOX) { p0_transpose_item<false>(F.w_fox, 2048, DM, DM, WFOX, scr, r, F.lane); continue; } r -= I_FOX;
        if (r < I_RET) { p0_transpose_item<false>(F.w_ret, DM, DM, DM, WRET, scr, r, F.lane); continue; } r -= I_RET;
        if (r < I_OUT) { p0_transpose_item<false>(F.w_out, DM, DM, DM, WOUT, scr, r, F.lane); continue; } r -= I_OUT;
        p0_transpose_item<false>(F.w_q, DM, PQ, PQ, WQ, scr, r, F.lane);
    }
    bf16* UX = wsp<bf16>(F, WS_UX);
    for (int m = gw; m < MTOK + NMETA; m += NGW) {
        const float* src = (m < MTOK) ? F.x + (size_t)m * DM : F.meta + (size_t)(m - MTOK) * DM;
        rms_row_to_bf16(src, F.g_mix, UX + (size_t)m * DM, F.lane);
    }
    const int gt = F.vcu * 512 + F.tid, NT = F.G * 512;
    zero_bytes16((unsigned char*)(UX + (size_t)(MTOK + NMETA) * DM), (size_t)(256 - NMETA) * DM * 2 / 16, gt, NT);
    { bf16* KB = wsp<bf16>(F, WS_KEYS); constexpr int NKE = PH * PK * PK;
      for (int i = gt; i < 2 * NKE / 4; i += NT) { const float* s = (i < NKE / 4) ? F.keys1 + 4 * (size_t)i : F.keys2 + 4 * (size_t)(i - NKE / 4); const f32x4 v = *(const GAS f32x4*)s;
          v2u w; w.x = pk2(v.x, v.y); w.y = pk2(v.z, v.w); *(GAS v2u*)(KB + 4 * (size_t)i) = w; } }
    for (int bh = 0; bh < NB * NH; ++bh) {
        zero_bytes16((unsigned char*)(wsp<bf16>(F, WS_KA) + (size_t)bh * SKV * HD), 48 * HD * 2 / 16, gt, NT);
        zero_bytes16((unsigned char*)(wsp<bf16>(F, WS_VA) + (size_t)bh * SKV * HD), 48 * HD * 2 / 16, gt, NT);
        zero_bytes16((unsigned char*)(wsp<bf16>(F, WS_KR) + (size_t)bh * LR * HD), 112 * HD * 2 / 16, gt, NT);
        zero_bytes16((unsigned char*)(wsp<bf16>(F, WS_VR) + (size_t)bh * LR * RDV), 112 * RDV * 2 / 16, gt, NT);
    }
}
typedef short v4i16_t __attribute__((ext_vector_type(4)));
__device__ __forceinline__ int v_st(int k, int c) { const int kk = (k & ~0xC) | ((k & 4) << 1) | ((k & 8) >> 1); return ((kk >> 3) * 4 + (c >> 5)) * 512 + ((kk & 7) * 32 + (c & 31)) * 2; }
__device__ __forceinline__ int v_rd_base(int lane) { return ((lane & 3) << 3) | (((lane >> 2) & 3) << 6) | (((lane >> 4) & 1) << 5) | (((lane >> 5) & 1) << 8); }
__device__ __forceinline__ s16x4 vtr(const LAS unsigned char* p) { return __builtin_bit_cast(s16x4, __builtin_amdgcn_ds_read_tr16_b64_v4i16((LAS v4i16_t*)p)); }
__device__ __forceinline__ bf16x8 tr_frag(const LAS unsigned char* p) {
    const s16x4 l = vtr(p), h = vtr(p + 2048);
    return (bf16x8){l[0], l[1], l[2], l[3], h[0], h[1], h[2], h[3]};
}
__device__ __forceinline__ int crow(int r, int hi) { return (r & 3) + 8 * (r >> 2) + 4 * hi; }
__device__ const float LG2GAM[16] = { -4.580368961e-02f, -2.272007650e-02f, -1.131531323e-02f, -5.646563141e-03f, -2.820519062e-03f, -1.409570255e-03f, -7.046129766e-04f, -3.522634716e-04f,
    -1.761209843e-04f, -8.805780458e-05f, -4.402823044e-05f, -2.201394726e-05f, -1.100693164e-05f, -5.503455325e-06f, -2.751725038e-06f, -1.375861863e-06f };

__device__ __forceinline__ void p2_cumsum(float* CUMp, int lane) {
    float carry = 0.f;
    constexpr int NIT = (SKV - 48 + 255) / 256;
    const GAS f32x4* src = (const GAS f32x4*)(CUMp + 48) + lane;
    f32x4 v = *src, vn;
    for (int it = 0; it < NIT; ++it) {
        const int j0n = 48 + (it + 1) * 256 + lane * 4;
        vn = (f32x4){0.f, 0.f, 0.f, 0.f};
        if (it + 1 < NIT && j0n < SKV) vn = src[(it + 1) * 64];
        const float p0 = v.x, p1 = p0 + v.y, p2 = p1 + v.z, p3 = p2 + v.w;
        float x = p3;
#pragma unroll
        for (int o = 1; o < 64; o <<= 1) { const float t = __shfl_up(x, o); if (lane >= o) x += t; }
        const float excl = carry + (x - p3);
        const int j0 = 48 + it * 256 + lane * 4;
        if (j0 < SKV) *((GAS f32x4*)(CUMp + j0)) = (f32x4){-(excl + p0), -(excl + p1), -(excl + p2), -(excl + p3)};
        carry += __shfl(x, 63);
        v = vn;
    }
    if (lane < 12) *((GAS f32x4*)CUMp + lane) = (f32x4){-__builtin_inff(), -__builtin_inff(), -__builtin_inff(), -__builtin_inff()};
}
__device__ __forceinline__ void p2_qknorm(Frame& F, int gw, int NGW) {
    constexpr int R_Q = NB * NH * SEQ, RK_PER = SKV - 48, R_K = NB * NH * RK_PER, NSTEP = (R_Q + R_K) / 4;
    bf16* QA = wsp<bf16>(F, WS_QA); bf16* KA = wsp<bf16>(F, WS_KA);
    const int sub = F.lane >> 4, c8 = (F.lane & 15) * 8;
    float gq[8], gk[8];
#pragma unroll
    for (int k = 0; k < 8; ++k) { gq[k] = F.g_q[c8 + k] * 0.08838834764831845f; gk[k] = F.g_k[c8 + k]; }
    for (int s0 = gw; s0 < NSTEP; s0 += 8 * NGW) {
        v4u w[8]; bf16* ptr[8]; bool isq[8], ok[8];
#pragma unroll
        for (int u = 0; u < 8; ++u) { const int s = s0 + u * NGW; ok[u] = s < NSTEP; const int r = 4 * s + sub;
            if (r < R_Q) { isq[u] = true; ptr[u] = QA + (size_t)r * HD + c8; }
            else { const int rp = r - R_Q, bh = rp / RK_PER, j = 48 + rp % RK_PER; isq[u] = false; ptr[u] = KA + ((size_t)bh * SKV + j) * HD + c8; }
            if (ok[u]) w[u] = *(const GAS v4u*)ptr[u]; else w[u] = (v4u){0u, 0u, 0u, 0u}; }
#pragma unroll
        for (int u = 0; u < 8; ++u) {
            float f[8] = {bflo(w[u].x), bfhi(w[u].x), bflo(w[u].y), bfhi(w[u].y), bflo(w[u].z), bfhi(w[u].z), bflo(w[u].w), bfhi(w[u].w)};
            float ss = 0.f;
#pragma unroll
            for (int k = 0; k < 8; ++k) ss += f[k] * f[k];
            ss += __shfl_xor(ss, 1); ss += __shfl_xor(ss, 2); ss += __shfl_xor(ss, 4); ss += __shfl_xor(ss, 8);
            const float rs = 1.f / sqrtf(ss * (1.f / HD) + EPS);
#pragma unroll
            for (int k = 0; k < 8; ++k) f[k] = f[k] * rs * (isq[u] ? gq[k] : gk[k]);
            v4u o; o.x = pk2(f[0], f[1]); o.y = pk2(f[2], f[3]); o.z = pk2(f[4], f[5]); o.w = pk2(f[6], f[7]);
            if (ok[u]) *(GAS v4u*)ptr[u] = o;
        }
    }
}
struct KvRegs { v4u kw[4], vw[2][4]; };
__device__ __forceinline__ void p2_kv_load(Frame& F, int item, KvRegs& R) {
    const int bh = item >> 6, n = item & 63;
    const bf16* Kg = wsp<bf16>(F, WS_KR) + ((size_t)bh * LR + 128 * n) * HD;
    const bf16* Vg = wsp<bf16>(F, WS_VR) + ((size_t)bh * LR + 128 * n) * RDV;
    int tid_ = F.tid; asm volatile("" : "+v"(tid_));
    const int sr = tid_ >> 4, sc = (tid_ & 15) * 8;
#pragma unroll
    for (int q = 0; q < 4; ++q) { const int j = sr + 32 * q; R.kw[q] = *(const GAS v4u*)(Kg + (size_t)j * HD + sc);
        R.vw[0][q] = *(const GAS v4u*)(Vg + (size_t)j * RDV + sc); R.vw[1][q] = *(const GAS v4u*)(Vg + (size_t)j * RDV + 128 + sc); }
}
__device__ __forceinline__ void p2_kv_item(Frame& F, int item, int next, KvRegs& R) {
    const int bh = item >> 6, h = bh & (NH - 1);
    const float lg2 = LG2GAM[h];
    LAS unsigned char* ldsV = F.lds; LAS unsigned char* ldsK = F.lds + 65536;
    const int sr = F.tid >> 4, sc = (F.tid & 15) * 8;
#pragma unroll
    for (int q = 0; q < 4; ++q) { const int j = sr + 32 * q; const float z = fast_exp2(lg2 * (float)(127 - j));
        const v4u kq = R.kw[q];
        v4u o; o.x = pk2(bflo(kq.x) * z, bfhi(kq.x) * z); o.y = pk2(bflo(kq.y) * z, bfhi(kq.y) * z); o.z = pk2(bflo(kq.z) * z, bfhi(kq.z) * z); o.w = pk2(bflo(kq.w) * z, bfhi(kq.w) * z);
        const int so = v_st(j & 63, sc);
        *(LAS v4u*)(ldsK + (j >> 6) * 16384 + so) = o;
        *(LAS v4u*)(ldsV + ((j >> 6) * 2 + 0) * 16384 + so) = R.vw[0][q];
        *(LAS v4u*)(ldsV + ((j >> 6) * 2 + 1) * 16384 + so) = R.vw[1][q]; }
    __syncthreads();
    if (next < NB * NH * NCHUNK) p2_kv_load(F, next, R);
    const int w = F.wave, r32 = F.lane & 31, hi = F.lane >> 5;
    const LAS unsigned char* pa = ldsV + v_rd_base(F.lane) + (w >> 2) * 16384 + (w & 3) * 512;
    const LAS unsigned char* pb = ldsK + v_rd_base(F.lane);
    f32x16 acc[4] = {};
#pragma unroll
    for (int jh = 0; jh < 2; ++jh)
#pragma unroll
        for (int ks = 0; ks < 4; ++ks) {
            const bf16x8 a = tr_frag(pa + jh * 32768 + ks * 4096);
#pragma unroll
            for (int dt = 0; dt < 4; ++dt) { const bf16x8 b = tr_frag(pb + jh * 16384 + dt * 512 + ks * 4096); acc[dt] = __builtin_amdgcn_mfma_f32_32x32x16_bf16(a, b, acc[dt], 0, 0, 0); }
        }
    bf16* outp = wsp<bf16>(F, WS_KVT) + (size_t)item * (RDV * HD);
#pragma unroll
    for (int dt = 0; dt < 4; ++dt)
#pragma unroll
        for (int r = 0; r < 16; ++r) { const float v = acc[dt][r], vn = __shfl_xor(v, 1);
            if ((r32 & 1) == 0) *(unsigned*)(outp + (size_t)(32 * w + crow(r, hi)) * HD + 32 * dt + r32) = pk2(v, vn); }
    __syncthreads();
}
__device__ __forceinline__ void p2_phase(Frame& F) {
    KvRegs R; int item = F.vcu;
    if (item < NB * NH * NCHUNK) p2_kv_load(F, item, R);
    if (F.wave == 0 && F.vcu < NB * NH) p2_cumsum(wsp<float>(F, WS_CUM) + (size_t)F.vcu * SKV, F.lane);
#ifdef P2_QKNORM
    p2_qknorm(F, F.vcu * 8 + F.wave, F.G * 8);
#endif
    for (; item < NB * NH * NCHUNK; item += F.G) p2_kv_item(F, item, item + F.G, R);
}
__device__ __forceinline__ void p3_scan(Frame& F) {
    const int gt = F.vcu * 512 + F.tid, NT = F.G * 512;
    const bf16* KVT = wsp<bf16>(F, WS_KVT); bf16* ST = wsp<bf16>(F, WS_ST);
    for (int g = gt; g < NB * NH * 4096; g += NT) {
        const int bh = g >> 12, off = (g & 4095) * 8, h = bh & (NH - 1);
        const float cd = fast_exp2(LG2GAM[h] * 128.f);
        const bf16* src = KVT + (size_t)bh * NCHUNK * 32768 + off;
        const int e_ = off >> 7, d0_ = off & 127;
        bf16* dst = ST + (size_t)bh * NCHUNK * 32768 + ((((e_ >> 7) * 4 + ((e_ >> 5) & 3)) * 8 + (d0_ >> 4)) * 64 + ((d0_ >> 3) & 1) * 32 + (e_ & 31)) * 8;
        float s[8] = {0.f, 0.f, 0.f, 0.f, 0.f, 0.f, 0.f, 0.f};
        for (int n0 = 0; n0 < NCHUNK; n0 += 8) {
            f32x4 a[8], b[8]; v4u raw[8];
#pragma unroll
            for (int u = 0; u < 8; ++u) raw[u] = *(const GAS v4u*)(src + (size_t)(n0 + u) * 32768);
#pragma unroll
            for (int u = 0; u < 8; ++u) { a[u] = (f32x4){bflo(raw[u].x), bfhi(raw[u].x), bflo(raw[u].y), bfhi(raw[u].y)}; b[u] = (f32x4){bflo(raw[u].z), bfhi(raw[u].z), bflo(raw[u].w), bfhi(raw[u].w)}; }
#pragma unroll
            for (int u = 0; u < 8; ++u) {
#pragma unroll
                for (int k = 0; k < 4; ++k) { s[k] = s[k] * cd + a[u][k]; s[4 + k] = s[4 + k] * cd + b[u][k]; }
                v4u o; o.x = pk2(s[0], s[1]); o.y = pk2(s[2], s[3]); o.z = pk2(s[4], s[5]); o.w = pk2(s[6], s[7]);
                *(GAS v4u*)(dst + (size_t)(n0 + u) * 32768) = o; }
        }
    }
}

namespace fox {
constexpr int D = 128, NW = 8, QBLK = 32, KVBLK = 64, QB = NW * QBLK;
constexpr int SHM_V = KVBLK * D * 2, SHM_K = KVBLK * D * 2;
constexpr int LDS_ATT = 2 * SHM_V + 2 * SHM_K + NW * 64 * 4;
constexpr float THR = 8.f;
constexpr int OSTRIDE = NH * HD;
#define KSWZ(row, colB) ((row) * 256 + ((colB) ^ (((row) & 7) << 4)))
constexpr int v_rd_off(int d0, int ks, int half) { return d0 * 512 + ks * 4096 + half * 2048; }
__device__ __forceinline__ bf16x8 load8(const bf16* p) { return *reinterpret_cast<const bf16x8*>(p); }
__device__ __forceinline__ void mask_tile(f32x16& p0, f32x16& p1, int dq) {
    const float NEG = -__builtin_inff();
#pragma unroll
    for (int r = 0; r < 16; ++r) {
        const int c = (r & 3) + 8 * (r >> 2);
        if (dq - c < 0) p0[r] = NEG;
        if (dq - c - 32 < 0) p1[r] = NEG;
    }
}
__device__ __forceinline__ void partialSM(f32x16& p0, f32x16& p1, float& m_reg, float& mn, float& alpha) {
    float pmax = p0[0];
#pragma unroll
    for (int r = 1; r < 16; ++r) pmax = fmaxf(pmax, p0[r]);
#pragma unroll
    for (int r = 0; r < 16; ++r) pmax = fmaxf(pmax, p1[r]);
    { auto rr = __builtin_amdgcn_permlane32_swap(__float_as_uint(pmax), __float_as_uint(pmax), false, false);
      pmax = fmaxf(__uint_as_float(rr[0]), __uint_as_float(rr[1])); }
    constexpr float C2 = 1.4426950408889634f;
    if (__builtin_expect(__all((pmax - m_reg) <= THR), 1)) { mn = m_reg; alpha = 1.f; }
    else { mn = fmaxf(m_reg, pmax); alpha = __builtin_amdgcn_exp2f((m_reg - mn) * C2); m_reg = mn; }
    const float mnL = -mn * C2;
#pragma unroll
    for (int r = 0; r < 16; ++r) p0[r] = fmaf(p0[r], C2, mnL);
#pragma unroll
    for (int r = 0; r < 16; ++r) p1[r] = fmaf(p1[r], C2, mnL);
#pragma unroll
    for (int r = 0; r < 16; ++r) p0[r] = __builtin_amdgcn_exp2f(p0[r]);
}
__device__ __forceinline__ void finishSM(f32x16& p0, f32x16& p1, float alpha, float& l_reg, bf16x8& pa0, bf16x8& pa1, bf16x8& pa2, bf16x8& pa3) {
#pragma unroll
    for (int r = 0; r < 16; ++r) p1[r] = __builtin_amdgcn_exp2f(p1[r]);
    float ps = 0;
#pragma unroll
    for (int r = 0; r < 16; ++r) ps += p0[r];
#pragma unroll
    for (int r = 0; r < 16; ++r) ps += p1[r];
    { auto rr = __builtin_amdgcn_permlane32_swap(__float_as_uint(ps), __float_as_uint(ps), false, false);
      ps = __uint_as_float(rr[0]) + __uint_as_float(rr[1]); }
    l_reg = l_reg * alpha + ps;
#define PK4(P, B_, OUT) do { unsigned a0 = cvtpk(P[B_+0], P[B_+1]), a1 = cvtpk(P[B_+2], P[B_+3]);                          \
        unsigned b0 = cvtpk(P[B_+4], P[B_+5]), b1 = cvtpk(P[B_+6], P[B_+7]);                                             \
        auto r0 = __builtin_amdgcn_permlane32_swap(a0, b0, false, false); auto r1 = __builtin_amdgcn_permlane32_swap(a1, b1, false, false); \
        v4u w = {r0[0], r1[0], r0[1], r1[1]}; OUT = *reinterpret_cast<bf16x8*>(&w); } while (0)
    PK4(p0, 0, pa0); PK4(p0, 8, pa1); PK4(p1, 0, pa2); PK4(p1, 8, pa3);
}
__device__ __forceinline__ void load_bias(f32x16& p0, f32x16& p1, __amdgpu_buffer_rsrc_t rs, int kb, int hi) {
    const int vo = hi * 16, so = kb * 4;
#pragma unroll
    for (int g = 0; g < 4; ++g) { const v4u x = __builtin_amdgcn_raw_buffer_load_b128(rs, vo, so + 32 * g, 0), y = __builtin_amdgcn_raw_buffer_load_b128(rs, vo, so + 32 * g + 128, 0);
        p0[4 * g] = __uint_as_float(x[0]); p0[4 * g + 1] = __uint_as_float(x[1]); p0[4 * g + 2] = __uint_as_float(x[2]); p0[4 * g + 3] = __uint_as_float(x[3]);
        p1[4 * g] = __uint_as_float(y[0]); p1[4 * g + 1] = __uint_as_float(y[1]); p1[4 * g + 2] = __uint_as_float(y[2]); p1[4 * g + 3] = __uint_as_float(y[3]); }
}
template <int KB>
__device__ __forceinline__ void qkt(f32x16& p0, f32x16& p1, const char* K_lds, int r32, int hi, const bf16x8* qr) {
    const char* kb[4];
#pragma unroll
    for (int dd = 0; dd < 4; ++dd) kb[dd] = K_lds + KB * SHM_K + KSWZ(r32, (dd * 16 + hi * 8) * 2);
#pragma unroll
    for (int d0 = 0; d0 < 8; ++d0) { const char* a = kb[d0 & 3] + (d0 >> 2) * 128;
        bf16x8 b0 = *reinterpret_cast<const bf16x8*>(a);
        bf16x8 b1 = *reinterpret_cast<const bf16x8*>(a + 32 * 256);
        p0 = __builtin_amdgcn_mfma_f32_32x32x16_bf16(b0, qr[d0], p0, 0, 0, 0);
        p1 = __builtin_amdgcn_mfma_f32_32x32x16_bf16(b1, qr[d0], p1, 0, 0, 0); }
}
template <int VB>
__device__ __forceinline__ void pv_tile(f32x16* o, int vb0, bf16x8 pa0, bf16x8 pa1, bf16x8 pa2, bf16x8 pa3) {
#define TRRD(dst, off) asm volatile("ds_read_b64_tr_b16 %0, %1 offset:%2" : "=&v"(dst) : "v"(vb0), "i"(off) : "memory")
#define PV_D0(d0) do { s16x4 l0, l1, l2, l3, h0, h1, h2, h3; constexpr int b_ = VB * SHM_V + v_rd_off(d0, 0, 0); \
        TRRD(l0, b_); TRRD(h0, b_ + 2048); TRRD(l1, b_ + 4096); TRRD(h1, b_ + 6144); TRRD(l2, b_ + 8192); TRRD(h2, b_ + 10240); TRRD(l3, b_ + 12288); TRRD(h3, b_ + 14336); \
        asm volatile("s_waitcnt lgkmcnt(0)" ::: "memory"); SBAR();   \
        o[d0] = __builtin_amdgcn_mfma_f32_32x32x16_bf16(pa0, (bf16x8){l0[0], l0[1], l0[2], l0[3], h0[0], h0[1], h0[2], h0[3]}, o[d0], 0, 0, 0);   \
        o[d0] = __builtin_amdgcn_mfma_f32_32x32x16_bf16(pa1, (bf16x8){l1[0], l1[1], l1[2], l1[3], h1[0], h1[1], h1[2], h1[3]}, o[d0], 0, 0, 0);   \
        o[d0] = __builtin_amdgcn_mfma_f32_32x32x16_bf16(pa2, (bf16x8){l2[0], l2[1], l2[2], l2[3], h2[0], h2[1], h2[2], h2[3]}, o[d0], 0, 0, 0);   \
        o[d0] = __builtin_amdgcn_mfma_f32_32x32x16_bf16(pa3, (bf16x8){l3[0], l3[1], l3[2], l3[3], h3[0], h3[1], h3[2], h3[3]}, o[d0], 0, 0, 0); } while (0)
    PV_D0(0); PV_D0(1); PV_D0(2); PV_D0(3);
#undef PV_D0
#undef TRRD
}
struct BlockRef { const bf16* Q; const bf16* K; const bf16* V; bf16* O; const float* Bz; int P0; };
struct Seam { bf16x8 qr[8]; bf16x8 st_v0, st_v1, st_k0, st_k1; };
#define VMW() asm volatile("s_waitcnt vmcnt(0)" ::: "memory")
#define VMWN(n) asm volatile("s_waitcnt vmcnt(%0)" :: "i"(n) : "memory")
#define BL16(rs, so) __builtin_bit_cast(bf16x8, __builtin_amdgcn_raw_buffer_load_b128(rs, lkvB, (so), 0))
#define SLOAD_H(rK, rV, k0) do { S.st_v0 = BL16(rV, (k0) * (D * 2)); S.st_v1 = BL16(rV, ((k0) + 32) * (D * 2));              \
                         S.st_k0 = BL16(rK, (k0) * (D * 2)); S.st_k1 = BL16(rK, ((k0) + 32) * (D * 2)); } while (0)
#define SWRITE_HK(bf) do { *(bf16x8*)(K_lds + (bf) * SHM_K + kws) = S.st_k0; *(bf16x8*)(K_lds + (bf) * SHM_K + kws + 32 * 256) = S.st_k1; } while (0)
#define SWRITE_HV(bf) do { *(bf16x8*)(V_lds + (bf) * SHM_V + vst0) = S.st_v0; *(bf16x8*)(V_lds + (bf) * SHM_V + vst1) = S.st_v1; } while (0)
#define SWRITE_H(bf) do { SWRITE_HV(bf); SWRITE_HK(bf); } while (0)
__device__ __forceinline__ void attn_prime(const BlockRef& cur, char* lds, Seam& S) {
    const int tid = threadIdx.x, wid = __builtin_amdgcn_readfirstlane(tid >> 6), lane = tid & 63, r32 = lane & 31, hi = lane >> 5;
    const int sr = tid >> 4, sc = (tid & 15) * 8, kws = KSWZ(sr, sc * 2); char* K_lds = lds + 2 * SHM_V; const int lkvB = (sr * D + sc) * 2;
    const __amdgpu_buffer_rsrc_t rsK = __builtin_amdgcn_make_buffer_rsrc((void*)cur.K, 0, SKV * D * 2, 0x00020000), rsV = __builtin_amdgcn_make_buffer_rsrc((void*)cur.V, 0, SKV * D * 2, 0x00020000);
    { const bf16* qp = (cur.Q + (size_t)(wid * QBLK) * D) + (unsigned)(r32 * D + hi * 8);
#pragma unroll
      for (int d0 = 0; d0 < 8; ++d0) S.qr[d0] = load8(qp + d0 * 16); }
    SLOAD_H(rsK, rsV, 0); VMW(); SWRITE_HK(0);
    __syncthreads();
}
__device__ __forceinline__ void attn_block(const BlockRef& cur, int skv, char* lds, Seam& S) {
    const int tid = threadIdx.x, wid = __builtin_amdgcn_readfirstlane(tid >> 6), lane = tid & 63, r32 = lane & 31, hi = lane >> 5;
    int j_hi = (cur.P0 + QB - 1) / KVBLK + 1; if (j_hi > skv / KVBLK) j_hi = skv / KVBLK;
    const int NT = j_hi;
    const int qlo = cur.P0 + wid * QBLK, qm = qlo + r32 - 4 * hi;
    char* V_lds = lds; char* K_lds = lds + 2 * SHM_V;
    float* ws = (float*)(lds + 2 * SHM_V + 2 * SHM_K) + wid * 64; float* li_l = ws, * al_l = ws + 32;
    float m_reg = -1e30f, l_reg = 0; f32x16 o[4] = {};
    const int sr = tid >> 4, sc = (tid & 15) * 8, vst0 = v_st(sr, sc), vst1 = v_st(32 + sr, sc), kws = KSWZ(sr, sc * 2); const int lkvB = (sr * D + sc) * 2;
    const int vb0 = (int)(uintptr_t)V_lds + v_rd_base(lane);
    const __amdgpu_buffer_rsrc_t Kh = __builtin_amdgcn_make_buffer_rsrc((void*)cur.K, 0, SKV * D * 2, 0x00020000), Vh = __builtin_amdgcn_make_buffer_rsrc((void*)cur.V, 0, SKV * D * 2, 0x00020000);
    const __amdgpu_buffer_rsrc_t Bz = __builtin_amdgcn_make_buffer_rsrc((void*)cur.Bz, 0, SKV * 4, 0x00020000);
#define RESC(a) do { if (__any((a) < 1.f)) { if (hi == 0) al_l[r32] = (a); asm volatile("s_waitcnt lgkmcnt(0)" ::: "memory");              \
                     for (int d_ = 0; d_ < 4; ++d_) for (int r = 0; r < 16; ++r) o[d_][r] *= al_l[crow(r, hi)]; } } while (0)
#define KBASE(t) ((t) * KVBLK)
#define MASKT(P0_, P1_, t) do { const int kb_ = KBASE(t); if (kb_ + KVBLK - 1 > qlo) mask_tile(P0_, P1_, qm - kb_); } while (0)
    f32x16 pA0, pA1, pB0, pB1; float mnA, mnB, alA, alB; bf16x8 pa0, pa1, pa2, pa3;
    SWRITE_HV(0); SBAR();
    load_bias(pA0, pA1, Bz, KBASE(0), hi);
    if (NT > 1) { load_bias(pB0, pB1, Bz, KBASE(1), hi); SLOAD_H(Kh, Vh, KBASE(1)); }
    SBAR(); qkt<0>(pA0, pA1, K_lds, r32, hi, S.qr);
    MASKT(pA0, pA1, 0); partialSM(pA0, pA1, m_reg, mnA, alA);
    if (NT > 1) { VMW(); SWRITE_H(1); }
    __syncthreads();
#define HALF_STEP(PX0, PX1, mnX, alX, PY0, PY1, alY, t, KB, VB, SB) do {                                                      \
        SBAR(); qkt<KB>(PX0, PX1, K_lds, r32, hi, S.qr);                                                                      \
        finishSM(PY0, PY1, alY, l_reg, pa0, pa1, pa2, pa3); SBAR();                                                           \
        if ((t) + 1 < NT) { load_bias(PY0, PY1, Bz, KBASE((t) + 1), hi); SLOAD_H(Kh, Vh, KBASE((t) + 1)); SBAR(); }            \
        pv_tile<VB>(o, vb0, pa0, pa1, pa2, pa3); MASKT(PX0, PX1, (t)); partialSM(PX0, PX1, m_reg, mnX, alX);                  \
        __syncthreads();                                                                                                      \
        if ((t) + 1 < NT) { VMW(); SWRITE_H(SB); }                                                                            \
        RESC(alX); __syncthreads(); } while (0)
    for (int t = 1; t + 1 < NT; t += 2) {
        HALF_STEP(pB0, pB1, mnB, alB, pA0, pA1, alA, t, 1, 0, 0);
        HALF_STEP(pA0, pA1, mnA, alA, pB0, pB1, alB, t + 1, 0, 1, 1);
    }
    const bool even = (NT & 1) == 0;
    if (even) { SBAR(); qkt<1>(pB0, pB1, K_lds, r32, hi, S.qr); SBAR(); }
    finishSM(pA0, pA1, alA, l_reg, pa0, pa1, pa2, pa3); SBAR();
    pv_tile<0>(o, vb0, pa0, pa1, pa2, pa3);
    if (even) { MASKT(pB0, pB1, NT - 1); partialSM(pB0, pB1, m_reg, mnB, alB); __syncthreads(); RESC(alB);
        finishSM(pB0, pB1, alB, l_reg, pa0, pa1, pa2, pa3); SBAR(); pv_tile<1>(o, vb0, pa0, pa1, pa2, pa3); }
    SBAR();
    if (hi == 0) li_l[r32] = l_reg; asm volatile("s_waitcnt lgkmcnt(0)" ::: "memory");
    float rli[16];
#pragma unroll
    for (int r = 0; r < 16; ++r) rli[r] = __builtin_amdgcn_rcpf(li_l[crow(r, hi)]);
    unsigned char* const Ow = (unsigned char*)(cur.O + (size_t)(wid * QBLK) * OSTRIDE); const unsigned lo_ = (unsigned)((4 * hi * OSTRIDE + r32) * 2);
#pragma unroll
    for (int r = 0; r < 16; ++r) { const int orow = crow(r, hi);
#pragma unroll
        for (int d0 = 0; d0 < 4; ++d0) { const float v = o[d0][r] * rli[r];
            const float vn = __shfl_xor(v, 1);
            if ((r32 & 1) == 0) *(unsigned*)((Ow + (size_t)((((r & 3) + 8 * (r >> 2)) * OSTRIDE + d0 * 32) * 2)) + lo_) = cvtpk(v, vn); } }
    __syncthreads();
#undef RESC
#undef KBASE
#undef MASKT
#undef HALF_STEP
}
#undef BL16
#undef VMW
#undef VMWN
#undef SLOAD_H
#undef SWRITE_HK
#undef SWRITE_HV
#undef SWRITE_H
#undef PK4
#undef KSWZ
}

__device__ __forceinline__ fox::BlockRef attn_ref(const Frame& F, int L, int pass) {
    const int bh = L >> 4, x = L & 15, qb = pass ? 31 - x : x, b = bh >> 4, h = bh & 15;
    fox::BlockRef r;
    r.Q = wsp<bf16>(F, WS_QA) + ((size_t)bh * SEQ + (size_t)qb * 256) * HD;
    r.K = wsp<bf16>(F, WS_KA) + (size_t)bh * SKV * HD; r.V = wsp<bf16>(F, WS_VA) + (size_t)bh * SKV * HD;
    r.O = wsp<bf16>(F, WS_YA) + ((size_t)b * SEQ + (size_t)qb * 256) * (NH * HD) + h * HD;
    r.Bz = wsp<float>(F, WS_CUM) + (size_t)bh * SKV; r.P0 = 64 + qb * 256;
    return r;
}
__device__ __forceinline__ void p3_attention(Frame& F, char* ldsg) {
    constexpr int TOTAL = NB * NH * 16;
    char* lds = ldsg + RING_OFF;
    for (int L = F.vcu; L < TOTAL; L += F.G)
#pragma unroll 1
        for (int pass = 0; pass < 2; ++pass) {
            const fox::BlockRef cur = attn_ref(F, L, pass);
            fox::Seam S;
            fox::attn_prime(cur, lds, S);
            fox::attn_block(cur, SKV, lds, S);
        }
}
template <int B_> __device__ __forceinline__ bf16x8 pk4(const f32x16& P) {
    unsigned a0 = cvtpk(P[B_ + 0], P[B_ + 1]), a1 = cvtpk(P[B_ + 2], P[B_ + 3]), b0 = cvtpk(P[B_ + 4], P[B_ + 5]), b1 = cvtpk(P[B_ + 6], P[B_ + 7]);
    auto r0 = __builtin_amdgcn_permlane32_swap(a0, b0, false, false); auto r1 = __builtin_amdgcn_permlane32_swap(a1, b1, false, false);
    v4u w = {r0[0], r1[0], r0[1], r1[1]}; return *reinterpret_cast<bf16x8*>(&w);
}
#define RKSWZ(row, colB) ((row) * 256 + ((colB) ^ (((row) & 7) << 4)))
struct RetRegs { v4u vw[2][4], kw[4]; };
__device__ __forceinline__ void p4_ret_load(Frame& F, int item, RetRegs& R) {
    const int bh = item >> 6, c = (item & 63) + 1;
    const bf16* Kg = wsp<bf16>(F, WS_KR) + ((size_t)bh * LR + 128 * c) * HD;
    const bf16* Vg = wsp<bf16>(F, WS_VR) + ((size_t)bh * LR + 128 * c) * RDV;
    int tid_ = F.tid; asm volatile("" : "+v"(tid_));
    const int sr = tid_ >> 4, sc = (tid_ & 15) * 8;
#pragma unroll
    for (int q = 0; q < 4; ++q) { const int j = sr + 32 * q; R.vw[0][q] = *(const GAS v4u*)(Vg + (size_t)j * RDV + sc); R.vw[1][q] = *(const GAS v4u*)(Vg + (size_t)j * RDV + 128 + sc); R.kw[q] = *(const GAS v4u*)(Kg + (size_t)j * HD + sc); }
}
__device__ __forceinline__ void p4_ret_item(Frame& F, int item, int next, RetRegs& R) {
    const int bh = item >> 6, c = (item & 63) + 1, b = bh >> 4, h = bh & (NH - 1);
    const float lg2 = LG2GAM[h];
    const bf16* Qg = wsp<bf16>(F, WS_QR) + ((size_t)bh * LR + 128 * c) * HD;
    const bf16* STg = wsp<bf16>(F, WS_ST) + ((size_t)bh * NCHUNK + (c - 1)) * 32768;
    LAS unsigned char* ldsV = F.lds; LAS unsigned char* ldsK = F.lds + 65536; LAS f32x2* stats = (LAS f32x2*)(F.lds + 98304);
    const int sr = F.tid >> 4, sc = (F.tid & 15) * 8;
    const int w = F.wave, ib = w & 3, eh = w >> 2, r32 = F.lane & 31, hi = F.lane >> 5;
    bf16x8 qr[8], sa[4][4];
#pragma unroll
    for (int ks = 0; ks < 8; ++ks) qr[ks] = *(const GAS bf16x8*)(Qg + (size_t)(32 * ib + r32) * HD + 16 * ks + 8 * hi);
    const bf16* STl = STg + (size_t)eh * 16384 + F.lane * 8;
#pragma unroll
    for (int ks = 0; ks < 4; ++ks)
#pragma unroll
        for (int et = 0; et < 4; ++et) sa[ks][et] = *(const GAS bf16x8*)(STl + (et * 8 + ks) * 512);
#pragma unroll
    for (int q = 0; q < 4; ++q) { const int j = sr + 32 * q, so = v_st(j & 63, sc);
        *(LAS v4u*)(ldsV + ((j >> 6) * 2 + 0) * 16384 + so) = R.vw[0][q]; *(LAS v4u*)(ldsV + ((j >> 6) * 2 + 1) * 16384 + so) = R.vw[1][q];
        *(LAS v4u*)(ldsK + (j >> 6) * 16384 + RKSWZ(j & 63, sc * 2)) = R.kw[q]; }
    __syncthreads();
    if (next < NB * NH * NCHUNK) p4_ret_load(F, next, R);
    f32x16 acc[4] = {};
#pragma unroll
    for (int ks = 0; ks < 4; ++ks)
#pragma unroll
        for (int et = 0; et < 4; ++et) acc[et] = __builtin_amdgcn_mfma_f32_32x32x16_bf16(sa[ks][et], qr[ks], acc[et], 0, 0, 0);
#pragma unroll
    for (int ks = 0; ks < 4; ++ks)
#pragma unroll
        for (int et = 0; et < 4; ++et) sa[ks][et] = *(const GAS bf16x8*)(STl + (et * 8 + ks + 4) * 512);
#pragma unroll
    for (int ks = 0; ks < 4; ++ks)
#pragma unroll
        for (int et = 0; et < 4; ++et) acc[et] = __builtin_amdgcn_mfma_f32_32x32x16_bf16(sa[ks][et], qr[ks + 4], acc[et], 0, 0, 0);
    { const float xi = fast_exp2(lg2 * (float)(32 * ib + r32 + 1));
#pragma unroll
      for (int et = 0; et < 4; ++et)
#pragma unroll
          for (int r = 0; r < 16; ++r) acc[et][r] *= xi; }
    const LAS unsigned char* pv = ldsV + v_rd_base(F.lane) + eh * 16384;
    for (int jt = 0; jt <= ib; ++jt) {
        f32x16 p = {};
        const LAS unsigned char* kp = ldsK + (jt >> 1) * 16384;
        const int krow = (jt & 1) * 32 + r32;
#pragma unroll
        for (int ks = 0; ks < 8; ++ks) { const bf16x8 a = *(const LAS bf16x8*)(kp + RKSWZ(krow, (16 * ks + 8 * hi) * 2));
            p = __builtin_amdgcn_mfma_f32_32x32x16_bf16(a, qr[ks], p, 0, 0, 0); }
        const int ibase = 32 * ib + r32 - 32 * jt - 4 * hi;
#pragma unroll
        for (int r = 0; r < 16; ++r) { const int dl = ibase - ((r & 3) + 8 * (r >> 2)); p[r] = dl >= 0 ? p[r] * fast_exp2(lg2 * (float)dl) : 0.f; }
        const bf16x8 pa0 = pk4<0>(p), pa1 = pk4<8>(p);
        const LAS unsigned char* pvj = pv + (jt >> 1) * 32768 + (jt & 1) * 8192;
#pragma unroll
        for (int et = 0; et < 4; ++et) { const bf16x8 a0 = tr_frag(pvj + et * 512), a1 = tr_frag(pvj + et * 512 + 4096);
            acc[et] = __builtin_amdgcn_mfma_f32_32x32x16_bf16(a0, pa0, acc[et], 0, 0, 0);
            acc[et] = __builtin_amdgcn_mfma_f32_32x32x16_bf16(a1, pa1, acc[et], 0, 0, 0); }
    }
    const size_t tok = (size_t)b * SEQ + 128 * (c - 1) + 32 * ib + r32;
    const bf16* GRp = wsp<bf16>(F, WS_GR) + tok * DM + h * RDV + 128 * eh + 4 * hi;
    v2u gt[4][4];
#pragma unroll
    for (int et = 0; et < 4; ++et)
#pragma unroll
        for (int g4 = 0; g4 < 4; ++g4) gt[et][g4] = *(const GAS v2u*)(GRp + 32 * et + 8 * g4);
    float s1 = 0.f, s2 = 0.f;
#pragma unroll
    for (int et = 0; et < 4; ++et)
#pragma unroll
        for (int r = 0; r < 16; ++r) { s1 += acc[et][r]; s2 += acc[et][r] * acc[et][r]; }
    s1 += __shfl_xor(s1, 32); s2 += __shfl_xor(s2, 32);
    if (hi == 0) stats[eh * 128 + 32 * ib + r32] = (f32x2){s1, s2};
    __syncthreads();
    const f32x2 sa_ = stats[32 * ib + r32], sb_ = stats[128 + 32 * ib + r32];
    const float mean = (sa_.x + sb_.x) * (1.f / RDV), var = fmaxf((sa_.y + sb_.y) * (1.f / RDV) - mean * mean, 0.f), rstd = 1.f / sqrtf(var + EPS);
    bf16* YRp = wsp<bf16>(F, WS_YR) + tok * DM + h * RDV + 128 * eh + 4 * hi;
    const float* gp = F.g_ret + h * RDV + 128 * eh + 4 * hi;
#pragma unroll
    for (int et = 0; et < 4; ++et)
#pragma unroll
        for (int g4 = 0; g4 < 4; ++g4) { const int eo = 32 * et + 8 * g4;
            const f32x4 gn = *(const GAS f32x4*)(gp + eo); const v2u g2 = gt[et][g4];
            const float o0 = (acc[et][4 * g4 + 0] - mean) * rstd * gn[0] * bflo(g2.x), o1 = (acc[et][4 * g4 + 1] - mean) * rstd * gn[1] * bfhi(g2.x);
            const float o2 = (acc[et][4 * g4 + 2] - mean) * rstd * gn[2] * bflo(g2.y), o3 = (acc[et][4 * g4 + 3] - mean) * rstd * gn[3] * bfhi(g2.y);
            v2u ov; ov.x = pk2(o0, o1); ov.y = pk2(o2, o3); *(GAS v2u*)(YRp + eo) = ov; }
    __syncthreads();
}
__device__ __forceinline__ void p4_phase(Frame& F) {
    RetRegs R; int item = F.vcu;
    if (item < NB * NH * NCHUNK) p4_ret_load(F, item, R);
    for (; item < NB * NH * NCHUNK; item += F.G) p4_ret_item(F, item, item + F.G, R);
}
__device__ __forceinline__ int f2key(float x) { const int i = __float_as_int(x); return i ^ ((i >> 31) & 0x7fffffff); }
__device__ __forceinline__ float key2f(int k) { return __int_as_float(k ^ ((k >> 31) & 0x7fffffff)); }
__device__ __forceinline__ int imax(int a, int b) { return a > b ? a : b; }
__device__ __forceinline__ int imin(int a, int b) { return a < b ? a : b; }
__device__ __forceinline__ void ins16(int (&a)[16], int x) {
#pragma unroll
    for (int i = 0; i < 16; ++i) { const int t = imax(a[i], x); x = imin(a[i], x); a[i] = t; }
}
__device__ __forceinline__ void merge_partner16(int (&a)[16]) {
    int c[16];
#pragma unroll
    for (int i = 0; i < 16; ++i) c[i] = __shfl_xor(a[15 - i], 32);
#pragma unroll
    for (int i = 0; i < 16; ++i) c[i] = imax(a[i], c[i]);
#pragma unroll
    for (int st = 8; st >= 1; st >>= 1)
#pragma unroll
        for (int i = 0; i < 16; ++i) if (!(i & st)) { const int hi_ = imax(c[i], c[i + st]), lo_ = imin(c[i], c[i + st]); c[i] = hi_; c[i + st] = lo_; }
#pragma unroll
    for (int i = 0; i < 16; ++i) a[i] = c[i];
}
struct CandTab { int a[50], b[50]; };
constexpr CandTab make_cands() { CandTab t{}; int n = 0; for (int a = 0; a < 16; ++a) for (int b = 0; b < 16; ++b) if ((a + 1) * (b + 1) <= 16) { t.a[n] = a; t.b[n] = b; ++n; } return t; }
constexpr CandTab CANDS = make_cands();

__device__ __forceinline__ void p9_unit(Frame& F, int unit) {
    const int tt = unit >> 3, h = unit & 7;
    int lane_ = F.lane; asm volatile("" : "+v"(lane_));
    const int w = F.wave, r32 = lane_ & 31, hi = lane_ >> 5;
    const int t = tt * 256 + 32 * w + r32;
    const bf16* QPp = wsp<bf16>(F, WS_QP) + (size_t)t * PQ + h * 256 + 8 * hi;
    const bf16* KB = wsp<bf16>(F, WS_KEYS);
    LAS int* mylds = (LAS int*)(F.lds + RING_OFF) + (size_t)F.tid * 32;
#pragma unroll 1
    for (int half = 0; half < 2; ++half) {
        bf16x8 qf[8];
#pragma unroll
        for (int ks = 0; ks < 8; ++ks) qf[ks] = *(const GAS bf16x8*)(QPp + half * 128 + 16 * ks);
        int top[16];
#pragma unroll
        for (int i = 0; i < 16; ++i) top[i] = (int)0x80000000;
        const bf16* Kh = KB + ((size_t)half * PH + h) * PK * 128 + (size_t)r32 * 128 + 8 * hi;
#pragma unroll 1
        for (int nt = 0; nt < 4; ++nt) {
            f32x16 p = {};
#pragma unroll
            for (int ks = 0; ks < 8; ++ks) { const bf16x8 a = *(const GAS bf16x8*)(Kh + (size_t)nt * 32 * 128 + 16 * ks); p = __builtin_amdgcn_mfma_f32_32x32x16_bf16(a, qf[ks], p, 0, 0, 0); }
            const int nb = 32 * nt + 4 * hi;
#pragma unroll
            for (int r = 0; r < 16; ++r) { const int n = nb + (r & 3) + 8 * (r >> 2); ins16(top, (f2key(p[r]) & ~127) | n); }
        }
        merge_partner16(top);
#pragma unroll
        for (int i = 0; i < 4; ++i) *(LAS v4u*)(mylds + half * 16 + 4 * i) = (v4u){(unsigned)top[4 * i], (unsigned)top[4 * i + 1], (unsigned)top[4 * i + 2], (unsigned)top[4 * i + 3]};
    }
    float f1[16], f2[16];
#pragma unroll
    for (int i = 0; i < 4; ++i) { const v4u a = *(LAS v4u*)(mylds + 4 * i), b = *(LAS v4u*)(mylds + 16 + 4 * i);
#pragma unroll
        for (int k = 0; k < 4; ++k) { f1[4 * i + k] = key2f((int)a[k] & ~127); f2[4 * i + k] = key2f((int)b[k] & ~127); } }
    int fin[16];
#pragma unroll
    for (int i = 0; i < 16; ++i) fin[i] = (int)0x80000000;
#pragma unroll
    for (int s = 0; s < 25; ++s) {
        const float ve = f1[CANDS.a[2 * s]] + f2[CANDS.b[2 * s]], vo = f1[CANDS.a[2 * s + 1]] + f2[CANDS.b[2 * s + 1]];
        const int ie = (CANDS.a[2 * s] << 4) | CANDS.b[2 * s], io = (CANDS.a[2 * s + 1] << 4) | CANDS.b[2 * s + 1];
        const float v = hi ? vo : ve; const int id = hi ? io : ie;
        ins16(fin, (f2key(v) & ~255) | id);
    }
    merge_partner16(fin);
    float sv[16], e[16]; float den = 0.f;
#pragma unroll
    for (int i = 0; i < 16; ++i) sv[i] = key2f(fin[i] & ~255);
#pragma unroll
    for (int i = 0; i < 16; ++i) { e[i] = fast_exp2((sv[i] - sv[0]) * 1.4426950408889634f); den += e[i]; }
    const float rden = 1.f / den;
    int eid[8]; float gw[8];
#pragma unroll
    for (int k = 0; k < 8; ++k) { const int key = hi ? fin[8 + k] : fin[k]; const int a = (key >> 4) & 15, b = key & 15;
        const int n1 = mylds[a] & 127, n2 = mylds[16 + b] & 127; eid[k] = n1 * PK + n2; gw[k] = (hi ? e[8 + k] : e[k]) * rden; }
    int* EIDp = wsp<int>(F, WS_EID) + (size_t)t * 128 + h * 16 + 8 * hi; float* GWp = wsp<float>(F, WS_GW) + (size_t)t * 128 + h * 16 + 8 * hi;
    *(GAS v4u*)EIDp = (v4u){(unsigned)eid[0], (unsigned)eid[1], (unsigned)eid[2], (unsigned)eid[3]}; *(GAS v4u*)(EIDp + 4) = (v4u){(unsigned)eid[4], (unsigned)eid[5], (unsigned)eid[6], (unsigned)eid[7]};
    *(GAS f32x4*)GWp = (f32x4){gw[0], gw[1], gw[2], gw[3]}; *(GAS f32x4*)(GWp + 4) = (f32x4){gw[4], gw[5], gw[6], gw[7]};
}
__device__ __forceinline__ void p9_phase(Frame& F) {
    for (int unit = F.vcu; unit < (MTOK / 256) * PH; unit += F.G) p9_unit(F, unit);
}
#ifndef P10_SORT
#define P10_SORT 1
#endif
#ifndef P10_AUX
#define P10_AUX 0
#endif
typedef __amdgpu_buffer_rsrc_t rsrc_t;
typedef unsigned v6u __attribute__((ext_vector_type(6)));
typedef float f32x32 __attribute__((ext_vector_type(32)));
#ifndef FPB
#define FPB 4
#endif
constexpr int ROWB = DM * FPB / 8, ROWCH = ROWB / 1024;
constexpr float FPMAX = FPB == 6 ? 7.5f : 6.0f;
__device__ __forceinline__ rsrc_t mk_rsrc(const void* p, unsigned bytes) { return __builtin_amdgcn_make_buffer_rsrc((void*)p, 0, bytes, 0x00020000); }
__device__ __forceinline__ void load_row8(v4u (&r)[ROWCH], rsrc_t rs, int lane16, int e) {
    const int so = e * ROWB;
#pragma unroll
    for (int j = 0; j < ROWCH; ++j) r[j] = __builtin_amdgcn_raw_buffer_load_b128(rs, lane16, so + j * 1024, P10_AUX);
}
#define D2(d, i) ((f32x2){d[2 * (i)], d[2 * (i) + 1]})
#if FPB == 6
#define DEC6A(r) __builtin_amdgcn_cvt_scalef32_pk32_f32_fp6((v6u){r[0][0], r[0][1], r[0][2], r[0][3], r[1][0], r[1][1]}, 1.0f)
#define DEC6B(r) __builtin_amdgcn_cvt_scalef32_pk32_f32_fp6((v6u){r[1][2], r[1][3], r[2][0], r[2][1], r[2][2], r[2][3]}, 1.0f)
__device__ __forceinline__ float dot_row8(const v4u (&r)[ROWCH], const f32x2 (&x)[32]) {
    f32x2 a0 = {0.f, 0.f}, a1 = {0.f, 0.f};
    { const f32x32 d = DEC6A(r);
#pragma unroll
      for (int i = 0; i < 16; i += 2) { a0 = __builtin_elementwise_fma(D2(d, i), x[i], a0); a1 = __builtin_elementwise_fma(D2(d, i + 1), x[i + 1], a1); asm volatile("" : "+v"(a0), "+v"(a1)); } }
    { const f32x32 d = DEC6B(r);
#pragma unroll
      for (int i = 0; i < 16; i += 2) { a0 = __builtin_elementwise_fma(D2(d, i), x[16 + i], a0); a1 = __builtin_elementwise_fma(D2(d, i + 1), x[16 + i + 1], a1); asm volatile("" : "+v"(a0), "+v"(a1)); } }
    return (a0.x + a0.y) + (a1.x + a1.y);
}
__device__ __forceinline__ void axpy_row8(f32x2 (&acc)[32], const v4u (&r)[ROWCH], float w) {
    const f32x2 ww = {w, w};
    { const f32x32 d = DEC6A(r);
#pragma unroll
      for (int i = 0; i < 16; ++i) { acc[i] = __builtin_elementwise_fma(ww, D2(d, i), acc[i]); asm volatile("" : "+v"(acc[i])); } }
    { const f32x32 d = DEC6B(r);
#pragma unroll
      for (int i = 0; i < 16; ++i) { acc[16 + i] = __builtin_elementwise_fma(ww, D2(d, i), acc[16 + i]); asm volatile("" : "+v"(acc[16 + i])); } }
}
#else
#define DEC4(w, b) __builtin_amdgcn_cvt_scalef32_pk_f32_fp4((w), 1.0f, (b))
__device__ __forceinline__ float dot_row8(const v4u (&r)[ROWCH], const f32x2 (&x)[32]) {
    f32x2 a0 = {0.f, 0.f}, a1 = {0.f, 0.f};
#pragma unroll
    for (int j = 0; j < 2; ++j)
#pragma unroll
        for (int d = 0; d < 4; ++d) { const unsigned w = r[j][d];
            a0 = __builtin_elementwise_fma(DEC4(w, 0), x[16 * j + 4 * d], a0); a1 = __builtin_elementwise_fma(DEC4(w, 1), x[16 * j + 4 * d + 1], a1);
            a0 = __builtin_elementwise_fma(DEC4(w, 2), x[16 * j + 4 * d + 2], a0); a1 = __builtin_elementwise_fma(DEC4(w, 3), x[16 * j + 4 * d + 3], a1);
            asm volatile("" : "+v"(a0), "+v"(a1)); }
    return (a0.x + a0.y) + (a1.x + a1.y);
}
__device__ __forceinline__ void axpy_row8(f32x2 (&acc)[32], const v4u (&r)[ROWCH], float w_) {
    const f32x2 ww = {w_, w_};
#pragma unroll
    for (int j = 0; j < 2; ++j)
#pragma unroll
        for (int d = 0; d < 4; ++d) { const unsigned w = r[j][d]; const int i = 16 * j + 4 * d;
            acc[i] = __builtin_elementwise_fma(ww, DEC4(w, 0), acc[i]); acc[i + 1] = __builtin_elementwise_fma(ww, DEC4(w, 1), acc[i + 1]);
            acc[i + 2] = __builtin_elementwise_fma(ww, DEC4(w, 2), acc[i + 2]); acc[i + 3] = __builtin_elementwise_fma(ww, DEC4(w, 3), acc[i + 3]);
            asm volatile("" : "+v"(acc[i]), "+v"(acc[i + 1]), "+v"(acc[i + 2]), "+v"(acc[i + 3])); }
}
#endif
__device__ __forceinline__ int imin_(int a, int b) { return a < b ? a : b; }
__device__ __forceinline__ float gelu1(float v) {
    const float av = __builtin_fabsf(v), t = fast_rcp(av * 0.2316418882f + 1.0f);
    float q = t * 0.5307027145f + (-0.7265760135f); q = q * t + 0.7107068705f; q = q * t + (-0.142248368f); q = q * t + 0.127414796f; q = q * t;
    const float e = fast_exp2((v * v) * (-0.72134752044f)), m = v * (q * e);
    return v < 0.f ? m : v - m;
}
__device__ __forceinline__ float red8(float p0, float p1, float p2, float p3, float p4, float p5, float p6, float p7, int lane) {
    const bool b0 = lane & 1, b1 = lane & 2, b2 = lane & 4;
    const float q0 = (b0 ? p1 : p0) + __shfl_xor(b0 ? p0 : p1, 1), q1 = (b0 ? p3 : p2) + __shfl_xor(b0 ? p2 : p3, 1);
    const float q2 = (b0 ? p5 : p4) + __shfl_xor(b0 ? p4 : p5, 1), q3 = (b0 ? p7 : p6) + __shfl_xor(b0 ? p6 : p7, 1);
    const float r0 = (b1 ? q1 : q0) + __shfl_xor(b1 ? q0 : q1, 2), r1 = (b1 ? q3 : q2) + __shfl_xor(b1 ? q2 : q3, 2);
    float s = (b2 ? r1 : r0) + __shfl_xor(b2 ? r0 : r1, 4);
    s += __shfl_xor(s, 8); s += __shfl_xor(s, 16); s += __shfl_xor(s, 32);
    return s;
}
#define RLI(v, k) __builtin_amdgcn_readlane((v), (k))
__device__ __forceinline__ float rlf(float v, int k) { return __int_as_float(__builtin_amdgcn_readlane(__float_as_int(v), k)); }
#if FPB == 6
__device__ __forceinline__ float u_half(const f32x2 (&x)[32], rsrc_t rs, int lane16, int ev, int lane) {
    float a = 0.f;
    v4u R0[ROWCH], R1[ROWCH], R2[ROWCH], R3[ROWCH], R4[ROWCH], R5[ROWCH], R6[ROWCH], R7[ROWCH];
    load_row8(R0, rs, lane16, RLI(ev, 0)); load_row8(R1, rs, lane16, RLI(ev, 1)); load_row8(R2, rs, lane16, RLI(ev, 2)); load_row8(R3, rs, lane16, RLI(ev, 3)); load_row8(R4, rs, lane16, RLI(ev, 4)); load_row8(R5, rs, lane16, RLI(ev, 5)); load_row8(R6, rs, lane16, RLI(ev, 6));
#pragma unroll 1
    for (int k = 0; k < 64; k += 8) {
        load_row8(R7, rs, lane16, RLI(ev, k + 7)); SBAR(); const float d0 = dot_row8(R0, x); SBAR();
        load_row8(R0, rs, lane16, RLI(ev, imin_(k + 8, 63))); SBAR(); const float d1 = dot_row8(R1, x); SBAR();
        load_row8(R1, rs, lane16, RLI(ev, imin_(k + 9, 63))); SBAR(); const float d2 = dot_row8(R2, x); SBAR();
        load_row8(R2, rs, lane16, RLI(ev, imin_(k + 10, 63))); SBAR(); const float d3 = dot_row8(R3, x); SBAR();
        load_row8(R3, rs, lane16, RLI(ev, imin_(k + 11, 63))); SBAR(); const float d4 = dot_row8(R4, x); SBAR();
        load_row8(R4, rs, lane16, RLI(ev, imin_(k + 12, 63))); SBAR(); const float d5 = dot_row8(R5, x); SBAR();
        load_row8(R5, rs, lane16, RLI(ev, imin_(k + 13, 63))); SBAR(); const float d6 = dot_row8(R6, x); SBAR();
        load_row8(R6, rs, lane16, RLI(ev, imin_(k + 14, 63))); SBAR(); const float d7 = dot_row8(R7, x); SBAR();
        const float sred = red8(d0, d1, d2, d3, d4, d5, d6, d7, lane);
        a = ((lane >> 3) == (k >> 3)) ? sred : a; SBAR();
    }
    return a;
}
__device__ __forceinline__ void v_half(f32x2 (&acc)[32], rsrc_t rs, int lane16, int ev, float wv) {
    v4u R0[ROWCH], R1[ROWCH], R2[ROWCH], R3[ROWCH], R4[ROWCH], R5[ROWCH], R6[ROWCH], R7[ROWCH];
    load_row8(R0, rs, lane16, RLI(ev, 0)); load_row8(R1, rs, lane16, RLI(ev, 1)); load_row8(R2, rs, lane16, RLI(ev, 2)); load_row8(R3, rs, lane16, RLI(ev, 3)); load_row8(R4, rs, lane16, RLI(ev, 4)); load_row8(R5, rs, lane16, RLI(ev, 5)); load_row8(R6, rs, lane16, RLI(ev, 6));
#pragma unroll 1
    for (int k = 0; k < 64; k += 8) {
        load_row8(R7, rs, lane16, RLI(ev, k + 7)); SBAR(); axpy_row8(acc, R0, rlf(wv, k + 0)); SBAR();
        load_row8(R0, rs, lane16, RLI(ev, imin_(k + 8, 63))); SBAR(); axpy_row8(acc, R1, rlf(wv, k + 1)); SBAR();
        load_row8(R1, rs, lane16, RLI(ev, imin_(k + 9, 63))); SBAR(); axpy_row8(acc, R2, rlf(wv, k + 2)); SBAR();
        load_row8(R2, rs, lane16, RLI(ev, imin_(k + 10, 63))); SBAR(); axpy_row8(acc, R3, rlf(wv, k + 3)); SBAR();
        load_row8(R3, rs, lane16, RLI(ev, imin_(k + 11, 63))); SBAR(); axpy_row8(acc, R4, rlf(wv, k + 4)); SBAR();
        load_row8(R4, rs, lane16, RLI(ev, imin_(k + 12, 63))); SBAR(); axpy_row8(acc, R5, rlf(wv, k + 5)); SBAR();
        load_row8(R5, rs, lane16, RLI(ev, imin_(k + 13, 63))); SBAR(); axpy_row8(acc, R6, rlf(wv, k + 6)); SBAR();
        load_row8(R6, rs, lane16, RLI(ev, imin_(k + 14, 63))); SBAR(); axpy_row8(acc, R7, rlf(wv, k + 7)); SBAR();
    }
}
#else
#define ROWS16(X) X(0) X(1) X(2) X(3) X(4) X(5) X(6) X(7) X(8) X(9) X(10) X(11) X(12) X(13) X(14) X(15)
__device__ __forceinline__ float u_half(const f32x2 (&x)[32], rsrc_t rs, int lane16, int ev, int lane) {
    float a = 0.f;
    v4u R[16][ROWCH];
#pragma unroll
    for (int i = 0; i < 15; ++i) load_row8(R[i], rs, lane16, RLI(ev, i));
#pragma unroll 1
    for (int k = 0; k < 64; k += 16) {
        float d[16];
#pragma unroll
        for (int i = 0; i < 16; ++i) { load_row8(R[(i + 15) & 15], rs, lane16, RLI(ev, imin_(k + i + 15, 63))); SBAR(); d[i] = dot_row8(R[i], x); SBAR(); }
        const float s0 = red8(d[0], d[1], d[2], d[3], d[4], d[5], d[6], d[7], lane), s1 = red8(d[8], d[9], d[10], d[11], d[12], d[13], d[14], d[15], lane);
        a = ((lane >> 3) == (k >> 3)) ? s0 : a; a = ((lane >> 3) == (k >> 3) + 1) ? s1 : a; SBAR();
    }
    return a;
}
__device__ __forceinline__ void v_half(f32x2 (&acc)[32], rsrc_t rs, int lane16, int ev, float wv) {
    v4u R[16][ROWCH];
#pragma unroll
    for (int i = 0; i < 15; ++i) load_row8(R[i], rs, lane16, RLI(ev, i));
#pragma unroll 1
    for (int k = 0; k < 64; k += 16) {
#pragma unroll
        for (int i = 0; i < 16; ++i) { load_row8(R[(i + 15) & 15], rs, lane16, RLI(ev, imin_(k + i + 15, 63))); SBAR(); axpy_row8(acc, R[i], rlf(wv, k + i)); SBAR(); }
    }
}
#endif
#ifndef P10_MFMA
#define P10_MFMA 0
#endif
#if P10_MFMA
typedef int v8i __attribute__((ext_vector_type(8)));
constexpr int P10_WREG = 8704, P10_ZERO_OFF = 8 * P10_WREG;
__device__ __forceinline__ void u_mfma(LAS unsigned char* wl, LAS unsigned char* zl, rsrc_t rs, int e0, int e1, int lane) {
    const int r = lane & 15, kq = lane >> 4;
    const LAS unsigned char* bp = (r < 2 ? wl + r * 4096 : zl) + kq * 16;
    LAS float* dots = (LAS float*)(wl + 8192);
    int voff[8];
#pragma unroll
    for (int g = 0; g < 8; ++g) voff[g] = __shfl(g < 4 ? e0 : e1, ((g & 3) << 4) + r) * ROWB + kq * 32;
    v4u R[2][8][2], B[2][2][2];
#pragma unroll
    for (int q = 0; q < 2; ++q)
#pragma unroll
        for (int g = 0; g < 8; ++g) { R[q][g][0] = __builtin_amdgcn_raw_buffer_load_b128(rs, voff[g], 128 * q, P10_AUX); R[q][g][1] = __builtin_amdgcn_raw_buffer_load_b128(rs, voff[g] + 16, 128 * q, P10_AUX); }
#pragma unroll
    for (int q = 0; q < 2; ++q)
#pragma unroll
        for (int h = 0; h < 2; ++h) { B[q][h][0] = *(const LAS v4u*)(bp + 256 * q + 128 * h); B[q][h][1] = *(const LAS v4u*)(bp + 256 * q + 128 * h + 64); }
    f32x4 c[8];
#pragma unroll
    for (int g = 0; g < 8; ++g) c[g] = (f32x4){0.f, 0.f, 0.f, 0.f};
#define MF(ra, bb, cc) { const v8i a8_ = {(int)ra[0], (int)ra[1], (int)ra[2], (int)ra[3], 0, 0, 0, 0}, b8_ = {(int)bb[0][0], (int)bb[0][1], (int)bb[0][2], (int)bb[0][3], (int)bb[1][0], (int)bb[1][1], (int)bb[1][2], (int)bb[1][3]}; \
                         cc = __builtin_amdgcn_mfma_scale_f32_16x16x128_f8f6f4(a8_, b8_, cc, 4, 0, 0, 0, 0, 0); }
#pragma unroll 1
    for (int pp = 0; pp < 16; pp += 2) {
#pragma unroll
        for (int q = 0; q < 2; ++q) {
            const int pn = pp + q + 2 < 16 ? pp + q + 2 : 15, so = 128 * pn;
            SBAR();
#pragma unroll
            for (int g = 0; g < 8; ++g) { MF(R[q][g][0], B[q][0], c[g]); SBAR(); R[q][g][0] = __builtin_amdgcn_raw_buffer_load_b128(rs, voff[g], so, P10_AUX); SBAR(); }
#pragma unroll
            for (int g = 0; g < 8; ++g) { MF(R[q][g][1], B[q][1], c[g]); SBAR(); R[q][g][1] = __builtin_amdgcn_raw_buffer_load_b128(rs, voff[g] + 16, so, P10_AUX); SBAR(); }
            { const LAS unsigned char* bq = bp + 256 * pn;
#pragma unroll
              for (int h = 0; h < 2; ++h) { B[q][h][0] = *(const LAS v4u*)(bq + 128 * h); B[q][h][1] = *(const LAS v4u*)(bq + 128 * h + 64); } }
            SBAR();
        }
    }
#undef MF
#pragma unroll
    for (int g = 0; g < 8; ++g) { f32x4 cg = c[g];
#pragma unroll
        for (int i = 0; i < 4; ++i) cg[i] += __shfl_xor(cg[i], 1);
        if (r == 0) *(LAS f32x4*)(dots + 16 * g + 4 * kq) = cg; }
}
#endif
#ifndef P10_SYNC
#define P10_SYNC 0
#endif
__device__ __forceinline__ void xcd_sweep_sync(unsigned* cnt, unsigned x, unsigned nloc, unsigned k) {
    __syncthreads();
    if (threadIdx.x == 0) {
        unsigned* w = cnt + 64 * x;
        (void)xb_add(w, 1u);
        const unsigned want = (k + 1u) * nloc; unsigned sp = 0u;
        while (xb_ld(w) < want) { __builtin_amdgcn_s_sleep(1); if (++sp > 4096u) break; }
    }
    __syncthreads();
}
struct SweepSync { unsigned* cnt; unsigned x, nloc, k; };
__device__ __forceinline__ void p10_token(Frame& F, int t, rsrc_t rsU, rsrc_t rsV, SweepSync& Y) {
    int lane_ = F.lane; asm volatile("" : "+v"(lane_));
    const int lane = lane_, lane16 = lane * 16;
    const int* EIDp = wsp<int>(F, WS_EID) + (size_t)t * 128; const float* GWp = wsp<float>(F, WS_GW) + (size_t)t * 128;
#if P10_SORT
    const int e0_ = EIDp[lane], e1_ = EIDp[64 + lane]; const float g0_ = GWp[lane], g1_ = GWp[64 + lane];
#else
    const int e0 = EIDp[lane], e1 = EIDp[64 + lane]; const float g0 = GWp[lane], g1 = GWp[64 + lane];
#endif
#if P10_SORT
    int e0 = e0_, e1 = e1_; float g0 = g0_, g1 = g1_;
#pragma unroll
    for (int size = 2; size <= 128; size <<= 1)
#pragma unroll
        for (int j = size >> 1; j > 0; j >>= 1) {
            if (j == 64) { const bool sw = e0 > e1; const int te = sw ? e1 : e0, tE = sw ? e0 : e1; const float tg = sw ? g1 : g0, tG = sw ? g0 : g1; e0 = te; e1 = tE; g0 = tg; g1 = tG; }
            else {
                { const int pe = __shfl_xor(e0, j); const float pg = __shfl_xor(g0, j); const bool up = (lane & size) == 0, lower = (lane & j) == 0;
                  const bool take = (lower == up) ? (pe < e0) : (pe > e0); e0 = take ? pe : e0; g0 = take ? pg : g0; }
                { const int i1 = lane + 64; const int pe = __shfl_xor(e1, j); const float pg = __shfl_xor(g1, j); const bool up = (i1 & size) == 0, lower = (lane & j) == 0;
                  const bool take = (lower == up) ? (pe < e1) : (pe > e1); e1 = take ? pe : e1; g1 = take ? pg : g1; }
            }
        }
#endif
    const float* SCU = wsp<float>(F, WS_SCU); const float* SCV = wsp<float>(F, WS_SCV);
    const float su0 = SCU[e0], su1 = SCU[e1], sv0 = SCV[e0], sv1 = SCV[e1];
    float w0, w1;
#if P10_MFMA
    {   const float rrow = 1.f / sqrtf(wave_sum(wsp<float>(F, WS_SSP)[(size_t)t * 64 + lane]) * (1.f / DM) + EPS);
        LAS unsigned char* wl = F.lds + F.wave * P10_WREG; LAS unsigned char* zl = F.lds + P10_ZERO_OFF;
        { const GAS v2u* xp = (const GAS v2u*)(wsp<bf16>(F, WS_XN) + (size_t)t * DM) + lane;
#pragma unroll
          for (int j = 0; j < 16; ++j) { const v2u a = xp[64 * j]; const float x0 = bflo(a.x), x1 = bfhi(a.x), x2 = bflo(a.y), x3 = bfhi(a.y);
              int h = __builtin_amdgcn_cvt_pk_fp8_f32(x0, x1, 0, false); h = __builtin_amdgcn_cvt_pk_fp8_f32(x2, x3, h, true);
              const f32x2 d01 = __builtin_amdgcn_cvt_pk_f32_fp8(h, false), d23 = __builtin_amdgcn_cvt_pk_f32_fp8(h, true);
              int l = __builtin_amdgcn_cvt_pk_fp8_f32(x0 - d01.x, x1 - d01.y, 0, false); l = __builtin_amdgcn_cvt_pk_fp8_f32(x2 - d23.x, x3 - d23.y, l, true);
              *(LAS int*)(wl + 4 * (64 * j + lane)) = h; *(LAS int*)(wl + 4096 + 4 * (64 * j + lane)) = l; } }
        u_mfma(wl, zl, rsU, e0, e1, lane); SBAR();
        const LAS float* dots = (const LAS float*)(wl + 8192);
        const float a0 = dots[lane], a1 = dots[64 + lane];
        w0 = g0 * gelu1(a0 * (su0 * rrow)) * sv0; w1 = g1 * gelu1(a1 * (su1 * rrow)) * sv1;
    }
#else
    {   f32x2 x[32];
        const float rrow = 1.f / sqrtf(wave_sum(wsp<float>(F, WS_SSP)[(size_t)t * 64 + lane]) * (1.f / DM) + EPS);
        { const GAS v2u* xp = (const GAS v2u*)(wsp<bf16>(F, WS_XN) + (size_t)t * DM) + lane;
#pragma unroll
          for (int j = 0; j < 16; ++j) { const v2u a = xp[64 * j]; x[2 * j] = (f32x2){bflo(a.x), bfhi(a.x)}; x[2 * j + 1] = (f32x2){bflo(a.y), bfhi(a.y)}; } }
        if (P10_SYNC && Y.cnt) { xcd_sweep_sync(Y.cnt, Y.x, Y.nloc, Y.k); ++Y.k; }
        const float a0 = u_half(x, rsU, lane16, e0, lane); SBAR();
#if P10_SYNC >= 2
        if (Y.cnt) { xcd_sweep_sync(Y.cnt, Y.x, Y.nloc, Y.k); ++Y.k; }
#endif
        const float a1 = u_half(x, rsU, lane16, e1, lane); SBAR();
        w0 = g0 * gelu1(a0 * (su0 * rrow)) * sv0; w1 = g1 * gelu1(a1 * (su1 * rrow)) * sv1;
    }
#endif
    SBAR();
    f32x2 acc[32];
#pragma unroll
    for (int i = 0; i < 32; ++i) acc[i] = (f32x2){0.f, 0.f};
    if (P10_SYNC && Y.cnt) { xcd_sweep_sync(Y.cnt, Y.x, Y.nloc, Y.k); ++Y.k; }
    v_half(acc, rsV, lane16, e0, w0); SBAR();
#if P10_SYNC >= 2
    if (Y.cnt) { xcd_sweep_sync(Y.cnt, Y.x, Y.nloc, Y.k); ++Y.k; }
#endif
    v_half(acc, rsV, lane16, e1, w1); SBAR();
    GAS f32x4* op = (GAS f32x4*)(F.out + (size_t)t * DM) + lane;
#pragma unroll
    for (int j = 0; j < 16; ++j) { f32x4 h = op[64 * j]; h[0] += acc[2 * j].x; h[1] += acc[2 * j].y; h[2] += acc[2 * j + 1].x; h[3] += acc[2 * j + 1].y; op[64 * j] = h; }
}
__device__ __forceinline__ void p10_range(Frame& F, int t0, int t1, int gw, int NGW, SweepSync Y) {
    const rsrc_t rsU = mk_rsrc(wsp<unsigned char>(F, WS_U8), (unsigned)MTOK * ROWB), rsV = mk_rsrc(wsp<unsigned char>(F, WS_V8), (unsigned)MTOK * ROWB);
#if P10_MFMA
    { int tid_ = F.tid; asm volatile("" : "+v"(tid_)); unsigned z_; asm volatile("v_mov_b32 %0, 0" : "=v"(z_)); ((LAS v2u*)(F.lds + P10_ZERO_OFF))[tid_] = (v2u){z_, z_}; }
    __syncthreads();
#endif
    for (int t = t0 + gw; t < t1; t += NGW) p10_token(F, t, rsU, rsV, Y);
}
constexpr int NPHASE = 11;
#ifndef MK_SYNC
#define MK_SYNC 0
#endif
constexpr int CW_SYNC = 32768, SYNC_STRIDE = 32 * 8 * 64;
static_assert((CW_SYNC + 5 * SYNC_STRIDE) * 4 <= (int)CTL_ZERO_BYTES, "sync counters inside the per-call memset");
constexpr int N_LAUNCHES = MK_N_LAUNCHES;
#ifndef MK_CUT
#define MK_CUT 1
#endif
struct Args { const float* in[17]; float* out; unsigned char* ws; int ph_lo, ph_hi, li, pad; };
__device__ __forceinline__ void cvt_table(const float* src, bf16* dst, size_t n8, int gt, int NT) {
    for (size_t i = gt; i < n8; i += NT) { const f32x4 a = ((const GAS f32x4*)src)[2 * i], b = ((const GAS f32x4*)src)[2 * i + 1];
        v4u o; o.x = pk2(a[0], a[1]); o.y = pk2(a[2], a[3]); o.z = pk2(b[0], b[1]); o.w = pk2(b[2], b[3]); ((GAS v4u*)dst)[i] = o; }
}
#ifndef MK_PIPE
#define MK_PIPE 0
#endif
#ifndef P1_WGM
#define P1_WGM 4
#endif
#ifndef CHAIN_WGM
#define CHAIN_WGM 8
#endif
#ifndef PIPE_CH
#define PIPE_CH 8192
#endif
#ifndef BAR_REP
#define BAR_REP 1
#endif
__device__ __forceinline__ void xbar(const XcdBarrier& b) {
#pragma unroll 1
    for (int q = 0; q < BAR_REP; ++q) xcd_barrier(b);
}
__device__ __forceinline__ void chain_front(Frame& F, int chunk, int CH, int G_, int c_, const XcdBarrier& gb) {
    const size_t r0 = (size_t)chunk * CH;
    { pg8::Gemm g{wsp<bf16>(F, WS_YA) + r0 * 2048, wsp<bf16>(F, WS_WFOX), CH, DM, 2048}; pg8::SyncOrder S; S.init(CH, DM, G_, c_, CHAIN_WGM); S.cnt = nullptr; S.on = 0;
      pg8::EpiGate<0> E{wsp<bf16>(F, WS_MRG) + r0 * DM, wsp<bf16>(F, WS_GA) + r0 * DM, DM};
      pg8::gemm_phase<pg8::EpiGate<0>, pg8::SyncOrder, true, true>(F.lds + RING_OFF, g, S, E); }
    { pg8::Gemm g{wsp<bf16>(F, WS_YR) + r0 * DM, wsp<bf16>(F, WS_WRET), CH, DM, DM}; pg8::SyncOrder S; S.init(CH, DM, G_, c_, CHAIN_WGM); S.cnt = nullptr; S.on = 0;
      pg8::EpiGate<1> E{wsp<bf16>(F, WS_MRG) + r0 * DM, wsp<bf16>(F, WS_GT) + r0 * DM, DM};
      pg8::gemm_phase<pg8::EpiGate<1>, pg8::SyncOrder, true, true>(F.lds + RING_OFF, g, S, E); }
    xbar(gb);
    { pg8::Gemm g{wsp<bf16>(F, WS_MRG) + r0 * DM, wsp<bf16>(F, WS_WOUT), CH, DM, DM}; pg8::SyncOrder S; S.init(CH, DM, G_, c_, CHAIN_WGM); S.cnt = nullptr; S.on = 0;
      pg8::EpiResHG E{F.x + r0 * DM, F.out + r0 * DM, wsp<bf16>(F, WS_XN) + r0 * DM, F.g_ffn, wsp<float>(F, WS_SSP) + r0 * 64, DM};
      pg8::gemm_phase<pg8::EpiResHG, pg8::SyncOrder, true, true>(F.lds + RING_OFF, g, S, E); }
}
__device__ __forceinline__ void chain_query(Frame& F, int chunk, int CH, int G_, int c_) {
    const size_t r0 = (size_t)chunk * CH;
    { pg8::Gemm g{wsp<bf16>(F, WS_XN) + r0 * DM, wsp<bf16>(F, WS_WQ), CH, PQ, DM}; pg8::SyncOrder S; S.init(CH, PQ, G_, c_, CHAIN_WGM); S.cnt = nullptr; S.on = 0;
      LAS float* rs = (LAS float*)(F.lds + LDSX_OFF); pg8::Unit u;
      int tid_ = F.tid; asm volatile("" : "+v"(tid_));
      for (int i = 0; i < 8 && S.next(i, u); ++i)
          if (tid_ < 256) { const GAS f32x4* sp = (const GAS f32x4*)(wsp<float>(F, WS_SSP) + (r0 + (size_t)u.pm * 256 + tid_) * 64); float ss = 0.f;
#pragma unroll
              for (int k = 0; k < 16; ++k) { const f32x4 v = sp[k]; ss += (v[0] + v[1]) + (v[2] + v[3]); }
              rs[256 * i + tid_] = 1.f / sqrtf(ss * (1.f / DM) + EPS); }
      __syncthreads();
      pg8::EpiRowScale E{wsp<bf16>(F, WS_QP) + r0 * PQ, rs, PQ};
      pg8::gemm_phase<pg8::EpiRowScale, pg8::SyncOrder, true, true>(F.lds + RING_OFF, g, S, E);
      const int t0 = chunk * (CH / 256);
      for (int i = 0; S.next(i, u); ++i) p9_unit(F, ((t0 + u.pm) << 3) | u.pn); }
}
#ifndef DBG_DUMP
#define DBG_DUMP -1
#endif
__device__ __forceinline__ void dbg_dump(Frame& F, size_t o0, size_t n0, size_t o1, size_t n1, size_t o2, size_t n2, bool f32_2) {
    const size_t gt = (size_t)F.vcu * 512 + F.tid, NT = (size_t)F.G * 512;
    for (size_t i = gt; i < (size_t)MTOK * DM; i += NT) {
        float v = 0.f;
        if (n0) v += __uint_as_float((unsigned)wsp<bf16>(F, o0)[i % n0] << 16);
        if (n1) v += __uint_as_float((unsigned)wsp<bf16>(F, o1)[i % n1] << 16);
        if (n2) v += f32_2 ? wsp<float>(F, o2)[i % n2] : __uint_as_float((unsigned)wsp<bf16>(F, o2)[i % n2] << 16);
        F.out[i] = v;
    }
}
#ifndef FP6_SEQ
#define FP6_SEQ 0
#endif
__device__ __forceinline__ void cvt_row_fp8(const float* src, unsigned char* dst, float* scale_out, int lane, bool nat) {
    const GAS f32x4* p = (const GAS f32x4*)src + lane;
    f32x4 v[16]; float am = 0.f;
#pragma unroll
    for (int j = 0; j < 16; ++j) { v[j] = p[64 * j]; am = fmaxf(fmaxf(am, fmaxf(__builtin_fabsf(v[j].x), __builtin_fabsf(v[j].y))), fmaxf(__builtin_fabsf(v[j].z), __builtin_fabsf(v[j].w))); }
#pragma unroll
    for (int o = 1; o < 64; o <<= 1) am = fmaxf(am, __shfl_xor(am, o));
    const float s = am > 0.f ? FPMAX / am : 1.f;
#if FPB == 6
    unsigned w[12];
#pragma unroll
    for (int g = 0; g < 2; ++g) { f32x16 a, b;
#pragma unroll
        for (int q = 0; q < 16; ++q) {
#if FP6_SEQ
            const int ka = 32 * g + q, kb = 32 * g + 16 + q;
#else
            const int ka = 32 * g + 2 * q, kb = ka + 1;
#endif
            a[q] = v[ka >> 2][ka & 3] * s; b[q] = v[kb >> 2][kb & 3] * s; }
        const v6u r = __builtin_amdgcn_cvt_scalef32_2xpk16_fp6_f32(a, b, 1.0f);
#pragma unroll
        for (int q = 0; q < 6; ++q) w[6 * g + q] = r[q]; }
#else
    if (nat) {
#pragma unroll
        for (int j = 0; j < 16; ++j) { unsigned t = __builtin_amdgcn_cvt_scalef32_pk_fp4_f32(0u, v[j].x * s, v[j].y * s, 1.0f, 0); t = __builtin_amdgcn_cvt_scalef32_pk_fp4_f32(t, v[j].z * s, v[j].w * s, 1.0f, 1);
            const int c = 4 * (64 * j + lane), ks = c >> 7, kq = (c >> 5) & 3, e = c & 31;
            *(GAS unsigned short*)(dst + 128 * (ks >> 1) + 32 * kq + 16 * (ks & 1) + (e >> 1)) = (unsigned short)t; }
        if (lane == 0) *scale_out = am > 0.f ? am * (1.f / FPMAX) : 1.f;
        return;
    }
    unsigned w[8];
#pragma unroll
    for (int d = 0; d < 8; ++d) { unsigned t = 0u;
#define PK4B(b) { const int k = 8 * d + 2 * (b); t = __builtin_amdgcn_cvt_scalef32_pk_fp4_f32(t, v[k >> 2][k & 3] * s, v[(k + 1) >> 2][(k + 1) & 3] * s, 1.0f, (b)); }
        PK4B(0) PK4B(1) PK4B(2) PK4B(3)
#undef PK4B
        w[d] = t; }
#endif
    GAS v4u* d = (GAS v4u*)dst + lane;
#pragma unroll
    for (int c = 0; c < ROWCH; ++c) d[64 * c] = (v4u){w[4 * c], w[4 * c + 1], w[4 * c + 2], w[4 * c + 3]};
    if (lane == 0) *scale_out = am > 0.f ? am * (1.f / FPMAX) : 1.f;
}
__global__ void __launch_bounds__(512, 2) fwd(Args args) {
    extern __shared__ __attribute__((aligned(16))) unsigned char lds[];
    Frame F;
    F.lds = (LAS unsigned char*)lds;
    F.MISC = (volatile LAS unsigned*)(F.lds + MISC_OFF);
    F.tid = threadIdx.x; F.lane = F.tid & 63; F.wave = __builtin_amdgcn_readfirstlane(F.tid >> 6);
    F.G = gridDim.x; { const int bx = blockIdx.x; F.vcu = (F.G % 8 == 0) ? (bx % 8) * (F.G / 8) + bx / 8 : bx; }
    F.ws = args.ws; F.ctl = (gu32*)(args.ws + WS_CTL);
    F.x = args.in[0]; F.meta = args.in[1]; F.g_mix = args.in[2]; F.w_in = args.in[3]; F.b_forget = args.in[4]; F.g_q = args.in[5]; F.g_k = args.in[6]; F.g_ret = args.in[7];
    F.w_fox = args.in[8]; F.w_ret = args.in[9]; F.w_out = args.in[10]; F.g_ffn = args.in[11]; F.w_q = args.in[12]; F.keys1 = args.in[13]; F.keys2 = args.in[14]; F.pu = args.in[15]; F.pv = args.in[16];
    F.out = args.out;
    for (int u = F.tid; u < (LDS_BYTES - LDSCTL_OFF) / 4; u += 512) ((LAS unsigned*)(F.lds + LDSCTL_OFF))[u] = 0u;
    __syncthreads();
    XcdBarrier bar; bar.bar = (unsigned*)(F.ctl + CW_BAR); bar.x = 0; bar.st = nullptr; bar.G = gridDim.x;
    if (args.ph_hi - args.ph_lo > 1) bar = xcd_barrier_post((unsigned*)(F.ctl + CW_BAR), F.MISC + 8, gridDim.x);
    const int lo = args.ph_lo, hi = args.ph_hi;
#ifndef PH_MASK
#define PH_MASK 0x7ff
#endif
#define IN(k) ((((PH_MASK) >> (k)) & 1) && lo <= (k) && (k) < hi)
#define SEAM(k) do { if (IN(k) && IN((k) + 1)) xbar(bar); } while (0)

    if (IN(0)) { p0_prologue(F);
#ifdef TWICE_P0
        __syncthreads(); p0_prologue(F);
#endif
    } SEAM(0);

    if (IN(1)) {
        pg8::Gemm g{wsp<bf16>(F, WS_UX), wsp<bf16>(F, WS_WZ), MROWS, NZ, DM}; pg8::SyncOrder S; S.init(MROWS, NZ, F.G, (int)blockIdx.x, P1_WGM); S.cnt = (unsigned*)(F.ctl + CW_SYNC) + 0 * SYNC_STRIDE; S.on = MK_SYNC;
#if DBG_DUMP == 100
        pg8::EpiGate<2> E{wsp<bf16>(F, WS_QA), nullptr, NZ};
        pg8::gemm_phase<pg8::EpiGate<2>, pg8::SyncOrder, true, true>(F.lds + RING_OFF, g, S, E);
#else
        pg8::EpiZ E{F.ws, F.b_forget, F.g_q, F.g_k, (LAS float*)(F.lds + LDSX_OFF)};
        pg8::gemm_phase<pg8::EpiZ, pg8::SyncOrder, true, true>(F.lds + RING_OFF, g, S, E);
#ifdef TWICE_P1
        __syncthreads(); pg8::gemm_phase<pg8::EpiZ, pg8::SyncOrder, true, true>(F.lds + RING_OFF, g, S, E);
#endif
#ifdef NULL_P1
        __syncthreads(); { pg8::EpiNull EN{wsp<float>(F, WS_CTL) + 1000}; pg8::gemm_phase<pg8::EpiNull, pg8::SyncOrder, true, true>(F.lds + RING_OFF, g, S, EN); }
#endif
#endif
    } SEAM(1);

    if (DBG_DUMP == 0) { dbg_dump(F, WS_UX, (size_t)MROWS * DM, WS_WZ, (size_t)NZ * DM, WS_WFOX, (size_t)48 * MiB, false); return; }
    if (DBG_DUMP == 100) { const size_t gt = (size_t)F.vcu * 512 + F.tid, NT = (size_t)F.G * 512, TOT = (size_t)MROWS * NZ;
        for (size_t i = gt; i < (size_t)MTOK * DM; i += NT) { float v = 0.f;
            for (int j = 0; j < 7; ++j) { const size_t k = i + (size_t)j * MTOK * DM; if (k < TOT) v += __uint_as_float((unsigned)wsp<bf16>(F, WS_QA)[k] << 16); }
            F.out[i] = v; } return; }
    if (DBG_DUMP == 1) { dbg_dump(F, WS_GR, (size_t)3 * MTOK * DM, 0, 0, 0, 0, false); return; }
    if (IN(2)) { p2_phase(F); } SEAM(2);
    if (DBG_DUMP == 2) { dbg_dump(F, WS_QA, (size_t)NB * NH * SEQ * HD, WS_GR, (size_t)3 * MTOK * DM, WS_KVT, (size_t)NB * NH * NCHUNK * 32768, true); return; }

    if (IN(3)) {
#ifndef NO_SCAN
        p3_scan(F);
#endif
#ifndef NO_ATT
        p3_attention(F, (char*)lds);
#endif
#ifdef TWICE_P3
        __syncthreads(); p3_scan(F); p3_attention(F, (char*)lds);
#endif
    } SEAM(3);

    if (IN(4)) { p4_phase(F);
#ifdef TWICE_P4
        p4_phase(F);
#endif
    } SEAM(4);
    if (DBG_DUMP == 4) { dbg_dump(F, WS_YA, (size_t)MTOK * 2048, WS_YR, (size_t)MTOK * DM, WS_ST, (size_t)NB * NH * NCHUNK * 32768, false); return; }

#if !MK_PIPE
    if (IN(5)) {
        { const int gw = F.vcu * 8 + F.wave, NGW = F.G * 8;
          for (int r = gw; r < 2 * MTOK; r += NGW) { const bool isv = r >= MTOK; const int e = isv ? r - MTOK : r;
              cvt_row_fp8((isv ? F.pv : F.pu) + (size_t)e * DM, wsp<unsigned char>(F, isv ? WS_V8 : WS_U8) + (size_t)e * ROWB, wsp<float>(F, isv ? WS_SCV : WS_SCU) + e, F.lane, P10_MFMA && !isv); } }
        chain_front(F, 0, MTOK, F.G, (int)blockIdx.x, bar); xbar(bar); chain_query(F, 0, MTOK, F.G, (int)blockIdx.x);
    } SEAM(5);
    if (IN(10)) { SweepSync Y{(MTOK % (F.G * 8) == 0) ? (unsigned*)(F.ctl + CW_SYNC) : nullptr, bar.x, bar.st[0], 0u};
        p10_range(F, 0, MTOK, F.vcu * 8 + F.wave, F.G * 8, Y); }
#else
    if (IN(5)) {
        constexpr int CH = PIPE_CH, NCH = MTOK / CH;
#ifndef CVT_REP
#define CVT_REP 1
#endif
#pragma unroll 1
        for (int rep = 0; rep < CVT_REP; ++rep)
        { const int gw = F.vcu * 8 + F.wave, NGW = F.G * 8;
          for (int r = gw; r < 2 * MTOK; r += NGW) { const bool isv = r >= MTOK; const int e = isv ? r - MTOK : r;
              cvt_row_fp8((isv ? F.pv : F.pu) + (size_t)e * DM, wsp<unsigned char>(F, isv ? WS_V8 : WS_U8) + (size_t)e * ROWB, wsp<float>(F, isv ? WS_SCV : WS_SCU) + e, F.lane, P10_MFMA && !isv); } }
        const int roleB = F.vcu & 1, gi2 = F.vcu >> 1, Gh = F.G >> 1;
        const int cB = (gi2 % (Gh / 8)) * 8 + gi2 / (Gh / 8);
        XcdBarrier gbar; gbar.bar = (unsigned*)(F.ctl + CW_BAR) + XCD_BAR_WORDS * (roleB ? 1 : 2); gbar.x = 0; gbar.st = nullptr; gbar.G = (unsigned)Gh;
        gbar = xcd_barrier_post((unsigned*)(F.ctl + CW_BAR) + XCD_BAR_WORDS * (roleB ? 1 : 2), F.MISC + 12, (unsigned)Gh);
#pragma unroll 1
        for (int s = 0; s <= NCH; ++s) {
            if (s < NCH && (s == 0 || roleB)) {
                const bool allc = (s == 0);
                const XcdBarrier gb = allc ? bar : gbar;
                chain_front(F, s, CH, allc ? F.G : Gh, allc ? (int)blockIdx.x : cB, gb);
            }
            if (s >= 1 && (s == NCH || !roleB)) {
                const bool allc = (s == NCH);
                const XcdBarrier gb = allc ? bar : gbar;
                chain_query(F, s - 1, CH, allc ? F.G : Gh, allc ? (int)blockIdx.x : cB);
                xbar(gb);
                p10_range(F, (s - 1) * CH, s * CH, (allc ? F.vcu : gi2) * 8 + F.wave, (allc ? F.G : Gh) * 8, SweepSync{nullptr, 0u, 1u, 0u});
            }
            if (s < NCH) xbar(bar);
        }
    }
#endif
#undef IN
#undef SEAM
}

extern "C" void kernel_launch(void* const* d_in, const int* in_sizes, int n_in, void* d_out, int out_size, void* d_ws, size_t ws_size, hipStream_t stream) {
    static int grid = 0;
    if (grid == 0) {
        if (n_in != 17 || in_sizes[0] != MTOK * DM || out_size != MTOK * DM || ws_size < WS_END) {
            fprintf(stderr, "kernel_launch: unexpected shapes (n_in %d, in0 %d, out %d, ws %zu; need ws >= %zu); nothing launched\n", n_in, n_in > 0 ? in_sizes[0] : -1, out_size, ws_size, (size_t)WS_END); grid = -1; return; }
        int dev = 0, cus = 0, per_cu = 0;
        if (hipGetDevice(&dev) != hipSuccess || hipDeviceGetAttribute(&cus, hipDeviceAttributeMultiprocessorCount, dev) != hipSuccess) { grid = -1; return; }
        if (hipFuncSetAttribute((const void*)fwd, hipFuncAttributeMaxDynamicSharedMemorySize, LDS_BYTES) != hipSuccess) { fprintf(stderr, "kernel_launch: hipFuncSetAttribute failed\n"); grid = -1; return; }
        if (hipOccupancyMaxActiveBlocksPerMultiprocessor(&per_cu, (const void*)fwd, 512, LDS_BYTES) != hipSuccess || per_cu < 1) { fprintf(stderr, "kernel_launch: occupancy query says %d blocks per CU\n", per_cu); }
        (void)hipGetLastError();
        grid = cus;
    }
    if (grid < 0) return;
    (void)hipMemsetAsync((char*)d_ws + WS_CTL, 0, CTL_ZERO_BYTES, stream);
    Args a{};
    for (int i = 0; i < 17; ++i) a.in[i] = (const float*)d_in[i];
    a.out = (float*)d_out; a.ws = (unsigned char*)d_ws; a.pad = 0;
    if (N_LAUNCHES == 1) { a.ph_lo = 0; a.ph_hi = NPHASE; a.li = 0; hipLaunchKernelGGL(fwd, dim3(grid), dim3(512), LDS_BYTES, stream, a); }
    else if (N_LAUNCHES == 2) { a.ph_lo = 0; a.ph_hi = MK_CUT; a.li = 0; hipLaunchKernelGGL(fwd, dim3(grid), dim3(512), LDS_BYTES, stream, a);
        a.ph_lo = MK_CUT; a.ph_hi = NPHASE; a.li = 1; hipLaunchKernelGGL(fwd, dim3(grid), dim3(512), LDS_BYTES, stream, a); }
    else { for (int p = 0; p < NPHASE; ++p) { a.ph_lo = p; a.ph_hi = p + 1; a.li = p; hipLaunchKernelGGL(fwd, dim3(grid), dim3(512), LDS_BYTES, stream, a); } }
}
```
